# Optimizing an MI355X kernel written in HIP

```python
import numpy as np
import jax
import jax.numpy as jnp
from jax import lax

D_MODEL = 1024
BATCH = 8
SEQ = 2048
DEPTH = 2

HEAD_DIM = 64
BLK = 128
CONV_CH = D_MODEL // 4
CONV_K = 31
SWA_HEADS = 4
SWA_KV_HEADS = 2
SWA_WINDOW = 128
RET_HEADS = 4
RET_QK = 64
RET_V = 128
NSA_HEADS = 4
NSA_CMP_LEN = 32
NSA_CMP_STRIDE = 16
NSA_CMP_HIDDEN = 256
NSA_SLC_LEN = 64
NSA_TOPN = 8
NSA_WINDOW = 512
NSA_FORCE = 1e4
N_EXPERTS = 64
TOP_K = 6
N_GROUPS = 8
TOPK_GROUPS = 4
D_EXPERT = D_MODEL // 4
ROUTE_SCALE = 2.5
MOE_BLK = 128
N_BRANCH = 4
ALPHA = (2 * DEPTH) ** 0.25
BETA = (8 * DEPTH) ** -0.25
LN_EPS = 1e-5
NEG_INF = -1e30

IN_WIDTHS = (
    2 * CONV_CH,
    SWA_HEADS * HEAD_DIM, SWA_KV_HEADS * HEAD_DIM, SWA_KV_HEADS * HEAD_DIM,
    RET_HEADS * RET_QK, RET_HEADS * RET_QK, RET_HEADS * RET_V, RET_HEADS * RET_V,
    NSA_HEADS * HEAD_DIM,
    HEAD_DIM, HEAD_DIM, HEAD_DIM, HEAD_DIM, HEAD_DIM, HEAD_DIM,
    3 * NSA_HEADS,
    N_BRANCH * D_MODEL,
)

kernel_name = 'hybrid_conv_swa_retention_nsa_moe_deepnorm'


def layer_norm(x, g, b):
    xf = x.astype(jnp.float32)
    mu = jnp.mean(xf, -1, keepdims=True)
    var = jnp.mean(jnp.square(xf - mu), -1, keepdims=True)
    return ((xf - mu) * lax.rsqrt(var + LN_EPS) * g + b).astype(x.dtype)


def alibi_slopes(n):
    return jnp.asarray([2.0 ** (-8.0 * (i + 1) / n) for i in range(n)], jnp.float32)


def masked_softmax(s, mask, sink=None):
    s = jnp.where(mask, s, NEG_INF)
    m = jnp.max(s, axis=-1, keepdims=True)
    if sink is not None:
        m = jnp.maximum(m, sink)
    e = jnp.where(mask, jnp.exp(s - m), 0.0)
    den = jnp.sum(e, -1, keepdims=True)
    if sink is not None:
        den = den + jnp.exp(sink - m)
    return e / jnp.maximum(den, 1e-30)


def banded_attention(q, k, v, slopes, window, sink=None):
    b, hq, s, dh = q.shape
    hkv = k.shape[1]
    rep = hq // hkv
    nb = s // BLK
    nprev = window // BLK

    def spans(t):
        tb = jnp.pad(t.reshape(b, hkv, nb, BLK, dh), ((0, 0), (0, 0), (nprev, 0), (0, 0), (0, 0)))
        return jnp.concatenate([tb[:, :, w:w + nb] for w in range(nprev + 1)], axis=3)

    ks, vs = spans(k), spans(v)
    qb = q.reshape(b, hkv, rep, nb, BLK, dh)
    sc = jnp.einsum('bgrnqd,bgnkd->bgrnqk', qb, ks, preferred_element_type=jnp.float32) * (dh ** -0.5)
    qpos = jnp.arange(nb)[:, None] * BLK + jnp.arange(BLK)[None, :]
    kpos = (jnp.arange(nb)[:, None] - nprev) * BLK + jnp.arange((nprev + 1) * BLK)[None, :]
    dist = qpos[:, :, None] - kpos[:, None, :]
    mask = (dist >= 0) & (dist < window) & (kpos[:, None, :] >= 0)
    sc = sc - slopes.reshape(1, hkv, rep, 1, 1, 1) * dist.astype(jnp.float32)
    sink_b = None if sink is None else sink.astype(jnp.float32).reshape(1, hkv, rep, 1, 1, 1)
    p = masked_softmax(sc, mask, sink_b)
    o = jnp.einsum('bgrnqk,bgnkd->bgrnqd', p.astype(v.dtype), vs)
    return o.reshape(b, hq, s, dh)


def conformer_conv(u, dw, db, g, b):
    a, gate = jnp.split(u, 2, axis=-1)
    h = a * jax.nn.sigmoid(gate)
    c = h.shape[-1]
    hp = jnp.pad(h, ((0, 0), (CONV_K - 1, 0), (0, 0)))
    y = lax.conv_general_dilated(hp, dw[:, None, :], window_strides=(1,), padding='VALID',
                                 dimension_numbers=('NWC', 'WIO', 'NWC'), feature_group_count=c) + db
    return jax.nn.silu(layer_norm(y, g, b))


def retention(q, k, v, g, gn_g, gn_b):
    b, s, _ = q.shape
    nc = s // BLK
    f32 = jnp.float32

    def heads(t, d):
        return t.reshape(b, nc, BLK, RET_HEADS, d).transpose(0, 3, 1, 2, 4).astype(f32)

    qh = heads(q, RET_QK)
    kh = heads(k, RET_QK) * (RET_QK ** -0.5)
    vh = heads(v, RET_V)
    log_gamma = jnp.log1p(-(2.0 ** (-5.0 - jnp.arange(RET_HEADS, dtype=f32))))
    idx = jnp.arange(BLK, dtype=f32)
    diff = idx[:, None] - idx[None, :]
    dmat = jnp.where(diff >= 0, jnp.exp(log_gamma[:, None, None] * jnp.maximum(diff, 0.0)), 0.0)
    inner = jnp.einsum('bhnqd,bhnkd->bhnqk', qh, kh) * dmat[None, :, None]
    o_inner = jnp.einsum('bhnqk,bhnkd->bhnqd', inner, vh)
    zeta = jnp.exp(log_gamma[:, None] * (BLK - 1 - idx)[None, :])
    xi = jnp.exp(log_gamma[:, None] * (idx + 1.0)[None, :])
    chunk_decay = jnp.exp(log_gamma * BLK)
    kv = jnp.einsum('bhnsd,bhnse->bhnde', kh * zeta[None, :, None, :, None], vh)

    def step(state, kv_c):
        return chunk_decay[None, :, None, None] * state + kv_c, state

    init = jnp.zeros((b, RET_HEADS, RET_QK, RET_V), f32)
    _, prev = lax.scan(step, init, jnp.moveaxis(kv, 2, 0))
    prev = jnp.moveaxis(prev, 0, 2)
    o_cross = jnp.einsum('bhnqd,bhnde->bhnqe', qh, prev) * xi[None, :, None, :, None]
    o = o_inner + o_cross
    mu = jnp.mean(o, -1, keepdims=True)
    var = jnp.mean(jnp.square(o - mu), -1, keepdims=True)
    o = (o - mu) * lax.rsqrt(var + LN_EPS)
    o = o.transpose(0, 2, 3, 1, 4).reshape(b, s, RET_HEADS * RET_V) * gn_g + gn_b
    return (jax.nn.silu(g.astype(f32)) * o).astype(g.dtype)


def native_sparse_attention(q, kc, vc, ks, vs, kw, vw, gates, slopes,
                            pe_k, w1_k, w2_k, pe_v, w1_v, w2_v):
    b, s, _ = q.shape
    dh = HEAD_DIM
    f32 = jnp.float32
    qh = q.reshape(b, s, NSA_HEADS, dh).transpose(0, 2, 1, 3)
    tpos = jnp.arange(s)

    def compress(t, pe, w1, w2):
        tc = t.reshape(b, s // NSA_CMP_STRIDE, NSA_CMP_STRIDE, dh)
        blocks = jnp.concatenate([tc[:, :-1], tc[:, 1:]], axis=2) + pe
        flat = blocks.reshape(b, blocks.shape[1], NSA_CMP_LEN * dh)
        return jax.nn.gelu(flat @ w1, approximate=False) @ w2

    kcmp = compress(kc, pe_k, w1_k, w2_k)
    vcmp = compress(vc, pe_v, w1_v, w2_v)
    ncmp = kcmp.shape[1]
    cstart = jnp.arange(ncmp) * NSA_CMP_STRIDE
    cdist = tpos[:, None] - (cstart + NSA_CMP_LEN - 1)[None, :]
    sc = jnp.einsum('bhtd,bcd->bhtc', qh, kcmp, preferred_element_type=f32) * (dh ** -0.5)
    sc = sc - slopes[:, None, None] * cdist.astype(f32)
    p_cmp = masked_softmax(sc, cdist >= 0)
    o_cmp = jnp.einsum('bhtc,bcd->bhtd', p_cmp.astype(vcmp.dtype), vcmp)

    nslc = s // NSA_SLC_LEN
    sstart = jnp.arange(nslc) * NSA_SLC_LEN
    overlap = ((cstart[:, None] < sstart[None, :] + NSA_SLC_LEN)
               & (cstart[:, None] + NSA_CMP_LEN > sstart[None, :])).astype(f32)
    imp = jnp.einsum('bhtc,cj->btj', p_cmp, overlap)
    cur = tpos // NSA_SLC_LEN
    jj = jnp.arange(nslc)
    forced = (jj[None, :] == 0) | (jj[None, :] == cur[:, None]) | (jj[None, :] == cur[:, None] - 1)
    future = jj[None, :] > cur[:, None]
    imp = jnp.where(forced, NSA_FORCE, jnp.where(future, -1.0, imp))
    _, sel = lax.top_k(imp, min(NSA_TOPN, nslc))

    kb = ks.reshape(b, nslc, NSA_SLC_LEN, dh)
    vb = vs.reshape(b, nslc, NSA_SLC_LEN, dh)
    nq = s // BLK
    take = jax.vmap(lambda t, i: t[i])

    def sel_block(args):
        q_blk, idx_blk, t_blk = args
        k_sel = take(kb, idx_blk)
        v_sel = take(vb, idx_blk)
        kpos = idx_blk[..., None] * NSA_SLC_LEN + jnp.arange(NSA_SLC_LEN)
        dist = t_blk[None, :, None, None] - kpos
        sc_s = jnp.einsum('bhqd,bqnld->bhqnl', q_blk, k_sel, preferred_element_type=f32) * (dh ** -0.5)
        sc_s = sc_s - slopes[None, :, None, None, None] * dist[:, None].astype(f32)
        p = masked_softmax(sc_s.reshape(b, NSA_HEADS, BLK, -1), (dist >= 0).reshape(b, 1, BLK, -1))
        return jnp.einsum('bhqm,bqmd->bhqd', p.astype(v_sel.dtype), v_sel.reshape(b, BLK, -1, dh))

    xs = (jnp.moveaxis(qh.reshape(b, NSA_HEADS, nq, BLK, dh), 2, 0),
          jnp.moveaxis(sel.reshape(b, nq, BLK, -1), 1, 0),
          tpos.reshape(nq, BLK))
    o_slc = jnp.moveaxis(lax.map(sel_block, xs), 0, 2).reshape(b, NSA_HEADS, s, dh)

    o_win = banded_attention(qh, kw[:, None], vw[:, None], slopes, NSA_WINDOW)

    gt = jax.nn.sigmoid(gates.astype(f32)).reshape(b, s, 3, NSA_HEADS).transpose(2, 0, 3, 1)[..., None]
    o = gt[0] * o_cmp + gt[1] * o_slc + gt[2] * o_win
    return o.transpose(0, 2, 1, 3).reshape(b, s, NSA_HEADS * dh).astype(q.dtype)


def token_mixer(x, w_in, conv_dw, conv_db, conv_ln_g, conv_ln_b, swa_sink, ret_gn_g, ret_gn_b,
                nsa_pe_k, nsa_w1_k, nsa_w2_k, nsa_pe_v, nsa_w1_v, nsa_w2_v,
                p_conv, p_swa, p_ret, p_nsa, w_out, slopes_swa, slopes_nsa):
    b, s, d = x.shape
    u = x @ w_in
    (conv_in, swa_q, swa_k, swa_v, ret_q, ret_k, ret_v, ret_g,
     nsa_q, nsa_kc, nsa_vc, nsa_ks, nsa_vs, nsa_kw, nsa_vw, nsa_gate, merge_gate) = jnp.split(
        u, [int(c) for c in np.cumsum(IN_WIDTHS)[:-1]], axis=-1)

    def heads(t, n):
        return t.reshape(b, s, n, HEAD_DIM).transpose(0, 2, 1, 3)

    y_conv = conformer_conv(conv_in, conv_dw, conv_db, conv_ln_g, conv_ln_b) @ p_conv
    o_swa = banded_attention(heads(swa_q, SWA_HEADS), heads(swa_k, SWA_KV_HEADS),
                             heads(swa_v, SWA_KV_HEADS), slopes_swa, SWA_WINDOW, swa_sink)
    y_swa = o_swa.transpose(0, 2, 1, 3).reshape(b, s, SWA_HEADS * HEAD_DIM) @ p_swa
    y_ret = retention(ret_q, ret_k, ret_v, ret_g, ret_gn_g, ret_gn_b) @ p_ret
    y_nsa = native_sparse_attention(nsa_q, nsa_kc, nsa_vc, nsa_ks, nsa_vs, nsa_kw, nsa_vw, nsa_gate,
                                    slopes_nsa, nsa_pe_k, nsa_w1_k, nsa_w2_k,
                                    nsa_pe_v, nsa_w1_v, nsa_w2_v) @ p_nsa
    gts = jax.nn.sigmoid(merge_gate.reshape(b, s, N_BRANCH, d).astype(jnp.float32))
    merged = (gts[..., 0, :] * y_conv + gts[..., 1, :] * y_swa
              + gts[..., 2, :] * y_ret + gts[..., 3, :] * y_nsa).astype(x.dtype)
    return merged @ w_out


def moe_ffn(x, router_w, router_b, wg, wu, wd, sh_wg, sh_wu, sh_wd):
    b, s, d = x.shape
    n_tok = b * s
    xt = x.reshape(n_tok, d)
    scores = jax.nn.sigmoid(xt.astype(jnp.float32) @ router_w.astype(jnp.float32).T)
    biased = scores + router_b.astype(jnp.float32)
    grp_score = lax.top_k(biased.reshape(n_tok, N_GROUPS, N_EXPERTS // N_GROUPS), 2)[0].sum(-1)
    _, gidx = lax.top_k(grp_score, TOPK_GROUPS)
    gmask = jnp.any(gidx[:, :, None] == jnp.arange(N_GROUPS)[None, None, :], axis=1)
    emask = jnp.repeat(gmask, N_EXPERTS // N_GROUPS, axis=1)
    _, eidx = lax.top_k(jnp.where(emask, biased, NEG_INF), TOP_K)
    gate = jnp.take_along_axis(scores, eidx, axis=1)
    gate = gate / jnp.sum(gate, -1, keepdims=True) * ROUTE_SCALE

    n_asg = n_tok * TOP_K
    e_flat = eidx.reshape(-1)
    order = jnp.argsort(e_flat)
    e_sorted = e_flat[order]
    tok_sorted = (jnp.arange(n_asg, dtype=jnp.int32) // TOP_K)[order]
    gate_sorted = gate.reshape(-1)[order]
    counts = jnp.bincount(e_flat, length=N_EXPERTS)
    padded = (counts + MOE_BLK - 1) // MOE_BLK * MOE_BLK
    pend = jnp.cumsum(padded)
    dest = (pend - padded)[e_sorted] + jnp.arange(n_asg) - (jnp.cumsum(counts) - counts)[e_sorted]
    n_blocks = (n_asg + N_EXPERTS * (MOE_BLK - 1) + MOE_BLK - 1) // MOE_BLK
    rows = n_blocks * MOE_BLK
    row_tok = jnp.full((rows,), n_tok, jnp.int32).at[dest].set(tok_sorted)
    row_gate = jnp.zeros((rows,), jnp.float32).at[dest].set(gate_sorted)
    blk_exp = jnp.minimum(jnp.searchsorted(pend, jnp.arange(n_blocks) * MOE_BLK, side='right'),
                          N_EXPERTS - 1)
    xpad = jnp.concatenate([xt, jnp.zeros((1, d), xt.dtype)], axis=0)

    def expert_block(args):
        tok, e = args
        h = xpad[tok]
        return (jax.nn.silu(h @ wg[e]) * (h @ wu[e])) @ wd[e]

    y_rows = lax.map(expert_block, (row_tok.reshape(n_blocks, MOE_BLK), blk_exp)).reshape(rows, d)
    routed = jax.ops.segment_sum(y_rows * row_gate[:, None], row_tok, num_segments=n_tok + 1)[:n_tok]
    shared = (jax.nn.silu(xt @ sh_wg) * (xt @ sh_wu)) @ sh_wd
    return (routed + shared).reshape(b, s, d).astype(x.dtype)


def setup_inputs(seed: int = 0) -> dict:
    key = jax.random.key(seed)
    keys = iter(jax.random.split(key, 40))
    L = DEPTH
    D = D_MODEL

    def nrm(shape, scale):
        return jax.random.normal(next(keys), shape, jnp.float32) * scale

    return {
        'x': nrm((BATCH, SEQ, D), 1.0),
        'w_in': nrm((L, D, sum(IN_WIDTHS)), D ** -0.5),
        'conv_dw': nrm((L, CONV_K, CONV_CH), CONV_K ** -0.5),
        'conv_db': nrm((L, CONV_CH), 0.02),
        'conv_ln_g': 1.0 + nrm((L, CONV_CH), 0.02),
        'conv_ln_b': nrm((L, CONV_CH), 0.02),
        'swa_sink': nrm((L, SWA_HEADS), 0.5),
        'ret_gn_g': 1.0 + nrm((L, RET_HEADS * RET_V), 0.02),
        'ret_gn_b': nrm((L, RET_HEADS * RET_V), 0.02),
        'nsa_pe_k': nrm((L, NSA_CMP_LEN, HEAD_DIM), 0.02),
        'nsa_w1_k': nrm((L, NSA_CMP_LEN * HEAD_DIM, NSA_CMP_HIDDEN), (NSA_CMP_LEN * HEAD_DIM) ** -0.5),
        'nsa_w2_k': nrm((L, NSA_CMP_HIDDEN, HEAD_DIM), NSA_CMP_HIDDEN ** -0.5),
        'nsa_pe_v': nrm((L, NSA_CMP_LEN, HEAD_DIM), 0.02),
        'nsa_w1_v': nrm((L, NSA_CMP_LEN * HEAD_DIM, NSA_CMP_HIDDEN), (NSA_CMP_LEN * HEAD_DIM) ** -0.5),
        'nsa_w2_v': nrm((L, NSA_CMP_HIDDEN, HEAD_DIM), NSA_CMP_HIDDEN ** -0.5),
        'p_conv': nrm((L, CONV_CH, D), CONV_CH ** -0.5),
        'p_swa': nrm((L, SWA_HEADS * HEAD_DIM, D), (SWA_HEADS * HEAD_DIM) ** -0.5),
        'p_ret': nrm((L, RET_HEADS * RET_V, D), (RET_HEADS * RET_V) ** -0.5),
        'p_nsa': nrm((L, NSA_HEADS * HEAD_DIM, D), (NSA_HEADS * HEAD_DIM) ** -0.5),
        'w_out': nrm((L, D, D), BETA * D ** -0.5),
        'ln1_g': 1.0 + nrm((L, D), 0.02),
        'ln1_b': nrm((L, D), 0.02),
        'router_w': nrm((L, N_EXPERTS, D), D ** -0.5),
        'router_b': nrm((L, N_EXPERTS), 0.01),
        'moe_wg': nrm((L, N_EXPERTS, D, D_EXPERT), D ** -0.5),
        'moe_wu': nrm((L, N_EXPERTS, D, D_EXPERT), D ** -0.5),
        'moe_wd': nrm((L, N_EXPERTS, D_EXPERT, D), BETA * D_EXPERT ** -0.5),
        'sh_wg': nrm((L, D, D_EXPERT), D ** -0.5),
        'sh_wu': nrm((L, D, D_EXPERT), D ** -0.5),
        'sh_wd': nrm((L, D_EXPERT, D), BETA * D_EXPERT ** -0.5),
        'ln2_g': 1.0 + nrm((L, D), 0.02),
        'ln2_b': nrm((L, D), 0.02),
    }


def reference(x, w_in, conv_dw, conv_db, conv_ln_g, conv_ln_b, swa_sink, ret_gn_g, ret_gn_b,
              nsa_pe_k, nsa_w1_k, nsa_w2_k, nsa_pe_v, nsa_w1_v, nsa_w2_v,
              p_conv, p_swa, p_ret, p_nsa, w_out, ln1_g, ln1_b,
              router_w, router_b, moe_wg, moe_wu, moe_wd, sh_wg, sh_wu, sh_wd, ln2_g, ln2_b):
    slopes = alibi_slopes(SWA_HEADS + NSA_HEADS)
    slopes_swa, slopes_nsa = slopes[:SWA_HEADS], slopes[SWA_HEADS:]
    for l in range(DEPTH):
        mix = token_mixer(x, w_in[l], conv_dw[l], conv_db[l], conv_ln_g[l], conv_ln_b[l], swa_sink[l],
                          ret_gn_g[l], ret_gn_b[l], nsa_pe_k[l], nsa_w1_k[l], nsa_w2_k[l],
                          nsa_pe_v[l], nsa_w1_v[l], nsa_w2_v[l], p_conv[l], p_swa[l], p_ret[l], p_nsa[l],
                          w_out[l], slopes_swa, slopes_nsa)
        x = layer_norm(ALPHA * x + mix, ln1_g[l], ln1_b[l])
        ffn = moe_ffn(x, router_w[l], router_b[l], moe_wg[l], moe_wu[l], moe_wd[l],
                      sh_wg[l], sh_wu[l], sh_wd[l])
        x = layer_norm(ALPHA * x + ffn, ln2_g[l], ln2_b[l])
    return x
```

```cpp
#include <hip/hip_runtime.h>
#include <stdint.h>
#include <stdio.h>

#ifndef ONE_LAUNCH
#define ONE_LAUNCH 0
#endif

typedef unsigned short u16;
typedef short bf16x8 __attribute__((ext_vector_type(8)));
typedef short bf16x4 __attribute__((ext_vector_type(4)));
typedef float f32x4 __attribute__((ext_vector_type(4)));
typedef unsigned u32x4 __attribute__((ext_vector_type(4)));
typedef unsigned u32x2 __attribute__((ext_vector_type(2)));

#define NTHR 256
#define T_TOK 16384
#define SEQ 2048
#define DM 1024
#define ALPHA_F 1.41421356237f
#define LN_EPS_F 1e-5f
#define NEGBIG (-1e30f)
#define LDU 2560
#define LDACT 1280
#define SMEM_BYTES 65536
#define SMEM_PRE_OFF 61440
#define SMEM_BAR_OFF 65520

struct Params { const float* in[32]; float* out; unsigned char* ws; };

constexpr size_t al256(size_t x) { return (x + 255) & ~(size_t)255; }
constexpr size_t OFF_BAR   = 0;
constexpr size_t OFF_CNT   = 16384;
constexpr size_t OFF_BIAS1 = OFF_CNT + 1024;
constexpr size_t OFF_XB    = 32768;
constexpr size_t SZ_TD     = (size_t)T_TOK * 1024 * 2;
constexpr size_t OFF_Z     = OFF_XB + SZ_TD;
constexpr size_t OFF_A     = OFF_Z + SZ_TD;
constexpr size_t OFF_U     = OFF_A;
constexpr size_t SZ_U      = (size_t)T_TOK * LDU * 2;
constexpr size_t OFF_UT    = OFF_U + SZ_U;
constexpr size_t SZ_UT     = (size_t)8 * 1024 * 2048 * 2;
constexpr size_t SZ_A      = (size_t)T_TOK * 6 * 1024 * 2;
static_assert(SZ_A >= SZ_U + SZ_UT, "region A");
constexpr size_t OFF_YSLOT = OFF_A;
constexpr size_t OFF_B     = OFF_A + SZ_A;
constexpr size_t OFF_ACT   = OFF_B;
constexpr size_t SZ_ACT    = (size_t)T_TOK * LDACT * 2;
constexpr size_t OFF_MERGED= OFF_ACT + SZ_ACT;
constexpr size_t SZ_B      = SZ_ACT + SZ_TD;
constexpr size_t OFF_H     = OFF_B;
static_assert(SZ_B >= (size_t)(98304 + 64 * 127 + 16384 + 128) * 256 * 2, "region B");
constexpr size_t OFF_KC    = OFF_B + SZ_B;
constexpr size_t SZ_KC     = al256(((size_t)T_TOK * 64 + 1024) * 2);
constexpr size_t OFF_VC    = OFF_KC + SZ_KC;
constexpr size_t OFF_KCMP  = OFF_VC + SZ_KC;
constexpr size_t OFF_VCMPT = OFF_KCMP + 1024 * 64 * 2;
constexpr size_t OFF_KVT   = OFF_VCMPT + 8 * 64 * 128 * 2;
constexpr size_t OFF_LIST  = OFF_KVT + (size_t)512 * 8192 * 4;
constexpr size_t OFF_GATEW = OFF_LIST + (size_t)64 * 16384 * 4;
constexpr size_t OFF_WINT  = OFF_GATEW + (size_t)T_TOK * 8 * 4;
constexpr size_t OFF_PT    = OFF_WINT + (size_t)7680 * 1024 * 2;
constexpr size_t OFF_WOUT  = OFF_PT + (size_t)1280 * 1024 * 2;
constexpr size_t OFF_RW    = OFF_WOUT + (size_t)1024 * 1024 * 2;
constexpr size_t OFF_WUP   = OFF_RW + (size_t)64 * 1024 * 2;
constexpr size_t OFF_WD    = OFF_WUP + (size_t)65 * 512 * 1024 * 2;
constexpr size_t OFF_W1T   = OFF_WD + (size_t)65 * 1024 * 256 * 2;
constexpr size_t OFF_W2T   = OFF_W1T + (size_t)2 * 256 * 2048 * 2;
constexpr size_t WS_TOTAL  = OFF_W2T + (size_t)2 * 64 * 256 * 2;

#define MFMA16(a, b, c) __builtin_amdgcn_mfma_f32_16x16x32_bf16((a), (b), (c), 0, 0, 0)

__device__ __forceinline__ u16 f2bf(float f) { uint32_t u = __float_as_uint(f); u += 0x7fffu + ((u >> 16) & 1u); return (u16)(u >> 16); }
__device__ __forceinline__ float bf2f(u16 h) { return __uint_as_float(((uint32_t)h) << 16); }
__device__ __forceinline__ uint32_t pack2(float a, float b) { return (uint32_t)f2bf(a) | ((uint32_t)f2bf(b) << 16); }
__device__ __forceinline__ uint2 pack4(f32x4 v) { return make_uint2(pack2(v[0], v[1]), pack2(v[2], v[3])); }
__device__ __forceinline__ float sigmoidf_(float x) { return 1.f / (1.f + __expf(-x)); }
__device__ __forceinline__ float siluf_(float x) { return x / (1.f + __expf(-x)); }
__device__ __forceinline__ float bflo(uint32_t w) { return __uint_as_float(w << 16); }
__device__ __forceinline__ float bfhi(uint32_t w) { return __uint_as_float(w & 0xffff0000u); }

__device__ __forceinline__ int tid_opaque() { int t = threadIdx.x; asm volatile("" : "+v"(t)); return t; }

template <int WM, int WN> __device__ __forceinline__ void zero_acc(f32x4 (&acc)[WM][WN]) {
#pragma unroll
    for (int i = 0; i < WM; ++i)
#pragma unroll
        for (int j = 0; j < WN; ++j) acc[i][j] = (f32x4){0.f, 0.f, 0.f, 0.f};
}

template <int WM, int WN, class FA, class FB>
__device__ __forceinline__ void gemm_acc(f32x4 (&acc)[WM][WN], FA rowA, FB rowB, int K, u16* sA, u16* sB) {
    const int tid = tid_opaque(), lane = tid & 63, wave = tid >> 6;
    const int wm = wave >> 1, wn = wave & 1;
    const int lr = tid >> 3, lc = (tid & 7) * 8;
    const int fr = lane & 15, fg = lane >> 4;
    const u16* pa[WM]; const u16* pb[WN];
#pragma unroll
    for (int i = 0; i < WM; ++i) pa[i] = rowA(lr + 32 * i) + lc;
#pragma unroll
    for (int j = 0; j < WN; ++j) pb[j] = rowB(lr + 32 * j) + lc;
    u32x4 ra[WM], rb[WN];
#pragma unroll
    for (int i = 0; i < WM; ++i) ra[i] = *(const u32x4*)(pa[i]);
#pragma unroll
    for (int j = 0; j < WN; ++j) rb[j] = *(const u32x4*)(pb[j]);
    for (int k0 = 0; k0 < K; k0 += 64) {
        __syncthreads();
#pragma unroll
        for (int i = 0; i < WM; ++i) *(u32x4*)&sA[(lr + 32 * i) * 72 + lc] = ra[i];
#pragma unroll
        for (int j = 0; j < WN; ++j) *(u32x4*)&sB[(lr + 32 * j) * 72 + lc] = rb[j];
        __syncthreads();
        if (k0 + 64 < K) {
#pragma unroll
            for (int i = 0; i < WM; ++i) ra[i] = *(const u32x4*)(pa[i] + k0 + 64);
#pragma unroll
            for (int j = 0; j < WN; ++j) rb[j] = *(const u32x4*)(pb[j] + k0 + 64);
        }
#pragma unroll
        for (int ks = 0; ks < 2; ++ks) {
            bf16x8 a[WM], b[WN];
#pragma unroll
            for (int i = 0; i < WM; ++i) a[i] = *(const bf16x8*)&sA[(wm * 16 * WM + 16 * i + fr) * 72 + 32 * ks + 8 * fg];
#pragma unroll
            for (int j = 0; j < WN; ++j) b[j] = *(const bf16x8*)&sB[(wn * 16 * WN + 16 * j + fr) * 72 + 32 * ks + 8 * fg];
#pragma unroll
            for (int i = 0; i < WM; ++i)
#pragma unroll
                for (int j = 0; j < WN; ++j) acc[i][j] = MFMA16(a[i], b[j], acc[i][j]);
        }
    }
}

__device__ __forceinline__ void stage_rows64(u16* s, const u16* g, int ld) {
    const int t = tid_opaque(), r = t >> 2, c = (t & 3) * 16;
    const uint4* p = (const uint4*)(g + (size_t)r * ld + c);
    const uint4 v0 = p[0], v1 = p[1];
    *(uint4*)&s[r * 72 + c] = v0; *(uint4*)&s[r * 72 + c + 8] = v1;
}
__device__ __forceinline__ void qk64(const u16* sK, const bf16x8 (&qf)[2], f32x4 (&s)[4], int lane) {
    const int r = lane & 15, g = lane >> 4;
#pragma unroll
    for (int mt = 0; mt < 4; ++mt) {
        s[mt] = (f32x4){0.f, 0.f, 0.f, 0.f};
#pragma unroll
        for (int ks = 0; ks < 2; ++ks) {
            const bf16x8 a = *(const bf16x8*)&sK[(16 * mt + r) * 72 + 32 * ks + 8 * g];
            s[mt] = MFMA16(a, qf[ks], s[mt]);
        }
    }
}
template <int DT>
__device__ __forceinline__ void pv64(const u16* sVt, int vstride, const bf16x8 (&pb)[2], f32x4 (&o)[DT], int lane) {
    const int r = lane & 15, g = lane >> 4;
#pragma unroll
    for (int dt = 0; dt < DT; ++dt)
#pragma unroll
        for (int s2 = 0; s2 < 2; ++s2) {
            const u16* p = &sVt[(16 * dt + r) * vstride + 32 * s2 + 4 * g];
            const u32x2 lo = *(const u32x2*)p, hi = *(const u32x2*)(p + 16);
            const u32x4 av = {lo.x, lo.y, hi.x, hi.y};
            o[dt] = MFMA16(__builtin_bit_cast(bf16x8, av), pb[s2], o[dt]);
        }
}
__device__ __forceinline__ void pack_p(const float (&x)[16], bf16x8 (&pb)[2]) {
#pragma unroll
    for (int s2 = 0; s2 < 2; ++s2) {
        const u32x4 tv = {pack2(x[8 * s2 + 0], x[8 * s2 + 1]), pack2(x[8 * s2 + 2], x[8 * s2 + 3]),
                          pack2(x[8 * s2 + 4], x[8 * s2 + 5]), pack2(x[8 * s2 + 6], x[8 * s2 + 7])};
        pb[s2] = __builtin_bit_cast(bf16x8, tv);
    }
}
template <int DT, class F>
__device__ __forceinline__ void flash_step(const u16* sK, const u16* sVt, int vstride, const bf16x8 (&qf)[2],
                                           f32x4 (&o)[DT], float& m, float& l, bool lane_active, F logit, int lane) {
    if (__ballot(lane_active) == 0ull) return;
    f32x4 s[4]; qk64(sK, qf, s, lane);
    const int g = lane >> 4;
    float x[16]; float mx = NEGBIG;
#pragma unroll
    for (int mt = 0; mt < 4; ++mt)
#pragma unroll
        for (int rr = 0; rr < 4; ++rr) {
            bool valid; float v = logit(16 * mt + 4 * g + rr, s[mt][rr], valid);
            v = (valid && lane_active) ? v : NEGBIG; x[mt * 4 + rr] = v; mx = fmaxf(mx, v);
        }
    mx = fmaxf(mx, __shfl_xor(mx, 16)); mx = fmaxf(mx, __shfl_xor(mx, 32));
    const float mn = fmaxf(m, mx), alpha = __expf(m - mn);
    float ps = 0.f;
#pragma unroll
    for (int i = 0; i < 16; ++i) { const float pv = (x[i] > -1e29f) ? __expf(x[i] - mn) : 0.f; x[i] = pv; ps += pv; }
    l = l * alpha + ps; m = mn;
#pragma unroll
    for (int dt = 0; dt < DT; ++dt) o[dt] *= alpha;
    bf16x8 pb[2]; pack_p(x, pb);
    pv64<DT>(sVt, vstride, pb, o, lane);
}

__device__ __forceinline__ void prep_tile(const float* __restrict__ src, int ld_src, int k0, int c0, int nvalid,
                                          u16* __restrict__ dst, int ld_dst, int drow_base, int grp_stride, float* tile) {
    const int t = threadIdx.x;
    {
        const int rr = t >> 4, cc = (t & 15) * 4;
#pragma unroll
        for (int ii = 0; ii < 4; ++ii) {
            const int row = rr + 16 * ii;
            float4 v = make_float4(0.f, 0.f, 0.f, 0.f);
            if (cc < nvalid) v = *(const float4*)(src + (size_t)(k0 + row) * ld_src + c0 + cc);
            float* tp = tile + row * 65 + cc; tp[0] = v.x; tp[1] = v.y; tp[2] = v.z; tp[3] = v.w;
        }
    }
    __syncthreads();
    {
        const int j = t >> 2, kk = (t & 3) * 16;
        uint32_t w[8];
#pragma unroll
        for (int i = 0; i < 8; ++i) w[i] = pack2(tile[(kk + 2 * i) * 65 + j], tile[(kk + 2 * i + 1) * 65 + j]);
        u16* dp = dst + (size_t)(drow_base + (j >> 4) * grp_stride + (j & 15)) * ld_dst + k0 + kk;
        *(uint4*)dp = make_uint4(w[0], w[1], w[2], w[3]); *(uint4*)(dp + 8) = make_uint4(w[4], w[5], w[6], w[7]);
    }
    __syncthreads();
}
__device__ __forceinline__ void win_seg(int drow, int& src, int& nvalid) {
    nvalid = 64;
    if (drow < 896) src = drow;
    else if (drow < 1152) src = 1024 + (drow - 896);
    else if (drow < 1408) src = 1280 + (drow - 1152);
    else if (drow < 1920) src = 2048 + (drow - 1408);
    else if (drow < 2176) src = 2560 + (drow - 1920);
    else if (drow < 2240) src = 2816;
    else if (drow < 2304) src = 2880;
    else if (drow < 2368) src = 2944;
    else if (drow < 2432) src = 3072;
    else if (drow < 2496) { src = 3200; nvalid = 12; }
    else if (drow < 2560) { src = 0; nvalid = 0; }
    else if (drow < 2688) src = 896 + (drow - 2560);
    else if (drow < 2944) src = 1280 + (drow - 2688);
    else if (drow < 3456) src = 1536 + (drow - 2944);
    else if (drow < 3520) src = 3008;
    else if (drow < 3584) src = 3136;
    else src = 3212 + (drow - 3584);
}
__device__ __forceinline__ void cvt16(const float* src, u16* dst) {
    const float4 a = ((const float4*)src)[0], b = ((const float4*)src)[1], c = ((const float4*)src)[2], d = ((const float4*)src)[3];
    *(uint4*)dst = make_uint4(pack2(a.x, a.y), pack2(a.z, a.w), pack2(b.x, b.y), pack2(b.z, b.w));
    *(uint4*)(dst + 8) = make_uint4(pack2(c.x, c.y), pack2(c.z, c.w), pack2(d.x, d.y), pack2(d.z, d.w));
}
__device__ __forceinline__ void prep_phase(const Params& p, int layer, bool with_x, unsigned char* smem) {
    float* tile = (float*)smem;
    unsigned char* ws = p.ws;
    const int nA = 1920, nB = 320, nC = 256, nD = 8320, nE = 4160, nF = 256, nG = 8, nH = 16, nI = 2, nJ = 1, nX = with_x ? 4096 : 0;
    const int total = nA + nB + nC + nD + nE + nF + nG + nH + nI + nJ + nX;
    const int t = threadIdx.x;
    for (int it = blockIdx.x; it < total; it += gridDim.x) {
        int idx = it;
        if (idx < nA) {
            const int dg = idx >> 4, kt = idx & 15; int src, nv; win_seg(dg * 64, src, nv);
            prep_tile(p.in[1] + (size_t)layer * 1024 * 7308, 7308, kt * 64, src, nv, (u16*)(ws + OFF_WINT), 1024, dg * 64, 16, tile);
            continue;
        }
        idx -= nA;
        if (idx < nB) {
            const float* src; int K, local; size_t off;
            if (idx < 64) { src = p.in[15] + (size_t)layer * 256 * 1024; K = 256; local = idx; off = 0; }
            else if (idx < 128) { src = p.in[16] + (size_t)layer * 256 * 1024; K = 256; local = idx - 64; off = 262144; }
            else if (idx < 256) { src = p.in[17] + (size_t)layer * 512 * 1024; K = 512; local = idx - 128; off = 524288; }
            else { src = p.in[18] + (size_t)layer * 256 * 1024; K = 256; local = idx - 256; off = 1048576; }
            const int nk = K >> 6, ct = local / nk, kt = local % nk;
            prep_tile(src, 1024, kt * 64, ct * 64, 64, (u16*)(ws + OFF_PT) + off, K, ct * 64, 16, tile);
            continue;
        }
        idx -= nB;
        if (idx < nC) {
            const int ct = idx >> 4, kt = idx & 15;
            prep_tile(p.in[19] + (size_t)layer * 1024 * 1024, 1024, kt * 64, ct * 64, 64, (u16*)(ws + OFF_WOUT), 1024, ct * 64, 16, tile);
            continue;
        }
        idx -= nC;
        if (idx < nD) {
            const int e = idx >> 7, rem = idx & 127, isUp = rem >> 6, r2 = rem & 63, ct = r2 >> 4, kt = r2 & 15;
            const float* src = (e < 64) ? p.in[24 + isUp] + ((size_t)layer * 64 + e) * 1024 * 256 : p.in[27 + isUp] + (size_t)layer * 1024 * 256;
            prep_tile(src, 256, kt * 64, ct * 64, 64, (u16*)(ws + OFF_WUP) + (size_t)e * 512 * 1024, 1024, 32 * (ct * 4) + 16 * isUp, 32, tile);
            continue;
        }
        idx -= nD;
        if (idx < nE) {
            const int e = idx >> 6, r2 = idx & 63, ct = r2 >> 2, kt = r2 & 3;
            const float* src = (e < 64) ? p.in[26] + ((size_t)layer * 64 + e) * 256 * 1024 : p.in[29] + (size_t)layer * 256 * 1024;
            prep_tile(src, 1024, kt * 64, ct * 64, 64, (u16*)(ws + OFF_WD) + (size_t)e * 1024 * 256, 256, ct * 64, 16, tile);
            continue;
        }
        idx -= nE;
        if (idx < nF) {
            const int which = idx >> 7, r2 = idx & 127, ct = r2 >> 5, kt = r2 & 31;
            prep_tile(p.in[which ? 13 : 10] + (size_t)layer * 2048 * 256, 256, kt * 64, ct * 64, 64, (u16*)(ws + OFF_W1T) + (size_t)which * 256 * 2048, 2048, ct * 64, 16, tile);
            continue;
        }
        idx -= nF;
        if (idx < nG) {
            const int which = idx >> 2, kt = idx & 3;
            prep_tile(p.in[which ? 14 : 11] + (size_t)layer * 256 * 64, 64, kt * 64, 0, 64, (u16*)(ws + OFF_W2T) + (size_t)which * 64 * 256, 256, 0, 16, tile);
            continue;
        }
        idx -= nG;
        if (idx < nH) {
            cvt16(p.in[22] + (size_t)layer * 65536 + (size_t)idx * 4096 + t * 16, (u16*)(ws + OFF_RW) + (size_t)idx * 4096 + t * 16);
            continue;
        }
        idx -= nH;
        if (idx < nI) {
            const float* pe = p.in[idx ? 12 : 9] + (size_t)layer * 2048;
            const float* w1 = p.in[idx ? 13 : 10] + (size_t)layer * 2048 * 256;
            float s = 0.f;
            for (int i = 0; i < 2048; ++i) s += pe[i] * w1[(size_t)i * 256 + t];
            ((float*)(ws + OFF_BIAS1))[idx * 256 + t] = s;
            continue;
        }
        idx -= nI;
        if (idx < nJ) {
            if (t < 128) ((unsigned*)(ws + OFF_CNT))[t] = 0u;
            u16* kcp = (u16*)(ws + OFF_KC) + (size_t)T_TOK * 64; u16* vcp = (u16*)(ws + OFF_VC) + (size_t)T_TOK * 64;
            for (int i = t; i < 1024; i += NTHR) { kcp[i] = 0; vcp[i] = 0; }
            continue;
        }
        idx -= nJ;
        cvt16(p.in[0] + (size_t)idx * 4096 + t * 16, (u16*)(ws + OFF_XB) + (size_t)idx * 4096 + t * 16);
    }
}

__device__ __forceinline__ void inproj_phase(const Params& p, int layer, unsigned char* smem) {
    u16* sA = (u16*)smem; u16* sB = sA + 128 * 72;
    unsigned char* ws = p.ws;
    const u16* XB = (const u16*)(ws + OFF_XB); const u16* WINT = (const u16*)(ws + OFF_WINT);
    u16* U = (u16*)(ws + OFF_U); u16* UT = (u16*)(ws + OFF_UT); u16* KC = (u16*)(ws + OFF_KC); u16* VC = (u16*)(ws + OFF_VC);
    const int lane = threadIdx.x & 63, wave = threadIdx.x >> 6, wm = wave >> 1, wn = wave & 1, fr = lane & 15, fg = lane >> 4;
    for (int it = blockIdx.x; it < 128 * 28; it += gridDim.x) {
        const int ft = it % 28, tt = it / 28;
        f32x4 acc[4][4]; zero_acc<4, 4>(acc);
        auto rowX = [=](int r) { return XB + (size_t)(tt * 128 + r) * 1024; };
        auto rowW = [=](int r) { return WINT + (size_t)(ft * 128 + r) * 1024; };
        if (ft < 20) {
            gemm_acc<4, 4>(acc, rowW, rowX, 1024, sA, sB);
#pragma unroll
            for (int i = 0; i < 4; ++i)
#pragma unroll
                for (int j = 0; j < 4; ++j) {
                    const int m = ft * 128 + wm * 64 + 16 * i + 4 * fg, n = tt * 128 + wn * 64 + 16 * j + fr;
                    const uint2 v = pack4(acc[i][j]);
                    if (ft == 17) {
                        const int f = m - 2176;
                        if (f < 64) *(uint2*)(KC + (size_t)n * 64 + f) = v; else *(uint2*)(VC + (size_t)n * 64 + (f - 64)) = v;
                    } else *(uint2*)(U + (size_t)n * LDU + m) = v;
                }
        } else {
            gemm_acc<4, 4>(acc, rowX, rowW, 1024, sA, sB);
#pragma unroll
            for (int i = 0; i < 4; ++i)
#pragma unroll
                for (int j = 0; j < 4; ++j) {
                    const int m = tt * 128 + wm * 64 + 16 * i + 4 * fg, n = ft * 128 + wn * 64 + 16 * j + fr;
                    const int trow = n - 2560, b = m >> 11, s = m & 2047;
                    f32x4 v = acc[i][j];
                    if (trow >= 128 && trow < 384) {
                        const int h = (trow - 128) >> 6; const float l2g = log2f(1.f - exp2f(-5.f - (float)h));
#pragma unroll
                        for (int r = 0; r < 4; ++r) v[r] *= 0.125f * exp2f((float)(127 - ((s + r) & 127)) * l2g);
                    }
                    *(uint2*)(UT + ((size_t)(b * 1024 + trow)) * 2048 + s) = pack4(v);
                }
        }
    }
}

__device__ __forceinline__ void compress_item(const Params& p, int item, unsigned char* smem) {
    unsigned char* ws = p.ws;
    u16* sA = (u16*)smem; u16* sB = sA + 128 * 72; u16* sH = sB + 64 * 72;
    const int which = item >> 4, r0 = (item & 15) * 64;
    const u16* src = (const u16*)(ws + (which ? OFF_VC : OFF_KC));
    const u16* W1 = (const u16*)(ws + OFF_W1T) + (size_t)which * 256 * 2048;
    const u16* W2 = (const u16*)(ws + OFF_W2T) + (size_t)which * 64 * 256;
    const float* bias = (const float*)(ws + OFF_BIAS1) + which * 256;
    const int t = tid_opaque();
    const int lane = t & 63, wave = t >> 6, wm = wave >> 1, wn = wave & 1, fr = lane & 15, fg = lane >> 4;
    for (int half = 0; half < 2; ++half) {
        f32x4 acc[4][2]; zero_acc<4, 2>(acc);
        auto rowW = [=](int r) { return W1 + (size_t)(half * 128 + r) * 2048; };
        auto rowA = [=](int r) { return src + (size_t)(r0 + r) * 1024; };
        gemm_acc<4, 2>(acc, rowW, rowA, 2048, sA, sB);
#pragma unroll
        for (int i = 0; i < 4; ++i)
#pragma unroll
            for (int j = 0; j < 2; ++j) {
                const int m = half * 128 + wm * 64 + 16 * i + 4 * fg, n = wn * 32 + 16 * j + fr;
                f32x4 v = acc[i][j];
#pragma unroll
                for (int r = 0; r < 4; ++r) { const float xx = v[r] + bias[m + r]; v[r] = 0.5f * xx * (1.f + erff(xx * 0.70710678118f)); }
                *(uint2*)&sH[n * 264 + m] = pack4(v);
            }
    }
    __syncthreads();
    f32x4 acc2[4];
#pragma unroll
    for (int nt = 0; nt < 4; ++nt) acc2[nt] = (f32x4){0.f, 0.f, 0.f, 0.f};
    if (which == 0) {
#pragma unroll
        for (int ks = 0; ks < 8; ++ks) {
            const bf16x8 a = *(const bf16x8*)(W2 + (size_t)(16 * wave + fr) * 256 + 32 * ks + 8 * fg);
#pragma unroll
            for (int nt = 0; nt < 4; ++nt) { const bf16x8 b = *(const bf16x8*)&sH[(16 * nt + fr) * 264 + 32 * ks + 8 * fg]; acc2[nt] = MFMA16(a, b, acc2[nt]); }
        }
        u16* KCMP = (u16*)(ws + OFF_KCMP);
#pragma unroll
        for (int nt = 0; nt < 4; ++nt) *(uint2*)(KCMP + (size_t)(r0 + 16 * nt + fr) * 64 + 16 * wave + 4 * fg) = pack4(acc2[nt]);
    } else {
#pragma unroll
        for (int ks = 0; ks < 8; ++ks) {
            const bf16x8 a = *(const bf16x8*)&sH[(16 * wave + fr) * 264 + 32 * ks + 8 * fg];
#pragma unroll
            for (int nt = 0; nt < 4; ++nt) { const bf16x8 b = *(const bf16x8*)(W2 + (size_t)(16 * nt + fr) * 256 + 32 * ks + 8 * fg); acc2[nt] = MFMA16(a, b, acc2[nt]); }
        }
        u16* VCMPT = (u16*)(ws + OFF_VCMPT);
        const int rg = r0 + 16 * wave + 4 * fg, bb = rg >> 7, ii = rg & 127;
#pragma unroll
        for (int nt = 0; nt < 4; ++nt) *(uint2*)(VCMPT + (size_t)(bb * 64 + 16 * nt + fr) * 128 + ii) = pack4(acc2[nt]);
    }
    __syncthreads();
}

__device__ __forceinline__ void retkv_item(const Params& p, int item) {
    unsigned char* ws = p.ws;
    const int bh = item >> 4, mc = item & 15, b = bh >> 2, h = bh & 3;
    const u16* Vt = (const u16*)(ws + OFF_UT) + ((size_t)(b * 1024 + 384 + h * 128)) * 2048 + mc * 128;
    const u16* Kt = (const u16*)(ws + OFF_UT) + ((size_t)(b * 1024 + 128 + h * 64)) * 2048 + mc * 128;
    const int t = tid_opaque();
    const int lane = t & 63, wave = t >> 6, fr = lane & 15, fg = lane >> 4;
    f32x4 acc[2][4]; zero_acc<2, 4>(acc);
#pragma unroll
    for (int ks = 0; ks < 4; ++ks) {
        bf16x8 a[2], bb[4];
#pragma unroll
        for (int mt = 0; mt < 2; ++mt) a[mt] = *(const bf16x8*)(Vt + (size_t)(32 * wave + 16 * mt + fr) * 2048 + 32 * ks + 8 * fg);
#pragma unroll
        for (int nt = 0; nt < 4; ++nt) bb[nt] = *(const bf16x8*)(Kt + (size_t)(16 * nt + fr) * 2048 + 32 * ks + 8 * fg);
#pragma unroll
        for (int mt = 0; mt < 2; ++mt)
#pragma unroll
            for (int nt = 0; nt < 4; ++nt) acc[mt][nt] = MFMA16(a[mt], bb[nt], acc[mt][nt]);
    }
    float* KVT = (float*)(ws + OFF_KVT) + (size_t)item * 8192;
#pragma unroll
    for (int mt = 0; mt < 2; ++mt)
#pragma unroll
        for (int nt = 0; nt < 4; ++nt)
#pragma unroll
            for (int r = 0; r < 4; ++r) KVT[(32 * wave + 16 * mt + 4 * fg + r) * 64 + 16 * nt + fr] = acc[mt][nt][r];
}

__device__ __forceinline__ void swa_item(const Params& p, int layer, int item, unsigned char* smem) {
    unsigned char* ws = p.ws;
    u16* sK = (u16*)smem; u16* sVt = sK + 64 * 72;
    const u16* U = (const u16*)(ws + OFF_U); const u16* UT = (const u16*)(ws + OFF_UT); u16* ACT = (u16*)(ws + OFF_ACT);
    const int b = item >> 7, h = (item >> 5) & 3, qb = item & 31, kvh = h >> 1;
    const int t = tid_opaque();
    const int lane = t & 63, wave = t >> 6, q = lane & 15, g = lane >> 4;
    const int tq = qb * 64 + wave * 16 + q; const size_t tglob = (size_t)b * 2048 + tq;
    bf16x8 qf[2];
#pragma unroll
    for (int ks = 0; ks < 2; ++ks) qf[ks] = *(const bf16x8*)(U + tglob * LDU + 512 + h * 64 + 32 * ks + 8 * g);
    const float slope = exp2f(-(float)(h + 1)); const float sink = p.in[6][layer * 4 + h];
    f32x4 o[4];
#pragma unroll
    for (int dt = 0; dt < 4; ++dt) o[dt] = (f32x4){0.f, 0.f, 0.f, 0.f};
    float m = NEGBIG, l = 0.f;
    const int kt0 = qb >= 2 ? qb - 2 : 0;
    for (int kt = kt0; kt <= qb; ++kt) {
        __syncthreads();
        stage_rows64(sK, U + ((size_t)b * 2048 + kt * 64) * LDU + 768 + kvh * 64, LDU);
        stage_rows64(sVt, UT + ((size_t)(b * 1024 + kvh * 64)) * 2048 + kt * 64, 2048);
        __syncthreads();
        flash_step<4>(sK, sVt, 72, qf, o, m, l, true,
                      [&](int key, float s, bool& valid) { const int d = tq - (kt * 64 + key); valid = (d >= 0) && (d < 128); return s * 0.125f - slope * (float)d; }, lane);
    }
    float lt = l + __shfl_xor(l, 16); lt += __shfl_xor(lt, 32);
    const float m2 = fmaxf(m, sink), sc = __expf(m - m2), den = lt * sc + __expf(sink - m2), inv = sc / fmaxf(den, 1e-30f);
#pragma unroll
    for (int dt = 0; dt < 4; ++dt) *(uint2*)(ACT + tglob * LDACT + 256 + h * 64 + 16 * dt + 4 * g) = pack4(o[dt] * inv);
    __syncthreads();
}

__device__ __forceinline__ void conv_item(const Params& p, int layer, int item, unsigned char* smem) {
    unsigned char* ws = p.ws;
    u16* sh = (u16*)smem; float* sy = (float*)(smem + 62 * 256 * 2);
    const u16* U = (const u16*)(ws + OFF_U); u16* ACT = (u16*)(ws + OFF_ACT);
    const int b = item >> 6, s0 = (item & 63) * 32, t = tid_opaque();
#pragma unroll 2
    for (int r = 0; r < 62; ++r) {
        const int sp = s0 - 30 + r; float hv = 0.f;
        if (sp >= 0) { const u16* row = U + ((size_t)b * 2048 + sp) * LDU; hv = bf2f(row[t]) * sigmoidf_(bf2f(row[256 + t])); }
        sh[r * 256 + t] = f2bf(hv);
    }
    __syncthreads();
    float w[31];
#pragma unroll
    for (int k = 0; k < 31; ++k) w[k] = p.in[2][(size_t)layer * 31 * 256 + k * 256 + t];
    const float db = p.in[3][layer * 256 + t];
#pragma unroll 1
    for (int tt = 0; tt < 32; ++tt) {
        float a = db;
#pragma unroll
        for (int k = 0; k < 31; ++k) a += bf2f(sh[(tt + k) * 256 + t]) * w[k];
        sy[tt * 256 + t] = a;
    }
    __syncthreads();
    const int lane = t & 63, wave = t >> 6, c = lane * 4;
    const float4 gg = *(const float4*)(p.in[4] + layer * 256 + c), bb = *(const float4*)(p.in[5] + layer * 256 + c);
    for (int i = 0; i < 8; ++i) {
        const int tt = wave * 8 + i;
        const float4 v = *(const float4*)&sy[tt * 256 + c];
        float s = v.x + v.y + v.z + v.w;
#pragma unroll
        for (int o = 32; o >= 1; o >>= 1) s += __shfl_xor(s, o);
        const float mu = s * (1.f / 256.f);
        const float dx = v.x - mu, dy = v.y - mu, dz = v.z - mu, dw = v.w - mu;
        float q = dx * dx + dy * dy + dz * dz + dw * dw;
#pragma unroll
        for (int o = 32; o >= 1; o >>= 1) q += __shfl_xor(q, o);
        const float rstd = rsqrtf(q * (1.f / 256.f) + LN_EPS_F);
        f32x4 ov; ov[0] = siluf_(dx * rstd * gg.x + bb.x); ov[1] = siluf_(dy * rstd * gg.y + bb.y); ov[2] = siluf_(dz * rstd * gg.z + bb.z); ov[3] = siluf_(dw * rstd * gg.w + bb.w);
        *(uint2*)(ACT + ((size_t)b * 2048 + s0 + tt) * LDACT + c) = pack4(ov);
    }
    __syncthreads();
}

#define FOR_ITEMS(j, base, n) for (int j = (int)((blockIdx.x + gridDim.x - ((base) % gridDim.x)) % gridDim.x); j < (n); j += gridDim.x)
__device__ __forceinline__ void p2a_phase(const Params& p, int layer, unsigned char* smem) {
    FOR_ITEMS(j, 0, 32) compress_item(p, j, smem);
    FOR_ITEMS(j, 32, 512) retkv_item(p, j);
    FOR_ITEMS(j, 544, 1024) swa_item(p, layer, j, smem);
    FOR_ITEMS(j, 1568, 512) conv_item(p, layer, j, smem);
}

__device__ __forceinline__ void retout_item(const Params& p, int layer, int item, unsigned char* smem) {
    unsigned char* ws = p.ws;
    u16* sS = (u16*)smem; u16* sK = sS + 128 * 72; u16* sVt = sK + 64 * 72;
    const u16* U = (const u16*)(ws + OFF_U); const u16* UT = (const u16*)(ws + OFF_UT); u16* ACT = (u16*)(ws + OFF_ACT);
    const int bh = item >> 4, n = item & 15, b = bh >> 2, h = bh & 3, t = tid_opaque();
    const float l2g = log2f(1.f - exp2f(-5.f - (float)h));
    {
        float as[32];
#pragma unroll
        for (int i = 0; i < 32; ++i) as[i] = 0.f;
        for (int mm = 0; mm < n; ++mm) {
            const float wgt = exp2f(128.f * (float)(n - 1 - mm) * l2g);
            const float4* src = (const float4*)((const float*)(ws + OFF_KVT) + (size_t)(bh * 16 + mm) * 8192 + t * 32);
#pragma unroll
            for (int i = 0; i < 8; ++i) { const float4 v = src[i]; as[4 * i] += wgt * v.x; as[4 * i + 1] += wgt * v.y; as[4 * i + 2] += wgt * v.z; as[4 * i + 3] += wgt * v.w; }
        }
        u16* dp = &sS[(t >> 1) * 72 + (t & 1) * 32];
#pragma unroll
        for (int i = 0; i < 4; ++i) *(uint4*)(dp + 8 * i) = make_uint4(pack2(as[8 * i], as[8 * i + 1]), pack2(as[8 * i + 2], as[8 * i + 3]), pack2(as[8 * i + 4], as[8 * i + 5]), pack2(as[8 * i + 6], as[8 * i + 7]));
    }
    __syncthreads();
    const int lane = t & 63, wave = t >> 6, q = lane & 15, g = lane >> 4;
    bf16x8 qf[2][2]; f32x4 o[2][8];
#pragma unroll
    for (int qt = 0; qt < 2; ++qt) {
        const size_t tglob = (size_t)b * 2048 + n * 128 + 32 * wave + 16 * qt + q;
#pragma unroll
        for (int ks = 0; ks < 2; ++ks) qf[qt][ks] = *(const bf16x8*)(U + tglob * LDU + 896 + h * 64 + 32 * ks + 8 * g);
#pragma unroll
        for (int dt = 0; dt < 8; ++dt) {
            o[qt][dt] = (f32x4){0.f, 0.f, 0.f, 0.f};
#pragma unroll
            for (int ks = 0; ks < 2; ++ks) { const bf16x8 a = *(const bf16x8*)&sS[(16 * dt + q) * 72 + 32 * ks + 8 * g]; o[qt][dt] = MFMA16(a, qf[qt][ks], o[qt][dt]); }
        }
        const float xi = exp2f((float)(32 * wave + 16 * qt + q + 1) * l2g);
#pragma unroll
        for (int dt = 0; dt < 8; ++dt) o[qt][dt] *= xi;
    }
    for (int kt = 0; kt < 2; ++kt) {
        __syncthreads();
        stage_rows64(sK, U + ((size_t)b * 2048 + n * 128 + kt * 64) * LDU + 1152 + h * 64, LDU);
        stage_rows64(sVt, UT + ((size_t)(b * 1024 + 384 + h * 128)) * 2048 + n * 128 + kt * 64, 2048);
        stage_rows64(sVt + 64 * 72, UT + ((size_t)(b * 1024 + 384 + h * 128 + 64)) * 2048 + n * 128 + kt * 64, 2048);
        __syncthreads();
#pragma unroll
        for (int qt = 0; qt < 2; ++qt) {
            if (kt * 64 > 32 * wave + 16 * qt + 15) continue;
            const int tql = 32 * wave + 16 * qt + q;
            f32x4 s[4]; qk64(sK, qf[qt], s, lane);
            float x[16];
#pragma unroll
            for (int mt = 0; mt < 4; ++mt)
#pragma unroll
                for (int rr = 0; rr < 4; ++rr) { const int d = tql - (kt * 64 + 16 * mt + 4 * g + rr); x[mt * 4 + rr] = (d >= 0) ? s[mt][rr] * 0.125f * exp2f((float)d * l2g) : 0.f; }
            bf16x8 pb[2]; pack_p(x, pb);
            pv64<8>(sVt, 72, pb, o[qt], lane);
        }
    }
#pragma unroll
    for (int qt = 0; qt < 2; ++qt) {
        const size_t tglob = (size_t)b * 2048 + n * 128 + 32 * wave + 16 * qt + q;
        float s = 0.f;
#pragma unroll
        for (int dt = 0; dt < 8; ++dt) s += o[qt][dt][0] + o[qt][dt][1] + o[qt][dt][2] + o[qt][dt][3];
        s += __shfl_xor(s, 16); s += __shfl_xor(s, 32);
        const float mu = s * (1.f / 128.f);
        float v = 0.f;
#pragma unroll
        for (int dt = 0; dt < 8; ++dt)
#pragma unroll
            for (int r = 0; r < 4; ++r) { const float d = o[qt][dt][r] - mu; v += d * d; }
        v += __shfl_xor(v, 16); v += __shfl_xor(v, 32);
        const float rstd = rsqrtf(v * (1.f / 128.f) + LN_EPS_F);
#pragma unroll
        for (int dt = 0; dt < 8; ++dt) {
            const int c = h * 128 + 16 * dt + 4 * g;
            const float4 gn = *(const float4*)(p.in[7] + layer * 512 + c), gb = *(const float4*)(p.in[8] + layer * 512 + c);
            const uint2 gv = *(const uint2*)(U + tglob * LDU + 1408 + c);
            f32x4 ov;
            ov[0] = ((o[qt][dt][0] - mu) * rstd * gn.x + gb.x) * siluf_(bflo(gv.x));
            ov[1] = ((o[qt][dt][1] - mu) * rstd * gn.y + gb.y) * siluf_(bfhi(gv.x));
            ov[2] = ((o[qt][dt][2] - mu) * rstd * gn.z + gb.z) * siluf_(bflo(gv.y));
            ov[3] = ((o[qt][dt][3] - mu) * rstd * gn.w + gb.w) * siluf_(bfhi(gv.y));
            *(uint2*)(ACT + tglob * LDACT + 512 + c) = pack4(ov);
        }
    }
    __syncthreads();
}

__device__ __forceinline__ void nsa_item(const Params& p, int item, unsigned char* smem) {
    unsigned char* ws = p.ws;
    u16* sKc = (u16*)smem;
    u16* sVc = sKc + 128 * 72;
    u16* sK = sVc + 64 * 136;
    u16* sVt = sK + 64 * 72;
    float* impL = (float*)(sVt + 64 * 72);
    unsigned* qmask = (unsigned*)(impL + 4 * 16 * 32);
    unsigned* wgor = qmask + 64;
    const u16* U = (const u16*)(ws + OFF_U); const u16* UT = (const u16*)(ws + OFF_UT); u16* ACT = (u16*)(ws + OFF_ACT);
    const int b = item >> 5, blk = item & 31, t = tid_opaque();
    const int lane = t & 63, wave = t >> 6, q = lane & 15, g = lane >> 4;
    const int tq = blk * 64 + wave * 16 + q; const size_t tglob = (size_t)b * 2048 + tq;
    __syncthreads();
    {
        const u16* kc = (const u16*)(ws + OFF_KCMP) + (size_t)b * 128 * 64;
        stage_rows64(sKc, kc, 64); stage_rows64(sKc + 64 * 72, kc + 64 * 64, 64);
        const u16* vc = (const u16*)(ws + OFF_VCMPT) + (size_t)b * 64 * 128;
        const int r = t >> 2, c = (t & 3) * 32;
        const uint4* src = (const uint4*)(vc + (size_t)r * 128 + c);
#pragma unroll
        for (int i = 0; i < 4; ++i) *(uint4*)&sVc[r * 136 + c + 8 * i] = src[i];
        if (t == 0) *wgor = 0u;
    }
    __syncthreads();
    const u16* qrow = U + tglob * LDU + 1920 + 8 * g;
    float impm[8], impc[8];
#pragma unroll
    for (int i = 0; i < 8; ++i) { impm[i] = 0.f; impc[i] = 0.f; }
#pragma unroll 1
    for (int h = 0; h < 4; ++h) {
        const float slope = exp2f(-(float)(h + 5));
        bf16x8 qh[2];
        qh[0] = *(const bf16x8*)(qrow + h * 64); qh[1] = *(const bf16x8*)(qrow + h * 64 + 32);
        f32x4 s0[4], s1[4]; qk64(sKc, qh, s0, lane); qk64(sKc + 64 * 72, qh, s1, lane);
        float x[32]; float mx = NEGBIG;
#pragma unroll
        for (int mt = 0; mt < 4; ++mt)
#pragma unroll
            for (int rr = 0; rr < 4; ++rr) {
                const int c0 = 16 * mt + 4 * g + rr, c1 = 64 + c0;
                const int d0 = tq - (16 * c0 + 31), d1 = tq - (16 * c1 + 31);
                const float v0 = d0 >= 0 ? s0[mt][rr] * 0.125f - slope * (float)d0 : NEGBIG;
                const float v1 = d1 >= 0 ? s1[mt][rr] * 0.125f - slope * (float)d1 : NEGBIG;
                x[mt * 4 + rr] = v0; x[16 + mt * 4 + rr] = v1; mx = fmaxf(mx, fmaxf(v0, v1));
            }
        mx = fmaxf(mx, __shfl_xor(mx, 16)); mx = fmaxf(mx, __shfl_xor(mx, 32));
        float ps = 0.f;
#pragma unroll
        for (int i = 0; i < 32; ++i) { const float pv = (x[i] > -1e29f) ? __expf(x[i] - mx) : 0.f; x[i] = pv; ps += pv; }
        ps += __shfl_xor(ps, 16); ps += __shfl_xor(ps, 32);
        const float inv = 1.f / fmaxf(ps, 1e-30f);
#pragma unroll
        for (int tm = 0; tm < 8; ++tm) {
            impm[tm] += (x[tm * 4] + x[tm * 4 + 1] + x[tm * 4 + 2] + x[tm * 4 + 3]) * inv;
            impc[tm] += x[tm * 4 + 3] * inv;
        }
    }
    float* myimp = impL + (wave * 16 + q) * 32;
#pragma unroll
    for (int tm = 0; tm < 8; ++tm) myimp[4 * tm + g] = impm[tm];
    __syncthreads();
#pragma unroll
    for (int tm = 0; tm < 8; ++tm) { const int j1 = 4 * tm + g + 1; if (j1 < 32) myimp[j1] += impc[tm]; }
    __syncthreads();
    if (g == 0) {
        const int cur = blk;
        for (int j = 0; j < 32; ++j) {
            float v = myimp[j];
            if (j == 0 || j == cur || j == cur - 1) v = 1e4f; else if (j > cur) v = -1.f;
            myimp[j] = v;
        }
        unsigned mask = 0u;
        for (int nsel = 0; nsel < 8; ++nsel) {
            float best = -3e38f; int bj = 0;
            for (int j = 0; j < 32; ++j) { const float v = myimp[j]; if (!((mask >> j) & 1u) && v > best) { best = v; bj = j; } }
            mask |= 1u << bj;
        }
        qmask[wave * 16 + q] = mask;
        atomicOr(wgor, mask);
    }
    __syncthreads();
    const unsigned mymask = qmask[wave * 16 + q];
    const unsigned allmask = *wgor;
    const int cur = blk;
#pragma unroll 1
    for (int h = 0; h < 4; ++h) {
        const float slope = exp2f(-(float)(h + 5));
        bf16x8 qh[2];
        qh[0] = *(const bf16x8*)(qrow + h * 64); qh[1] = *(const bf16x8*)(qrow + h * 64 + 32);
        const u16* grow = U + tglob * LDU + 2432;
        const float g0 = sigmoidf_(bf2f(grow[h])), g1 = sigmoidf_(bf2f(grow[4 + h])), g2 = sigmoidf_(bf2f(grow[8 + h]));
        f32x4 otot[4];
        {
            f32x4 o[4];
#pragma unroll
            for (int dt = 0; dt < 4; ++dt) o[dt] = (f32x4){0.f, 0.f, 0.f, 0.f};
            float m = NEGBIG, l = 0.f;
#pragma unroll
            for (int tile = 0; tile < 2; ++tile)
                flash_step<4>(sKc + tile * 64 * 72, sVc + tile * 64, 136, qh, o, m, l, true,
                              [&](int key, float s, bool& valid) { const int d = tq - (16 * (tile * 64 + key) + 31); valid = d >= 0; return s * 0.125f - slope * (float)d; }, lane);
            float lt = l + __shfl_xor(l, 16); lt += __shfl_xor(lt, 32);
            const float sc = g0 / fmaxf(lt, 1e-30f);
#pragma unroll
            for (int dt = 0; dt < 4; ++dt) otot[dt] = o[dt] * sc;
        }
        {
            f32x4 o[4];
#pragma unroll
            for (int dt = 0; dt < 4; ++dt) o[dt] = (f32x4){0.f, 0.f, 0.f, 0.f};
            float m = NEGBIG, l = 0.f;
            for (int j = 0; j <= cur; ++j) {
                if (!((allmask >> j) & 1u)) continue;
                __syncthreads();
                stage_rows64(sK, U + ((size_t)b * 2048 + j * 64) * LDU + 2304, LDU);
                stage_rows64(sVt, UT + ((size_t)(b * 1024 + 896)) * 2048 + j * 64, 2048);
                __syncthreads();
                flash_step<4>(sK, sVt, 72, qh, o, m, l, ((mymask >> j) & 1u) != 0u,
                              [&](int key, float s, bool& valid) { const int d = tq - (j * 64 + key); valid = d >= 0; return s * 0.125f - slope * (float)d; }, lane);
            }
            float lt = l + __shfl_xor(l, 16); lt += __shfl_xor(lt, 32);
            const float sc = g1 / fmaxf(lt, 1e-30f);
#pragma unroll
            for (int dt = 0; dt < 4; ++dt) otot[dt] += o[dt] * sc;
        }
        {
            f32x4 o[4];
#pragma unroll
            for (int dt = 0; dt < 4; ++dt) o[dt] = (f32x4){0.f, 0.f, 0.f, 0.f};
            float m = NEGBIG, l = 0.f;
            const int kt0 = cur >= 8 ? cur - 8 : 0;
            for (int kt = kt0; kt <= cur; ++kt) {
                __syncthreads();
                stage_rows64(sK, U + ((size_t)b * 2048 + kt * 64) * LDU + 2368, LDU);
                stage_rows64(sVt, UT + ((size_t)(b * 1024 + 960)) * 2048 + kt * 64, 2048);
                __syncthreads();
                flash_step<4>(sK, sVt, 72, qh, o, m, l, true,
                              [&](int key, float s, bool& valid) { const int d = tq - (kt * 64 + key); valid = (d >= 0) && (d < 512); return s * 0.125f - slope * (float)d; }, lane);
            }
            float lt = l + __shfl_xor(l, 16); lt += __shfl_xor(lt, 32);
            const float sc = g2 / fmaxf(lt, 1e-30f);
#pragma unroll
            for (int dt = 0; dt < 4; ++dt) otot[dt] += o[dt] * sc;
        }
#pragma unroll
        for (int dt = 0; dt < 4; ++dt) *(uint2*)(ACT + tglob * LDACT + 1024 + h * 64 + 16 * dt + 4 * g) = pack4(otot[dt]);
    }
    __syncthreads();
}

__device__ __forceinline__ void p2b_phase(const Params& p, int layer, unsigned char* smem) {
    FOR_ITEMS(j, 0, 256) nsa_item(p, j, smem);
    FOR_ITEMS(j, 256, 512) retout_item(p, layer, j, smem);
}

__device__ __forceinline__ void merge_phase(const Params& p, unsigned char* smem) {
    unsigned char* ws = p.ws;
    u16* sA = (u16*)smem; u16* sB = sA + 64 * 72;
    const u16* XB = (const u16*)(ws + OFF_XB); const u16* WINT = (const u16*)(ws + OFF_WINT); const u16* PT = (const u16*)(ws + OFF_PT);
    const u16* ACT = (const u16*)(ws + OFF_ACT); u16* MERGED = (u16*)(ws + OFF_MERGED);
    const int lane = threadIdx.x & 63, wave = threadIdx.x >> 6, wm = wave >> 1, wn = wave & 1, fr = lane & 15, fg = lane >> 4;
    for (int it = blockIdx.x; it < 128 * 16; it += gridDim.x) {
        const int ct = it & 15, tt = it >> 4;
        f32x4 accm[2][4]; zero_acc<2, 4>(accm);
        auto rowX = [=](int r) { return XB + (size_t)(tt * 128 + r) * 1024; };
#pragma unroll 1
        for (int br = 0; br < 4; ++br) {
            const int Kb = (br == 2) ? 512 : 256;
            const size_t poff = (br == 0) ? 0 : (br == 1) ? 262144 : (br == 2) ? 524288 : 1048576;
            const int aoff = (br == 0) ? 0 : (br == 1) ? 256 : (br == 2) ? 512 : 1024;
            f32x4 accg[2][4]; zero_acc<2, 4>(accg);
            auto rowWg = [=](int r) { return WINT + (size_t)(3584 + br * 1024 + ct * 64 + r) * 1024; };
            gemm_acc<2, 4>(accg, rowWg, rowX, 1024, sA, sB);
#pragma unroll
            for (int i = 0; i < 2; ++i)
#pragma unroll
                for (int j = 0; j < 4; ++j)
#pragma unroll
                    for (int r = 0; r < 4; ++r) accg[i][j][r] = sigmoidf_(accg[i][j][r]);
            f32x4 accy[2][4]; zero_acc<2, 4>(accy);
            auto rowP = [=](int r) { return PT + poff + (size_t)(ct * 64 + r) * Kb; };
            auto rowAct = [=](int r) { return ACT + (size_t)(tt * 128 + r) * LDACT + aoff; };
            gemm_acc<2, 4>(accy, rowP, rowAct, Kb, sA, sB);
#pragma unroll
            for (int i = 0; i < 2; ++i)
#pragma unroll
                for (int j = 0; j < 4; ++j) accm[i][j] += accg[i][j] * accy[i][j];
        }
#pragma unroll
        for (int i = 0; i < 2; ++i)
#pragma unroll
            for (int j = 0; j < 4; ++j) {
                const int m = ct * 64 + wm * 32 + 16 * i + 4 * fg, n = tt * 128 + wn * 64 + 16 * j + fr;
                *(uint2*)(MERGED + (size_t)n * 1024 + m) = pack4(accm[i][j]);
            }
    }
}

__device__ __forceinline__ void wout_phase(const Params& p, unsigned char* smem) {
    unsigned char* ws = p.ws;
    u16* sA = (u16*)smem; u16* sB = sA + 128 * 72;
    const u16* XB = (const u16*)(ws + OFF_XB); const u16* WOUT = (const u16*)(ws + OFF_WOUT); const u16* MERGED = (const u16*)(ws + OFF_MERGED);
    u16* Z = (u16*)(ws + OFF_Z);
    const int lane = threadIdx.x & 63, wave = threadIdx.x >> 6, wm = wave >> 1, wn = wave & 1, fr = lane & 15, fg = lane >> 4;
    for (int it = blockIdx.x; it < 128 * 8; it += gridDim.x) {
        const int ct = it & 7, tt = it >> 3;
        f32x4 acc[4][4]; zero_acc<4, 4>(acc);
        auto rowW = [=](int r) { return WOUT + (size_t)(ct * 128 + r) * 1024; };
        auto rowM = [=](int r) { return MERGED + (size_t)(tt * 128 + r) * 1024; };
        gemm_acc<4, 4>(acc, rowW, rowM, 1024, sA, sB);
#pragma unroll
        for (int i = 0; i < 4; ++i)
#pragma unroll
            for (int j = 0; j < 4; ++j) {
                const int m = ct * 128 + wm * 64 + 16 * i + 4 * fg, n = tt * 128 + wn * 64 + 16 * j + fr;
                const uint2 xv = *(const uint2*)(XB + (size_t)n * 1024 + m);
                f32x4 v = acc[i][j];
                v[0] += ALPHA_F * bflo(xv.x); v[1] += ALPHA_F * bfhi(xv.x); v[2] += ALPHA_F * bflo(xv.y); v[3] += ALPHA_F * bfhi(xv.y);
                *(uint2*)(Z + (size_t)n * 1024 + m) = pack4(v);
            }
    }
}

__device__ __forceinline__ void ln_row16(float (&v)[16], const float* gam, const float* bet, int lane) {
    float s = 0.f;
#pragma unroll
    for (int i = 0; i < 16; ++i) s += v[i];
#pragma unroll
    for (int o = 32; o >= 1; o >>= 1) s += __shfl_xor(s, o);
    const float mu = s * (1.f / 1024.f);
    float q = 0.f;
#pragma unroll
    for (int i = 0; i < 16; ++i) { v[i] -= mu; q += v[i] * v[i]; }
#pragma unroll
    for (int o = 32; o >= 1; o >>= 1) q += __shfl_xor(q, o);
    const float rstd = rsqrtf(q * (1.f / 1024.f) + LN_EPS_F);
#pragma unroll
    for (int hh = 0; hh < 2; ++hh) {
        const int c = hh * 512 + lane * 8;
        const float4 g0 = *(const float4*)(gam + c), g1 = *(const float4*)(gam + c + 4), b0 = *(const float4*)(bet + c), b1 = *(const float4*)(bet + c + 4);
        v[8 * hh + 0] = v[8 * hh + 0] * rstd * g0.x + b0.x; v[8 * hh + 1] = v[8 * hh + 1] * rstd * g0.y + b0.y;
        v[8 * hh + 2] = v[8 * hh + 2] * rstd * g0.z + b0.z; v[8 * hh + 3] = v[8 * hh + 3] * rstd * g0.w + b0.w;
        v[8 * hh + 4] = v[8 * hh + 4] * rstd * g1.x + b1.x; v[8 * hh + 5] = v[8 * hh + 5] * rstd * g1.y + b1.y;
        v[8 * hh + 6] = v[8 * hh + 6] * rstd * g1.z + b1.z; v[8 * hh + 7] = v[8 * hh + 7] * rstd * g1.w + b1.w;
    }
}
__device__ __forceinline__ void unpack8(const uint4 w, float* v) {
    v[0] = bflo(w.x); v[1] = bfhi(w.x); v[2] = bflo(w.y); v[3] = bfhi(w.y); v[4] = bflo(w.z); v[5] = bfhi(w.z); v[6] = bflo(w.w); v[7] = bfhi(w.w);
}

__device__ __forceinline__ void router_phase(const Params& p, int layer, unsigned char* smem) {
    unsigned char* ws = p.ws;
    u16* sA = (u16*)smem; u16* sB = sA + 128 * 72; float* L = (float*)smem;
    const u16* Z = (const u16*)(ws + OFF_Z); u16* XB = (u16*)(ws + OFF_XB); const u16* RW = (const u16*)(ws + OFF_RW);
    unsigned* cnt = (unsigned*)(ws + OFF_CNT); unsigned* LIST = (unsigned*)(ws + OFF_LIST); float* GATEW = (float*)(ws + OFF_GATEW);
    const float* gam = p.in[20] + layer * 1024; const float* bet = p.in[21] + layer * 1024; const float* rbias = p.in[23] + layer * 64;
    const int t = threadIdx.x, lane = t & 63, wave = t >> 6, wm = wave >> 1, wn = wave & 1, fr = lane & 15, fg = lane >> 4;
    for (int tt = blockIdx.x; tt < 128; tt += gridDim.x) {
        for (int i = 0; i < 32; ++i) {
            const size_t row = (size_t)tt * 128 + wave * 32 + i;
            float v[16];
            unpack8(*(const uint4*)(Z + row * 1024 + lane * 8), v); unpack8(*(const uint4*)(Z + row * 1024 + 512 + lane * 8), v + 8);
            ln_row16(v, gam, bet, lane);
            *(uint4*)(XB + row * 1024 + lane * 8) = make_uint4(pack2(v[0], v[1]), pack2(v[2], v[3]), pack2(v[4], v[5]), pack2(v[6], v[7]));
            *(uint4*)(XB + row * 1024 + 512 + lane * 8) = make_uint4(pack2(v[8], v[9]), pack2(v[10], v[11]), pack2(v[12], v[13]), pack2(v[14], v[15]));
        }
        __threadfence_block();
        __syncthreads();
        f32x4 acc[4][4]; zero_acc<4, 4>(acc);
        auto rowR = [=](int r) { return RW + (size_t)(r & 63) * 1024; };
        auto rowX = [=](int r) { return (const u16*)XB + (size_t)(tt * 128 + r) * 1024; };
        gemm_acc<4, 4>(acc, rowR, rowX, 1024, sA, sB);
        __syncthreads();
        if (wm == 0) {
#pragma unroll
            for (int i = 0; i < 4; ++i)
#pragma unroll
                for (int j = 0; j < 4; ++j)
#pragma unroll
                    for (int r = 0; r < 4; ++r) L[(wn * 64 + 16 * j + fr) * 65 + 16 * i + 4 * fg + r] = acc[i][j][r];
        }
        __syncthreads();
        if (t < 128) {
            float* Lr = L + t * 65;
            for (int e = 0; e < 64; ++e) Lr[e] = sigmoidf_(Lr[e]) + rbias[e];
            float gs[8];
#pragma unroll
            for (int gI = 0; gI < 8; ++gI) {
                float m1 = -3e38f, m2 = -3e38f;
#pragma unroll
                for (int k = 0; k < 8; ++k) { const float v = Lr[gI * 8 + k]; if (v > m1) { m2 = m1; m1 = v; } else if (v > m2) m2 = v; }
                gs[gI] = m1 + m2;
            }
            unsigned gmask = 0u;
#pragma unroll
            for (int nsel = 0; nsel < 4; ++nsel) {
                float best = -3e38f; int bi = 0;
#pragma unroll
                for (int gI = 0; gI < 8; ++gI) if (!((gmask >> gI) & 1u) && gs[gI] > best) { best = gs[gI]; bi = gI; }
                gmask |= 1u << bi;
            }
            unsigned long long chosen = 0ull; int eidx[6]; float sraw[6]; float ssum = 0.f;
#pragma unroll
            for (int k = 0; k < 6; ++k) {
                float best = -3e38f; int be = 0;
                for (int e = 0; e < 64; ++e) {
                    if (((gmask >> (e >> 3)) & 1u) && !((chosen >> e) & 1ull)) { const float v = Lr[e]; if (v > best) { best = v; be = e; } }
                }
                chosen |= 1ull << be; eidx[k] = be; sraw[k] = best - rbias[be]; ssum += sraw[k];
            }
            const unsigned tok = (unsigned)(tt * 128 + t);
#pragma unroll
            for (int k = 0; k < 6; ++k) {
                const unsigned pos = atomicAdd(&cnt[eidx[k]], 1u);
                LIST[(size_t)eidx[k] * 16384 + pos] = tok * 8u + (unsigned)k;
                GATEW[tok * 8u + k] = sraw[k] / ssum * 2.5f;
            }
        }
        __syncthreads();
    }
}

__device__ __forceinline__ void moe_prefix(const Params& p, int* pre) {
    if (threadIdx.x == 0) {
        const unsigned* cnt = (const unsigned*)(p.ws + OFF_CNT);
        int a = 0;
        for (int e = 0; e < 64; ++e) { pre[e] = a; a += (int)((cnt[e] + 127u) >> 7); }
        pre[64] = a; a += 128; pre[65] = a;
    }
    __syncthreads();
}

__device__ __forceinline__ void moe_up_phase(const Params& p, unsigned char* smem) {
    unsigned char* ws = p.ws;
    u16* sA = (u16*)smem; u16* sB = sA + 128 * 72; int* pre = (int*)(smem + SMEM_PRE_OFF);
    const u16* XB = (const u16*)(ws + OFF_XB); const u16* WUP = (const u16*)(ws + OFF_WUP); u16* H = (u16*)(ws + OFF_H);
    const unsigned* cnt = (const unsigned*)(ws + OFF_CNT); const unsigned* LIST = (const unsigned*)(ws + OFF_LIST);
    const int lane = threadIdx.x & 63, wave = threadIdx.x >> 6, wm = wave >> 1, wn = wave & 1, fr = lane & 15, fg = lane >> 4;
    moe_prefix(p, pre);
    const int total = pre[65] * 4;
    for (int it = blockIdx.x; it < total; it += gridDim.x) {
        const int bi = it >> 2, nt = it & 3;
        int e = 0; while (pre[e + 1] <= bi) ++e;
        const int rb = bi - pre[e]; const int ce = (e < 64) ? (int)cnt[e] : T_TOK;
        f32x4 acc[4][4]; zero_acc<4, 4>(acc);
        auto rowW = [=](int r) { return WUP + ((size_t)e * 512 + nt * 128 + r) * 1024; };
        auto rowX = [=](int r) {
            const int idx = rb * 128 + r; unsigned tok = 0u;
            if (idx < ce) tok = (e < 64) ? (LIST[(size_t)e * 16384 + idx] >> 3) : (unsigned)idx;
            return XB + (size_t)tok * 1024;
        };
        gemm_acc<4, 4>(acc, rowW, rowX, 1024, sA, sB);
        const size_t hrow0 = (size_t)pre[e] * 128 + (size_t)rb * 128;
#pragma unroll
        for (int i = 0; i < 4; i += 2)
#pragma unroll
            for (int j = 0; j < 4; ++j) {
                const int n = wn * 64 + 16 * j + fr;
                const int col = 16 * ((nt * 8 + wm * 4 + i) >> 1) + 4 * fg;
                f32x4 v;
#pragma unroll
                for (int r = 0; r < 4; ++r) v[r] = siluf_(acc[i][j][r]) * acc[i + 1][j][r];
                *(uint2*)(H + (hrow0 + n) * 256 + col) = pack4(v);
            }
    }
}

__device__ __forceinline__ void moe_down_phase(const Params& p, unsigned char* smem) {
    unsigned char* ws = p.ws;
    u16* sA = (u16*)smem; u16* sB = sA + 128 * 72; int* pre = (int*)(smem + SMEM_PRE_OFF);
    const u16* XB = (const u16*)(ws + OFF_XB); const u16* WD = (const u16*)(ws + OFF_WD); const u16* H = (const u16*)(ws + OFF_H);
    u16* Z = (u16*)(ws + OFF_Z); u16* YS = (u16*)(ws + OFF_YSLOT);
    const unsigned* cnt = (const unsigned*)(ws + OFF_CNT); const unsigned* LIST = (const unsigned*)(ws + OFF_LIST); const float* GATEW = (const float*)(ws + OFF_GATEW);
    const int lane = threadIdx.x & 63, wave = threadIdx.x >> 6, wm = wave >> 1, wn = wave & 1, fr = lane & 15, fg = lane >> 4;
    moe_prefix(p, pre);
    const int total = pre[65] * 8;
    for (int it = blockIdx.x; it < total; it += gridDim.x) {
        const int bi = it >> 3, nt = it & 7;
        int e = 0; while (pre[e + 1] <= bi) ++e;
        const int rb = bi - pre[e]; const int ce = (e < 64) ? (int)cnt[e] : T_TOK;
        const size_t hrow0 = (size_t)pre[e] * 128 + (size_t)rb * 128;
        f32x4 acc[4][4]; zero_acc<4, 4>(acc);
        auto rowW = [=](int r) { return WD + ((size_t)e * 1024 + nt * 128 + r) * 256; };
        auto rowH = [=](int r) { return H + (hrow0 + r) * 256; };
        gemm_acc<4, 4>(acc, rowW, rowH, 256, sA, sB);
#pragma unroll
        for (int j = 0; j < 4; ++j) {
            const int n = wn * 64 + 16 * j + fr, idx = rb * 128 + n;
            if (idx < ce) {
                if (e < 64) {
                    const unsigned ent = LIST[(size_t)e * 16384 + idx]; const float gw = GATEW[ent];
                    u16* dst = YS + ((size_t)(ent >> 3) * 6 + (ent & 7u)) * 1024 + nt * 128 + wm * 64 + 4 * fg;
#pragma unroll
                    for (int i = 0; i < 4; ++i) *(uint2*)(dst + 16 * i) = pack4(acc[i][j] * gw);
                } else {
                    const size_t o = (size_t)idx * 1024 + nt * 128 + wm * 64 + 4 * fg;
#pragma unroll
                    for (int i = 0; i < 4; ++i) {
                        const uint2 xv = *(const uint2*)(XB + o + 16 * i);
                        f32x4 v = acc[i][j];
                        v[0] += ALPHA_F * bflo(xv.x); v[1] += ALPHA_F * bfhi(xv.x); v[2] += ALPHA_F * bflo(xv.y); v[3] += ALPHA_F * bfhi(xv.y);
                        *(uint2*)(Z + o + 16 * i) = pack4(v);
                    }
                }
            }
        }
    }
}

__device__ __forceinline__ void combine_phase(const Params& p, int layer) {
    unsigned char* ws = p.ws;
    const u16* Z = (const u16*)(ws + OFF_Z); const u16* YS = (const u16*)(ws + OFF_YSLOT); u16* XB = (u16*)(ws + OFF_XB);
    const float* gam = p.in[30] + layer * 1024; const float* bet = p.in[31] + layer * 1024;
    const int t = threadIdx.x, lane = t & 63, wave = t >> 6;
    for (int it = blockIdx.x; it < 512; it += gridDim.x) {
        for (int i = 0; i < 8; ++i) {
            const size_t row = (size_t)it * 32 + wave * 8 + i;
            float v[16];
            unpack8(*(const uint4*)(Z + row * 1024 + lane * 8), v); unpack8(*(const uint4*)(Z + row * 1024 + 512 + lane * 8), v + 8);
#pragma unroll
            for (int k = 0; k < 6; ++k) {
                float y[16];
                unpack8(*(const uint4*)(YS + (row * 6 + k) * 1024 + lane * 8), y); unpack8(*(const uint4*)(YS + (row * 6 + k) * 1024 + 512 + lane * 8), y + 8);
#pragma unroll
                for (int c = 0; c < 16; ++c) v[c] += y[c];
            }
            ln_row16(v, gam, bet, lane);
            *(uint4*)(XB + row * 1024 + lane * 8) = make_uint4(pack2(v[0], v[1]), pack2(v[2], v[3]), pack2(v[4], v[5]), pack2(v[6], v[7]));
            *(uint4*)(XB + row * 1024 + 512 + lane * 8) = make_uint4(pack2(v[8], v[9]), pack2(v[10], v[11]), pack2(v[12], v[13]), pack2(v[14], v[15]));
            if (layer == 1) {
                float* op = p.out + row * 1024;
                *(float4*)(op + lane * 8) = make_float4(v[0], v[1], v[2], v[3]); *(float4*)(op + lane * 8 + 4) = make_float4(v[4], v[5], v[6], v[7]);
                *(float4*)(op + 512 + lane * 8) = make_float4(v[8], v[9], v[10], v[11]); *(float4*)(op + 512 + lane * 8 + 4) = make_float4(v[12], v[13], v[14], v[15]);
            }
        }
    }
}

__device__ __forceinline__ void run_phase(const Params& p, int ph, int layer, unsigned char* smem) {
    switch (ph) {
        case 0: prep_phase(p, layer, layer == 0, smem); break;
        case 1: inproj_phase(p, layer, smem); break;
        case 2: p2a_phase(p, layer, smem); break;
        case 3: p2b_phase(p, layer, smem); break;
        case 4: merge_phase(p, smem); break;
        case 5: wout_phase(p, smem); break;
        case 6: router_phase(p, layer, smem); break;
        case 7: moe_up_phase(p, smem); break;
        case 8: moe_down_phase(p, smem); break;
        default: combine_phase(p, layer); if (layer == 0) prep_phase(p, 1, false, smem); break;
    }
}

#if !ONE_LAUNCH
template <int PH> __global__ void __launch_bounds__(NTHR, 2) k_phase(Params p, int layer) {
    __shared__ __attribute__((aligned(16))) unsigned char smem[SMEM_BYTES];
    run_phase(p, PH, layer, smem);
}
#endif

extern "C" void kernel_launch(void* const* d_in, const int* in_sizes, int n_in, void* d_out, int out_size, void* d_ws, size_t ws_size, hipStream_t stream) {
    if (ws_size < WS_TOTAL) { fprintf(stderr, "kernel_launch: workspace too small: %zu < %zu\n", ws_size, (size_t)WS_TOTAL); return; }
    Params p{};
    for (int i = 0; i < 32; ++i) p.in[i] = (const float*)d_in[i];
    p.out = (float*)d_out; p.ws = (unsigned char*)d_ws;
    hipMemsetAsync((char*)d_ws + OFF_BAR, 0, 16384, stream);
#if !ONE_LAUNCH
    const int G = 512;
    hipLaunchKernelGGL(k_phase<0>, dim3(G), dim3(NTHR), 0, stream, p, 0);
    for (int layer = 0; layer < 2; ++layer) {
        hipLaunchKernelGGL(k_phase<1>, dim3(G), dim3(NTHR), 0, stream, p, layer);
        hipLaunchKernelGGL(k_phase<2>, dim3(G), dim3(NTHR), 0, stream, p, layer);
        hipLaunchKernelGGL(k_phase<3>, dim3(G), dim3(NTHR), 0, stream, p, layer);
        hipLaunchKernelGGL(k_phase<4>, dim3(G), dim3(NTHR), 0, stream, p, layer);
        hipLaunchKernelGGL(k_phase<5>, dim3(G), dim3(NTHR), 0, stream, p, layer);
        hipLaunchKernelGGL(k_phase<6>, dim3(G), dim3(NTHR), 0, stream, p, layer);
        hipLaunchKernelGGL(k_phase<7>, dim3(G), dim3(NTHR), 0, stream, p, layer);
        hipLaunchKernelGGL(k_phase<8>, dim3(G), dim3(NTHR), 0, stream, p, layer);
        hipLaunchKernelGGL(k_phase<9>, dim3(G), dim3(NTHR), 0, stream, p, layer);
    }
#endif
}
```

```cpp
#include <hip/hip_runtime.h>
#include <stdint.h>
#include <stdio.h>

#ifndef ONE_LAUNCH
#define ONE_LAUNCH 1
#endif

typedef unsigned short u16;
typedef short bf16x8 __attribute__((ext_vector_type(8)));
typedef short bf16x4 __attribute__((ext_vector_type(4)));
typedef float f32x4 __attribute__((ext_vector_type(4)));
typedef unsigned u32x4 __attribute__((ext_vector_type(4)));
typedef unsigned u32x2 __attribute__((ext_vector_type(2)));

#define NTHR 256
#define T_TOK 16384
#define SEQ 2048
#define DM 1024
#define ALPHA_F 1.41421356237f
#define LN_EPS_F 1e-5f
#define NEGBIG (-1e30f)
#define LDU 2560
#define LDACT 1280
#define SMEM_BYTES 65536
#define SMEM_PRE_OFF 61440
#define SMEM_BAR_OFF 65520

struct Params { const float* in[32]; float* out; unsigned char* ws; };

constexpr size_t al256(size_t x) { return (x + 255) & ~(size_t)255; }
constexpr size_t OFF_BAR   = 0;
constexpr size_t OFF_CNT   = 16384;
constexpr size_t OFF_BIAS1 = OFF_CNT + 1024;
constexpr size_t OFF_XB    = 32768;
constexpr size_t SZ_TD     = (size_t)T_TOK * 1024 * 2;
constexpr size_t OFF_Z     = OFF_XB + SZ_TD;
constexpr size_t OFF_A     = OFF_Z + SZ_TD;
constexpr size_t OFF_U     = OFF_A;
constexpr size_t SZ_U      = (size_t)T_TOK * LDU * 2;
constexpr size_t OFF_UT    = OFF_U + SZ_U;
constexpr size_t SZ_UT     = (size_t)8 * 1024 * 2048 * 2;
constexpr size_t SZ_A      = (size_t)T_TOK * 6 * 1024 * 2;
static_assert(SZ_A >= SZ_U + SZ_UT, "region A");
constexpr size_t OFF_YSLOT = OFF_A;
constexpr size_t OFF_B     = OFF_A + SZ_A;
constexpr size_t OFF_ACT   = OFF_B;
constexpr size_t SZ_ACT    = (size_t)T_TOK * LDACT * 2;
constexpr size_t OFF_MERGED= OFF_ACT + SZ_ACT;
constexpr size_t SZ_B      = SZ_ACT + SZ_TD;
constexpr size_t OFF_H     = OFF_B;
static_assert(SZ_B >= (size_t)(98304 + 64 * 127 + 16384 + 128) * 256 * 2, "region B");
constexpr size_t OFF_KC    = OFF_B + SZ_B;
constexpr size_t SZ_KC     = al256(((size_t)T_TOK * 64 + 1024) * 2);
constexpr size_t OFF_VC    = OFF_KC + SZ_KC;
constexpr size_t OFF_KCMP  = OFF_VC + SZ_KC;
constexpr size_t OFF_VCMPT = OFF_KCMP + 1024 * 64 * 2;
constexpr size_t OFF_KVT   = OFF_VCMPT + 8 * 64 * 128 * 2;
constexpr size_t OFF_LIST  = OFF_KVT + (size_t)512 * 8192 * 4;
constexpr size_t OFF_GATEW = OFF_LIST + (size_t)64 * 16384 * 4;
constexpr size_t OFF_WINT  = OFF_GATEW + (size_t)T_TOK * 8 * 4;
constexpr size_t OFF_PT    = OFF_WINT + (size_t)7680 * 1024 * 2;
constexpr size_t OFF_WOUT  = OFF_PT + (size_t)1280 * 1024 * 2;
constexpr size_t OFF_RW    = OFF_WOUT + (size_t)1024 * 1024 * 2;
constexpr size_t OFF_WUP   = OFF_RW + (size_t)64 * 1024 * 2;
constexpr size_t OFF_WD    = OFF_WUP + (size_t)65 * 512 * 1024 * 2;
constexpr size_t OFF_W1T   = OFF_WD + (size_t)65 * 1024 * 256 * 2;
constexpr size_t OFF_W2T   = OFF_W1T + (size_t)2 * 256 * 2048 * 2;
constexpr size_t WS_TOTAL  = OFF_W2T + (size_t)2 * 64 * 256 * 2;

#define MFMA16(a, b, c) __builtin_amdgcn_mfma_f32_16x16x32_bf16((a), (b), (c), 0, 0, 0)

__device__ __forceinline__ u16 f2bf(float f) { uint32_t u = __float_as_uint(f); u += 0x7fffu + ((u >> 16) & 1u); return (u16)(u >> 16); }
__device__ __forceinline__ float bf2f(u16 h) { return __uint_as_float(((uint32_t)h) << 16); }
__device__ __forceinline__ uint32_t pack2(float a, float b) { return (uint32_t)f2bf(a) | ((uint32_t)f2bf(b) << 16); }
__device__ __forceinline__ uint2 pack4(f32x4 v) { return make_uint2(pack2(v[0], v[1]), pack2(v[2], v[3])); }
__device__ __forceinline__ float sigmoidf_(float x) { return 1.f / (1.f + __expf(-x)); }
__device__ __forceinline__ float siluf_(float x) { return x / (1.f + __expf(-x)); }
__device__ __forceinline__ float bflo(uint32_t w) { return __uint_as_float(w << 16); }
__device__ __forceinline__ float bfhi(uint32_t w) { return __uint_as_float(w & 0xffff0000u); }

__device__ __forceinline__ int tid_opaque() { int t = threadIdx.x; asm volatile("" : "+v"(t)); return t; }
__device__ __forceinline__ unsigned char* ws_opaque(unsigned char* w) {
    unsigned lo = (unsigned)(uintptr_t)w, hi = (unsigned)((uintptr_t)w >> 32);
    asm volatile("" : "+v"(lo), "+v"(hi));
    lo = __builtin_amdgcn_readfirstlane(lo); hi = __builtin_amdgcn_readfirstlane(hi);
    return (unsigned char*)(((uintptr_t)hi << 32) | (uintptr_t)lo);
}

template <int WM, int WN> __device__ __forceinline__ void zero_acc(f32x4 (&acc)[WM][WN]) {
#pragma unroll
    for (int i = 0; i < WM; ++i)
#pragma unroll
        for (int j = 0; j < WN; ++j) acc[i][j] = (f32x4){0.f, 0.f, 0.f, 0.f};
}

template <int WM, int WN, class FA, class FB>
__device__ __forceinline__ void gemm_acc(f32x4 (&acc)[WM][WN], FA rowA, FB rowB, int K, u16* sA, u16* sB) {
    const int tid = tid_opaque(), lane = tid & 63, wave = tid >> 6;
    const int wm = wave >> 1, wn = wave & 1;
    const int lr = tid >> 3, lc = (tid & 7) * 8;
    const int fr = lane & 15, fg = lane >> 4;
    const u16* pa[WM]; const u16* pb[WN];
#pragma unroll
    for (int i = 0; i < WM; ++i) pa[i] = rowA(lr + 32 * i) + lc;
#pragma unroll
    for (int j = 0; j < WN; ++j) pb[j] = rowB(lr + 32 * j) + lc;
    u32x4 ra[WM], rb[WN];
#pragma unroll
    for (int i = 0; i < WM; ++i) ra[i] = *(const u32x4*)(pa[i]);
#pragma unroll
    for (int j = 0; j < WN; ++j) rb[j] = *(const u32x4*)(pb[j]);
    for (int k0 = 0; k0 < K; k0 += 64) {
        __syncthreads();
#pragma unroll
        for (int i = 0; i < WM; ++i) *(u32x4*)&sA[(lr + 32 * i) * 72 + lc] = ra[i];
#pragma unroll
        for (int j = 0; j < WN; ++j) *(u32x4*)&sB[(lr + 32 * j) * 72 + lc] = rb[j];
        __syncthreads();
        if (k0 + 64 < K) {
#pragma unroll
            for (int i = 0; i < WM; ++i) ra[i] = *(const u32x4*)(pa[i] + k0 + 64);
#pragma unroll
            for (int j = 0; j < WN; ++j) rb[j] = *(const u32x4*)(pb[j] + k0 + 64);
        }
#pragma unroll
        for (int ks = 0; ks < 2; ++ks) {
            bf16x8 a[WM], b[WN];
#pragma unroll
            for (int i = 0; i < WM; ++i) a[i] = *(const bf16x8*)&sA[(wm * 16 * WM + 16 * i + fr) * 72 + 32 * ks + 8 * fg];
#pragma unroll
            for (int j = 0; j < WN; ++j) b[j] = *(const bf16x8*)&sB[(wn * 16 * WN + 16 * j + fr) * 72 + 32 * ks + 8 * fg];
#pragma unroll
            for (int i = 0; i < WM; ++i)
#pragma unroll
                for (int j = 0; j < WN; ++j) acc[i][j] = MFMA16(a[i], b[j], acc[i][j]);
        }
    }
}

__device__ __forceinline__ void stage_rows64(u16* s, const u16* g, int ld) {
    const int t = tid_opaque(), r = t >> 2, c = (t & 3) * 16;
    const uint4* p = (const uint4*)(g + (size_t)r * ld + c);
    const uint4 v0 = p[0], v1 = p[1];
    *(uint4*)&s[r * 72 + c] = v0; *(uint4*)&s[r * 72 + c + 8] = v1;
}
__device__ __forceinline__ void qk64(const u16* sK, const bf16x8 (&qf)[2], f32x4 (&s)[4], int lane) {
    const int r = lane & 15, g = lane >> 4;
#pragma unroll
    for (int mt = 0; mt < 4; ++mt) {
        s[mt] = (f32x4){0.f, 0.f, 0.f, 0.f};
#pragma unroll
        for (int ks = 0; ks < 2; ++ks) {
            const bf16x8 a = *(const bf16x8*)&sK[(16 * mt + r) * 72 + 32 * ks + 8 * g];
            s[mt] = MFMA16(a, qf[ks], s[mt]);
        }
    }
}
template <int DT>
__device__ __forceinline__ void pv64(const u16* sVt, int vstride, const bf16x8 (&pb)[2], f32x4 (&o)[DT], int lane) {
    const int r = lane & 15, g = lane >> 4;
#pragma unroll
    for (int dt = 0; dt < DT; ++dt)
#pragma unroll
        for (int s2 = 0; s2 < 2; ++s2) {
            const u16* p = &sVt[(16 * dt + r) * vstride + 32 * s2 + 4 * g];
            const u32x2 lo = *(const u32x2*)p, hi = *(const u32x2*)(p + 16);
            const u32x4 av = {lo.x, lo.y, hi.x, hi.y};
            o[dt] = MFMA16(__builtin_bit_cast(bf16x8, av), pb[s2], o[dt]);
        }
}
__device__ __forceinline__ void pack_p(const float (&x)[16], bf16x8 (&pb)[2]) {
#pragma unroll
    for (int s2 = 0; s2 < 2; ++s2) {
        const u32x4 tv = {pack2(x[8 * s2 + 0], x[8 * s2 + 1]), pack2(x[8 * s2 + 2], x[8 * s2 + 3]),
                          pack2(x[8 * s2 + 4], x[8 * s2 + 5]), pack2(x[8 * s2 + 6], x[8 * s2 + 7])};
        pb[s2] = __builtin_bit_cast(bf16x8, tv);
    }
}
template <int DT, class F>
__device__ __forceinline__ void flash_step(const u16* sK, const u16* sVt, int vstride, const bf16x8 (&qf)[2],
                                           f32x4 (&o)[DT], float& m, float& l, bool lane_active, F logit, int lane) {
    if (__ballot(lane_active) == 0ull) return;
    f32x4 s[4]; qk64(sK, qf, s, lane);
    const int g = lane >> 4;
    float x[16]; float mx = NEGBIG;
#pragma unroll
    for (int mt = 0; mt < 4; ++mt)
#pragma unroll
        for (int rr = 0; rr < 4; ++rr) {
            bool valid; float v = logit(16 * mt + 4 * g + rr, s[mt][rr], valid);
            v = (valid && lane_active) ? v : NEGBIG; x[mt * 4 + rr] = v; mx = fmaxf(mx, v);
        }
    mx = fmaxf(mx, __shfl_xor(mx, 16)); mx = fmaxf(mx, __shfl_xor(mx, 32));
    const float mn = fmaxf(m, mx), alpha = __expf(m - mn);
    float ps = 0.f;
#pragma unroll
    for (int i = 0; i < 16; ++i) { const float pv = (x[i] > -1e29f) ? __expf(x[i] - mn) : 0.f; x[i] = pv; ps += pv; }
    l = l * alpha + ps; m = mn;
#pragma unroll
    for (int dt = 0; dt < DT; ++dt) o[dt] *= alpha;
    bf16x8 pb[2]; pack_p(x, pb);
    pv64<DT>(sVt, vstride, pb, o, lane);
}

__device__ __forceinline__ void prep_tile(const float* __restrict__ src, int ld_src, int k0, int c0, int nvalid,
                                          u16* __restrict__ dst, int ld_dst, int drow_base, int grp_stride, float* tile) {
    const int t = tid_opaque();
    {
        const int rr = t >> 4, cc = (t & 15) * 4;
#pragma unroll
        for (int ii = 0; ii < 4; ++ii) {
            const int row = rr + 16 * ii;
            float4 v = make_float4(0.f, 0.f, 0.f, 0.f);
            if (cc < nvalid) v = *(const float4*)(src + (size_t)(k0 + row) * ld_src + c0 + cc);
            float* tp = tile + row * 65 + cc; tp[0] = v.x; tp[1] = v.y; tp[2] = v.z; tp[3] = v.w;
        }
    }
    __syncthreads();
    {
        const int j = t >> 2, kk = (t & 3) * 16;
        uint32_t w[8];
#pragma unroll
        for (int i = 0; i < 8; ++i) w[i] = pack2(tile[(kk + 2 * i) * 65 + j], tile[(kk + 2 * i + 1) * 65 + j]);
        u16* dp = dst + (size_t)(drow_base + (j >> 4) * grp_stride + (j & 15)) * ld_dst + k0 + kk;
        *(uint4*)dp = make_uint4(w[0], w[1], w[2], w[3]); *(uint4*)(dp + 8) = make_uint4(w[4], w[5], w[6], w[7]);
    }
    __syncthreads();
}
__device__ __forceinline__ void win_seg(int drow, int& src, int& nvalid) {
    nvalid = 64;
    if (drow < 896) src = drow;
    else if (drow < 1152) src = 1024 + (drow - 896);
    else if (drow < 1408) src = 1280 + (drow - 1152);
    else if (drow < 1920) src = 2048 + (drow - 1408);
    else if (drow < 2176) src = 2560 + (drow - 1920);
    else if (drow < 2240) src = 2816;
    else if (drow < 2304) src = 2880;
    else if (drow < 2368) src = 2944;
    else if (drow < 2432) src = 3072;
    else if (drow < 2496) { src = 3200; nvalid = 12; }
    else if (drow < 2560) { src = 0; nvalid = 0; }
    else if (drow < 2688) src = 896 + (drow - 2560);
    else if (drow < 2944) src = 1280 + (drow - 2688);
    else if (drow < 3456) src = 1536 + (drow - 2944);
    else if (drow < 3520) src = 3008;
    else if (drow < 3584) src = 3136;
    else src = 3212 + (drow - 3584);
}
__device__ __forceinline__ void cvt16(const float* src, u16* dst) {
    const float4 a = ((const float4*)src)[0], b = ((const float4*)src)[1], c = ((const float4*)src)[2], d = ((const float4*)src)[3];
    *(uint4*)dst = make_uint4(pack2(a.x, a.y), pack2(a.z, a.w), pack2(b.x, b.y), pack2(b.z, b.w));
    *(uint4*)(dst + 8) = make_uint4(pack2(c.x, c.y), pack2(c.z, c.w), pack2(d.x, d.y), pack2(d.z, d.w));
}
__device__ __forceinline__ void prep_phase(const Params& p, int layer, bool with_x, unsigned char* smem) {
    float* tile = (float*)smem;
    unsigned char* ws = ws_opaque(p.ws);
    const int nA = 1920, nB = 320, nC = 256, nD = 8320, nE = 4160, nF = 256, nG = 8, nH = 16, nI = 2, nJ = 1, nX = with_x ? 4096 : 0;
    const int total = nA + nB + nC + nD + nE + nF + nG + nH + nI + nJ + nX;
    const int t = tid_opaque();
    for (int it = blockIdx.x; it < total; it += gridDim.x) {
        int idx = it;
        if (idx < nA) {
            const int dg = idx >> 4, kt = idx & 15; int src, nv; win_seg(dg * 64, src, nv);
            prep_tile(p.in[1] + (size_t)layer * 1024 * 7308, 7308, kt * 64, src, nv, (u16*)(ws + OFF_WINT), 1024, dg * 64, 16, tile);
            continue;
        }
        idx -= nA;
        if (idx < nB) {
            const float* src; int K, local; size_t off;
            if (idx < 64) { src = p.in[15] + (size_t)layer * 256 * 1024; K = 256; local = idx; off = 0; }
            else if (idx < 128) { src = p.in[16] + (size_t)layer * 256 * 1024; K = 256; local = idx - 64; off = 262144; }
            else if (idx < 256) { src = p.in[17] + (size_t)layer * 512 * 1024; K = 512; local = idx - 128; off = 524288; }
            else { src = p.in[18] + (size_t)layer * 256 * 1024; K = 256; local = idx - 256; off = 1048576; }
            const int nk = K >> 6, ct = local / nk, kt = local % nk;
            prep_tile(src, 1024, kt * 64, ct * 64, 64, (u16*)(ws + OFF_PT) + off, K, ct * 64, 16, tile);
            continue;
        }
        idx -= nB;
        if (idx < nC) {
            const int ct = idx >> 4, kt = idx & 15;
            prep_tile(p.in[19] + (size_t)layer * 1024 * 1024, 1024, kt * 64, ct * 64, 64, (u16*)(ws + OFF_WOUT), 1024, ct * 64, 16, tile);
            continue;
        }
        idx -= nC;
        if (idx < nD) {
            const int e = idx >> 7, rem = idx & 127, isUp = rem >> 6, r2 = rem & 63, ct = r2 >> 4, kt = r2 & 15;
            const float* src = (e < 64) ? p.in[24 + isUp] + ((size_t)layer * 64 + e) * 1024 * 256 : p.in[27 + isUp] + (size_t)layer * 1024 * 256;
            prep_tile(src, 256, kt * 64, ct * 64, 64, (u16*)(ws + OFF_WUP) + (size_t)e * 512 * 1024, 1024, 32 * (ct * 4) + 16 * isUp, 32, tile);
            continue;
        }
        idx -= nD;
        if (idx < nE) {
            const int e = idx >> 6, r2 = idx & 63, ct = r2 >> 2, kt = r2 & 3;
            const float* src = (e < 64) ? p.in[26] + ((size_t)layer * 64 + e) * 256 * 1024 : p.in[29] + (size_t)layer * 256 * 1024;
            prep_tile(src, 1024, kt * 64, ct * 64, 64, (u16*)(ws + OFF_WD) + (size_t)e * 1024 * 256, 256, ct * 64, 16, tile);
            continue;
        }
        idx -= nE;
        if (idx < nF) {
            const int which = idx >> 7, r2 = idx & 127, ct = r2 >> 5, kt = r2 & 31;
            prep_tile(p.in[which ? 13 : 10] + (size_t)layer * 2048 * 256, 256, kt * 64, ct * 64, 64, (u16*)(ws + OFF_W1T) + (size_t)which * 256 * 2048, 2048, ct * 64, 16, tile);
            continue;
        }
        idx -= nF;
        if (idx < nG) {
            const int which = idx >> 2, kt = idx & 3;
            prep_tile(p.in[which ? 14 : 11] + (size_t)layer * 256 * 64, 64, kt * 64, 0, 64, (u16*)(ws + OFF_W2T) + (size_t)which * 64 * 256, 256, 0, 16, tile);
            continue;
        }
        idx -= nG;
        if (idx < nH) {
            cvt16(p.in[22] + (size_t)layer * 65536 + (size_t)idx * 4096 + t * 16, (u16*)(ws + OFF_RW) + (size_t)idx * 4096 + t * 16);
            continue;
        }
        idx -= nH;
        if (idx < nI) {
            const float* pe = p.in[idx ? 12 : 9] + (size_t)layer * 2048;
            const float* w1 = p.in[idx ? 13 : 10] + (size_t)layer * 2048 * 256;
            float s = 0.f;
            for (int i = 0; i < 2048; ++i) s += pe[i] * w1[(size_t)i * 256 + t];
            ((float*)(ws + OFF_BIAS1))[idx * 256 + t] = s;
            continue;
        }
        idx -= nI;
        if (idx < nJ) {
            if (t < 128) ((unsigned*)(ws + OFF_CNT))[t] = 0u;
            u16* kcp = (u16*)(ws + OFF_KC) + (size_t)T_TOK * 64; u16* vcp = (u16*)(ws + OFF_VC) + (size_t)T_TOK * 64;
            for (int i = t; i < 1024; i += NTHR) { kcp[i] = 0; vcp[i] = 0; }
            continue;
        }
        idx -= nJ;
        cvt16(p.in[0] + (size_t)idx * 4096 + t * 16, (u16*)(ws + OFF_XB) + (size_t)idx * 4096 + t * 16);
    }
}

__device__ __forceinline__ void inproj_phase(const Params& p, int layer, unsigned char* smem) {
    u16* sA = (u16*)smem; u16* sB = sA + 128 * 72;
    unsigned char* ws = ws_opaque(p.ws);
    const u16* XB = (const u16*)(ws + OFF_XB); const u16* WINT = (const u16*)(ws + OFF_WINT);
    u16* U = (u16*)(ws + OFF_U); u16* UT = (u16*)(ws + OFF_UT); u16* KC = (u16*)(ws + OFF_KC); u16* VC = (u16*)(ws + OFF_VC);
    const int t_ = tid_opaque();
    const int lane = t_ & 63, wave = t_ >> 6, wm = wave >> 1, wn = wave & 1, fr = lane & 15, fg = lane >> 4;
    for (int it = blockIdx.x; it < 128 * 28; it += gridDim.x) {
        const int ft = it % 28, tt = it / 28;
        f32x4 acc[4][4]; zero_acc<4, 4>(acc);
        auto rowX = [=](int r) { return XB + (size_t)(tt * 128 + r) * 1024; };
        auto rowW = [=](int r) { return WINT + (size_t)(ft * 128 + r) * 1024; };
        if (ft < 20) {
            gemm_acc<4, 4>(acc, rowW, rowX, 1024, sA, sB);
#pragma unroll
            for (int i = 0; i < 4; ++i)
#pragma unroll
                for (int j = 0; j < 4; ++j) {
                    const int m = ft * 128 + wm * 64 + 16 * i + 4 * fg, n = tt * 128 + wn * 64 + 16 * j + fr;
                    const uint2 v = pack4(acc[i][j]);
                    if (ft == 17) {
                        const int f = m - 2176;
                        if (f < 64) *(uint2*)(KC + (size_t)n * 64 + f) = v; else *(uint2*)(VC + (size_t)n * 64 + (f - 64)) = v;
                    } else *(uint2*)(U + (size_t)n * LDU + m) = v;
                }
        } else {
            gemm_acc<4, 4>(acc, rowX, rowW, 1024, sA, sB);
#pragma unroll
            for (int i = 0; i < 4; ++i)
#pragma unroll
                for (int j = 0; j < 4; ++j) {
                    const int m = tt * 128 + wm * 64 + 16 * i + 4 * fg, n = ft * 128 + wn * 64 + 16 * j + fr;
                    const int trow = n - 2560, b = m >> 11, s = m & 2047;
                    f32x4 v = acc[i][j];
                    if (trow >= 128 && trow < 384) {
                        const int h = (trow - 128) >> 6; const float l2g = log2f(1.f - exp2f(-5.f - (float)h));
#pragma unroll
                        for (int r = 0; r < 4; ++r) v[r] *= 0.125f * exp2f((float)(127 - ((s + r) & 127)) * l2g);
                    }
                    *(uint2*)(UT + ((size_t)(b * 1024 + trow)) * 2048 + s) = pack4(v);
                }
        }
    }
}

__device__ __forceinline__ void compress_item(const Params& p, int item, unsigned char* smem) {
    unsigned char* ws = ws_opaque(p.ws);
    u16* sA = (u16*)smem; u16* sB = sA + 128 * 72; u16* sH = sB + 64 * 72;
    const int which = item >> 4, r0 = (item & 15) * 64;
    const u16* src = (const u16*)(ws + (which ? OFF_VC : OFF_KC));
    const u16* W1 = (const u16*)(ws + OFF_W1T) + (size_t)which * 256 * 2048;
    const u16* W2 = (const u16*)(ws + OFF_W2T) + (size_t)which * 64 * 256;
    const float* bias = (const float*)(ws + OFF_BIAS1) + which * 256;
    const int t = tid_opaque();
    const int lane = t & 63, wave = t >> 6, wm = wave >> 1, wn = wave & 1, fr = lane & 15, fg = lane >> 4;
    for (int half = 0; half < 2; ++half) {
        f32x4 acc[4][2]; zero_acc<4, 2>(acc);
        auto rowW = [=](int r) { return W1 + (size_t)(half * 128 + r) * 2048; };
        auto rowA = [=](int r) { return src + (size_t)(r0 + r) * 1024; };
        gemm_acc<4, 2>(acc, rowW, rowA, 2048, sA, sB);
#pragma unroll
        for (int i = 0; i < 4; ++i)
#pragma unroll
            for (int j = 0; j < 2; ++j) {
                const int m = half * 128 + wm * 64 + 16 * i + 4 * fg, n = wn * 32 + 16 * j + fr;
                f32x4 v = acc[i][j];
#pragma unroll
                for (int r = 0; r < 4; ++r) { const float xx = v[r] + bias[m + r]; v[r] = 0.5f * xx * (1.f + erff(xx * 0.70710678118f)); }
                *(uint2*)&sH[n * 264 + m] = pack4(v);
            }
    }
    __syncthreads();
    f32x4 acc2[4];
#pragma unroll
    for (int nt = 0; nt < 4; ++nt) acc2[nt] = (f32x4){0.f, 0.f, 0.f, 0.f};
    if (which == 0) {
#pragma unroll
        for (int ks = 0; ks < 8; ++ks) {
            const bf16x8 a = *(const bf16x8*)(W2 + (size_t)(16 * wave + fr) * 256 + 32 * ks + 8 * fg);
#pragma unroll
            for (int nt = 0; nt < 4; ++nt) { const bf16x8 b = *(const bf16x8*)&sH[(16 * nt + fr) * 264 + 32 * ks + 8 * fg]; acc2[nt] = MFMA16(a, b, acc2[nt]); }
        }
        u16* KCMP = (u16*)(ws + OFF_KCMP);
#pragma unroll
        for (int nt = 0; nt < 4; ++nt) *(uint2*)(KCMP + (size_t)(r0 + 16 * nt + fr) * 64 + 16 * wave + 4 * fg) = pack4(acc2[nt]);
    } else {
#pragma unroll
        for (int ks = 0; ks < 8; ++ks) {
            const bf16x8 a = *(const bf16x8*)&sH[(16 * wave + fr) * 264 + 32 * ks + 8 * fg];
#pragma unroll
            for (int nt = 0; nt < 4; ++nt) { const bf16x8 b = *(const bf16x8*)(W2 + (size_t)(16 * nt + fr) * 256 + 32 * ks + 8 * fg); acc2[nt] = MFMA16(a, b, acc2[nt]); }
        }
        u16* VCMPT = (u16*)(ws + OFF_VCMPT);
        const int rg = r0 + 16 * wave + 4 * fg, bb = rg >> 7, ii = rg & 127;
#pragma unroll
        for (int nt = 0; nt < 4; ++nt) *(uint2*)(VCMPT + (size_t)(bb * 64 + 16 * nt + fr) * 128 + ii) = pack4(acc2[nt]);
    }
    __syncthreads();
}

__device__ __forceinline__ void retkv_item(const Params& p, int item) {
    unsigned char* ws = ws_opaque(p.ws);
    const int bh = item >> 4, mc = item & 15, b = bh >> 2, h = bh & 3;
    const u16* Vt = (const u16*)(ws + OFF_UT) + ((size_t)(b * 1024 + 384 + h * 128)) * 2048 + mc * 128;
    const u16* Kt = (const u16*)(ws + OFF_UT) + ((size_t)(b * 1024 + 128 + h * 64)) * 2048 + mc * 128;
    const int t = tid_opaque();
    const int lane = t & 63, wave = t >> 6, fr = lane & 15, fg = lane >> 4;
    f32x4 acc[2][4]; zero_acc<2, 4>(acc);
#pragma unroll
    for (int ks = 0; ks < 4; ++ks) {
        bf16x8 a[2], bb[4];
#pragma unroll
        for (int mt = 0; mt < 2; ++mt) a[mt] = *(const bf16x8*)(Vt + (size_t)(32 * wave + 16 * mt + fr) * 2048 + 32 * ks + 8 * fg);
#pragma unroll
        for (int nt = 0; nt < 4; ++nt) bb[nt] = *(const bf16x8*)(Kt + (size_t)(16 * nt + fr) * 2048 + 32 * ks + 8 * fg);
#pragma unroll
        for (int mt = 0; mt < 2; ++mt)
#pragma unroll
            for (int nt = 0; nt < 4; ++nt) acc[mt][nt] = MFMA16(a[mt], bb[nt], acc[mt][nt]);
    }
    float* KVT = (float*)(ws + OFF_KVT) + (size_t)item * 8192;
#pragma unroll
    for (int mt = 0; mt < 2; ++mt)
#pragma unroll
        for (int nt = 0; nt < 4; ++nt)
#pragma unroll
            for (int r = 0; r < 4; ++r) KVT[(32 * wave + 16 * mt + 4 * fg + r) * 64 + 16 * nt + fr] = acc[mt][nt][r];
}

__device__ __forceinline__ void swa_item(const Params& p, int layer, int item, unsigned char* smem) {
    unsigned char* ws = ws_opaque(p.ws);
    u16* sK = (u16*)smem; u16* sVt = sK + 64 * 72;
    const u16* U = (const u16*)(ws + OFF_U); const u16* UT = (const u16*)(ws + OFF_UT); u16* ACT = (u16*)(ws + OFF_ACT);
    const int b = item >> 7, h = (item >> 5) & 3, qb = item & 31, kvh = h >> 1;
    const int t = tid_opaque();
    const int lane = t & 63, wave = t >> 6, q = lane & 15, g = lane >> 4;
    const int tq = qb * 64 + wave * 16 + q; const size_t tglob = (size_t)b * 2048 + tq;
    bf16x8 qf[2];
#pragma unroll
    for (int ks = 0; ks < 2; ++ks) qf[ks] = *(const bf16x8*)(U + tglob * LDU + 512 + h * 64 + 32 * ks + 8 * g);
    const float slope = exp2f(-(float)(h + 1)); const float sink = p.in[6][layer * 4 + h];
    f32x4 o[4];
#pragma unroll
    for (int dt = 0; dt < 4; ++dt) o[dt] = (f32x4){0.f, 0.f, 0.f, 0.f};
    float m = NEGBIG, l = 0.f;
    const int kt0 = qb >= 2 ? qb - 2 : 0;
    for (int kt = kt0; kt <= qb; ++kt) {
        __syncthreads();
        stage_rows64(sK, U + ((size_t)b * 2048 + kt * 64) * LDU + 768 + kvh * 64, LDU);
        stage_rows64(sVt, UT + ((size_t)(b * 1024 + kvh * 64)) * 2048 + kt * 64, 2048);
        __syncthreads();
        flash_step<4>(sK, sVt, 72, qf, o, m, l, true,
                      [&](int key, float s, bool& valid) { const int d = tq - (kt * 64 + key); valid = (d >= 0) && (d < 128); return s * 0.125f - slope * (float)d; }, lane);
    }
    float lt = l + __shfl_xor(l, 16); lt += __shfl_xor(lt, 32);
    const float m2 = fmaxf(m, sink), sc = __expf(m - m2), den = lt * sc + __expf(sink - m2), inv = sc / fmaxf(den, 1e-30f);
#pragma unroll
    for (int dt = 0; dt < 4; ++dt) *(uint2*)(ACT + tglob * LDACT + 256 + h * 64 + 16 * dt + 4 * g) = pack4(o[dt] * inv);
    __syncthreads();
}

__device__ __forceinline__ void conv_item(const Params& p, int layer, int item, unsigned char* smem) {
    unsigned char* ws = ws_opaque(p.ws);
    u16* sh = (u16*)smem; float* sy = (float*)(smem + 62 * 256 * 2);
    const u16* U = (const u16*)(ws + OFF_U); u16* ACT = (u16*)(ws + OFF_ACT);
    const int b = item >> 6, s0 = (item & 63) * 32, t = tid_opaque();
#pragma unroll 2
    for (int r = 0; r < 62; ++r) {
        const int sp = s0 - 30 + r; float hv = 0.f;
        if (sp >= 0) { const u16* row = U + ((size_t)b * 2048 + sp) * LDU; hv = bf2f(row[t]) * sigmoidf_(bf2f(row[256 + t])); }
        sh[r * 256 + t] = f2bf(hv);
    }
    __syncthreads();
    float w[31];
#pragma unroll
    for (int k = 0; k < 31; ++k) w[k] = p.in[2][(size_t)layer * 31 * 256 + k * 256 + t];
    const float db = p.in[3][layer * 256 + t];
#pragma unroll 1
    for (int tt = 0; tt < 32; ++tt) {
        float a = db;
#pragma unroll
        for (int k = 0; k < 31; ++k) a += bf2f(sh[(tt + k) * 256 + t]) * w[k];
        sy[tt * 256 + t] = a;
    }
    __syncthreads();
    const int lane = t & 63, wave = t >> 6, c = lane * 4;
    const float4 gg = *(const float4*)(p.in[4] + layer * 256 + c), bb = *(const float4*)(p.in[5] + layer * 256 + c);
    for (int i = 0; i < 8; ++i) {
        const int tt = wave * 8 + i;
        const float4 v = *(const float4*)&sy[tt * 256 + c];
        float s = v.x + v.y + v.z + v.w;
#pragma unroll
        for (int o = 32; o >= 1; o >>= 1) s += __shfl_xor(s, o);
        const float mu = s * (1.f / 256.f);
        const float dx = v.x - mu, dy = v.y - mu, dz = v.z - mu, dw = v.w - mu;
        float q = dx * dx + dy * dy + dz * dz + dw * dw;
#pragma unroll
        for (int o = 32; o >= 1; o >>= 1) q += __shfl_xor(q, o);
        const float rstd = rsqrtf(q * (1.f / 256.f) + LN_EPS_F);
        f32x4 ov; ov[0] = siluf_(dx * rstd * gg.x + bb.x); ov[1] = siluf_(dy * rstd * gg.y + bb.y); ov[2] = siluf_(dz * rstd * gg.z + bb.z); ov[3] = siluf_(dw * rstd * gg.w + bb.w);
        *(uint2*)(ACT + ((size_t)b * 2048 + s0 + tt) * LDACT + c) = pack4(ov);
    }
    __syncthreads();
}

#define FOR_ITEMS(j, base, n) for (int j = (int)((blockIdx.x + gridDim.x - ((base) % gridDim.x)) % gridDim.x); j < (n); j += gridDim.x)
__device__ __forceinline__ void p2a_phase(const Params& p, int layer, unsigned char* smem) {
    FOR_ITEMS(j, 0, 32) compress_item(p, j, smem);
    FOR_ITEMS(j, 32, 512) retkv_item(p, j);
    FOR_ITEMS(j, 544, 1024) swa_item(p, layer, j, smem);
    FOR_ITEMS(j, 1568, 512) conv_item(p, layer, j, smem);
}

__device__ __forceinline__ void retout_item(const Params& p, int layer, int item, unsigned char* smem) {
    unsigned char* ws = ws_opaque(p.ws);
    u16* sS = (u16*)smem; u16* sK = sS + 128 * 72; u16* sVt = sK + 64 * 72;
    const u16* U = (const u16*)(ws + OFF_U); const u16* UT = (const u16*)(ws + OFF_UT); u16* ACT = (u16*)(ws + OFF_ACT);
    const int bh = item >> 4, n = item & 15, b = bh >> 2, h = bh & 3, t = tid_opaque();
    const float l2g = log2f(1.f - exp2f(-5.f - (float)h));
    {
        float as[32];
#pragma unroll
        for (int i = 0; i < 32; ++i) as[i] = 0.f;
        for (int mm = 0; mm < n; ++mm) {
            const float wgt = exp2f(128.f * (float)(n - 1 - mm) * l2g);
            const float4* src = (const float4*)((const float*)(ws + OFF_KVT) + (size_t)(bh * 16 + mm) * 8192 + t * 32);
#pragma unroll
            for (int i = 0; i < 8; ++i) { const float4 v = src[i]; as[4 * i] += wgt * v.x; as[4 * i + 1] += wgt * v.y; as[4 * i + 2] += wgt * v.z; as[4 * i + 3] += wgt * v.w; }
        }
        u16* dp = &sS[(t >> 1) * 72 + (t & 1) * 32];
#pragma unroll
        for (int i = 0; i < 4; ++i) *(uint4*)(dp + 8 * i) = make_uint4(pack2(as[8 * i], as[8 * i + 1]), pack2(as[8 * i + 2], as[8 * i + 3]), pack2(as[8 * i + 4], as[8 * i + 5]), pack2(as[8 * i + 6], as[8 * i + 7]));
    }
    __syncthreads();
    const int lane = t & 63, wave = t >> 6, q = lane & 15, g = lane >> 4;
    bf16x8 qf[2][2]; f32x4 o[2][8];
#pragma unroll
    for (int qt = 0; qt < 2; ++qt) {
        const size_t tglob = (size_t)b * 2048 + n * 128 + 32 * wave + 16 * qt + q;
#pragma unroll
        for (int ks = 0; ks < 2; ++ks) qf[qt][ks] = *(const bf16x8*)(U + tglob * LDU + 896 + h * 64 + 32 * ks + 8 * g);
#pragma unroll
        for (int dt = 0; dt < 8; ++dt) {
            o[qt][dt] = (f32x4){0.f, 0.f, 0.f, 0.f};
#pragma unroll
            for (int ks = 0; ks < 2; ++ks) { const bf16x8 a = *(const bf16x8*)&sS[(16 * dt + q) * 72 + 32 * ks + 8 * g]; o[qt][dt] = MFMA16(a, qf[qt][ks], o[qt][dt]); }
        }
        const float xi = exp2f((float)(32 * wave + 16 * qt + q + 1) * l2g);
#pragma unroll
        for (int dt = 0; dt < 8; ++dt) o[qt][dt] *= xi;
    }
    for (int kt = 0; kt < 2; ++kt) {
        __syncthreads();
        stage_rows64(sK, U + ((size_t)b * 2048 + n * 128 + kt * 64) * LDU + 1152 + h * 64, LDU);
        stage_rows64(sVt, UT + ((size_t)(b * 1024 + 384 + h * 128)) * 2048 + n * 128 + kt * 64, 2048);
        stage_rows64(sVt + 64 * 72, UT + ((size_t)(b * 1024 + 384 + h * 128 + 64)) * 2048 + n * 128 + kt * 64, 2048);
        __syncthreads();
#pragma unroll
        for (int qt = 0; qt < 2; ++qt) {
            if (kt * 64 > 32 * wave + 16 * qt + 15) continue;
            const int tql = 32 * wave + 16 * qt + q;
            f32x4 s[4]; qk64(sK, qf[qt], s, lane);
            float x[16];
#pragma unroll
            for (int mt = 0; mt < 4; ++mt)
#pragma unroll
                for (int rr = 0; rr < 4; ++rr) { const int d = tql - (kt * 64 + 16 * mt + 4 * g + rr); x[mt * 4 + rr] = (d >= 0) ? s[mt][rr] * 0.125f * exp2f((float)d * l2g) : 0.f; }
            bf16x8 pb[2]; pack_p(x, pb);
            pv64<8>(sVt, 72, pb, o[qt], lane);
        }
    }
#pragma unroll
    for (int qt = 0; qt < 2; ++qt) {
        const size_t tglob = (size_t)b * 2048 + n * 128 + 32 * wave + 16 * qt + q;
        float s = 0.f;
#pragma unroll
        for (int dt = 0; dt < 8; ++dt) s += o[qt][dt][0] + o[qt][dt][1] + o[qt][dt][2] + o[qt][dt][3];
        s += __shfl_xor(s, 16); s += __shfl_xor(s, 32);
        const float mu = s * (1.f / 128.f);
        float v = 0.f;
#pragma unroll
        for (int dt = 0; dt < 8; ++dt)
#pragma unroll
            for (int r = 0; r < 4; ++r) { const float d = o[qt][dt][r] - mu; v += d * d; }
        v += __shfl_xor(v, 16); v += __shfl_xor(v, 32);
        const float rstd = rsqrtf(v * (1.f / 128.f) + LN_EPS_F);
#pragma unroll
        for (int dt = 0; dt < 8; ++dt) {
            const int c = h * 128 + 16 * dt + 4 * g;
            const float4 gn = *(const float4*)(p.in[7] + layer * 512 + c), gb = *(const float4*)(p.in[8] + layer * 512 + c);
            const uint2 gv = *(const uint2*)(U + tglob * LDU + 1408 + c);
            f32x4 ov;
            ov[0] = ((o[qt][dt][0] - mu) * rstd * gn.x + gb.x) * siluf_(bflo(gv.x));
            ov[1] = ((o[qt][dt][1] - mu) * rstd * gn.y + gb.y) * siluf_(bfhi(gv.x));
            ov[2] = ((o[qt][dt][2] - mu) * rstd * gn.z + gb.z) * siluf_(bflo(gv.y));
            ov[3] = ((o[qt][dt][3] - mu) * rstd * gn.w + gb.w) * siluf_(bfhi(gv.y));
            *(uint2*)(ACT + tglob * LDACT + 512 + c) = pack4(ov);
        }
    }
    __syncthreads();
}

__device__ __forceinline__ void nsa_item(const Params& p, int item, unsigned char* smem) {
    unsigned char* ws = ws_opaque(p.ws);
    u16* sKc = (u16*)smem;
    u16* sVc = sKc + 128 * 72;
    u16* sK = sVc + 64 * 136;
    u16* sVt = sK + 64 * 72;
    float* impL = (float*)(sVt + 64 * 72);
    unsigned* qmask = (unsigned*)(impL + 4 * 16 * 32);
    unsigned* wgor = qmask + 64;
    const u16* U = (const u16*)(ws + OFF_U); const u16* UT = (const u16*)(ws + OFF_UT); u16* ACT = (u16*)(ws + OFF_ACT);
    const int b = item >> 5, blk = item & 31, t = tid_opaque();
    const int lane = t & 63, wave = t >> 6, q = lane & 15, g = lane >> 4;
    const int tq = blk * 64 + wave * 16 + q; const size_t tglob = (size_t)b * 2048 + tq;
    __syncthreads();
    {
        const u16* kc = (const u16*)(ws + OFF_KCMP) + (size_t)b * 128 * 64;
        stage_rows64(sKc, kc, 64); stage_rows64(sKc + 64 * 72, kc + 64 * 64, 64);
        const u16* vc = (const u16*)(ws + OFF_VCMPT) + (size_t)b * 64 * 128;
        const int r = t >> 2, c = (t & 3) * 32;
        const uint4* src = (const uint4*)(vc + (size_t)r * 128 + c);
#pragma unroll
        for (int i = 0; i < 4; ++i) *(uint4*)&sVc[r * 136 + c + 8 * i] = src[i];
        if (t == 0) *wgor = 0u;
    }
    __syncthreads();
    const u16* qrow = U + tglob * LDU + 1920 + 8 * g;
    float impm[8], impc[8];
#pragma unroll
    for (int i = 0; i < 8; ++i) { impm[i] = 0.f; impc[i] = 0.f; }
#pragma unroll 1
    for (int h = 0; h < 4; ++h) {
        const float slope = exp2f(-(float)(h + 5));
        bf16x8 qh[2];
        qh[0] = *(const bf16x8*)(qrow + h * 64); qh[1] = *(const bf16x8*)(qrow + h * 64 + 32);
        f32x4 s0[4], s1[4]; qk64(sKc, qh, s0, lane); qk64(sKc + 64 * 72, qh, s1, lane);
        float x[32]; float mx = NEGBIG;
#pragma unroll
        for (int mt = 0; mt < 4; ++mt)
#pragma unroll
            for (int rr = 0; rr < 4; ++rr) {
                const int c0 = 16 * mt + 4 * g + rr, c1 = 64 + c0;
                const int d0 = tq - (16 * c0 + 31), d1 = tq - (16 * c1 + 31);
                const float v0 = d0 >= 0 ? s0[mt][rr] * 0.125f - slope * (float)d0 : NEGBIG;
                const float v1 = d1 >= 0 ? s1[mt][rr] * 0.125f - slope * (float)d1 : NEGBIG;
                x[mt * 4 + rr] = v0; x[16 + mt * 4 + rr] = v1; mx = fmaxf(mx, fmaxf(v0, v1));
            }
        mx = fmaxf(mx, __shfl_xor(mx, 16)); mx = fmaxf(mx, __shfl_xor(mx, 32));
        float ps = 0.f;
#pragma unroll
        for (int i = 0; i < 32; ++i) { const float pv = (x[i] > -1e29f) ? __expf(x[i] - mx) : 0.f; x[i] = pv; ps += pv; }
        ps += __shfl_xor(ps, 16); ps += __shfl_xor(ps, 32);
        const float inv = 1.f / fmaxf(ps, 1e-30f);
#pragma unroll
        for (int tm = 0; tm < 8; ++tm) {
            impm[tm] += (x[tm * 4] + x[tm * 4 + 1] + x[tm * 4 + 2] + x[tm * 4 + 3]) * inv;
            impc[tm] += x[tm * 4 + 3] * inv;
        }
    }
    float* myimp = impL + (wave * 16 + q) * 32;
#pragma unroll
    for (int tm = 0; tm < 8; ++tm) myimp[4 * tm + g] = impm[tm];
    __syncthreads();
#pragma unroll
    for (int tm = 0; tm < 8; ++tm) { const int j1 = 4 * tm + g + 1; if (j1 < 32) myimp[j1] += impc[tm]; }
    __syncthreads();
    if (g == 0) {
        const int cur = blk;
        for (int j = 0; j < 32; ++j) {
            float v = myimp[j];
            if (j == 0 || j == cur || j == cur - 1) v = 1e4f; else if (j > cur) v = -1.f;
            myimp[j] = v;
        }
        unsigned mask = 0u;
        for (int nsel = 0; nsel < 8; ++nsel) {
            float best = -3e38f; int bj = 0;
            for (int j = 0; j < 32; ++j) { const float v = myimp[j]; if (!((mask >> j) & 1u) && v > best) { best = v; bj = j; } }
            mask |= 1u << bj;
        }
        qmask[wave * 16 + q] = mask;
        atomicOr(wgor, mask);
    }
    __syncthreads();
    const unsigned mymask = qmask[wave * 16 + q];
    const unsigned allmask = *wgor;
    const int cur = blk;
#pragma unroll 1
    for (int h = 0; h < 4; ++h) {
        const float slope = exp2f(-(float)(h + 5));
        bf16x8 qh[2];
        qh[0] = *(const bf16x8*)(qrow + h * 64); qh[1] = *(const bf16x8*)(qrow + h * 64 + 32);
        const u16* grow = U + tglob * LDU + 2432;
        const float g0 = sigmoidf_(bf2f(grow[h])), g1 = sigmoidf_(bf2f(grow[4 + h])), g2 = sigmoidf_(bf2f(grow[8 + h]));
        f32x4 otot[4];
        {
            f32x4 o[4];
#pragma unroll
            for (int dt = 0; dt < 4; ++dt) o[dt] = (f32x4){0.f, 0.f, 0.f, 0.f};
            float m = NEGBIG, l = 0.f;
#pragma unroll
            for (int tile = 0; tile < 2; ++tile)
                flash_step<4>(sKc + tile * 64 * 72, sVc + tile * 64, 136, qh, o, m, l, true,
                              [&](int key, float s, bool& valid) { const int d = tq - (16 * (tile * 64 + key) + 31); valid = d >= 0; return s * 0.125f - slope * (float)d; }, lane);
            float lt = l + __shfl_xor(l, 16); lt += __shfl_xor(lt, 32);
            const float sc = g0 / fmaxf(lt, 1e-30f);
#pragma unroll
            for (int dt = 0; dt < 4; ++dt) otot[dt] = o[dt] * sc;
        }
        {
            f32x4 o[4];
#pragma unroll
            for (int dt = 0; dt < 4; ++dt) o[dt] = (f32x4){0.f, 0.f, 0.f, 0.f};
            float m = NEGBIG, l = 0.f;
            for (int j = 0; j <= cur; ++j) {
                if (!((allmask >> j) & 1u)) continue;
                __syncthreads();
                stage_rows64(sK, U + ((size_t)b * 2048 + j * 64) * LDU + 2304, LDU);
                stage_rows64(sVt, UT + ((size_t)(b * 1024 + 896)) * 2048 + j * 64, 2048);
                __syncthreads();
                flash_step<4>(sK, sVt, 72, qh, o, m, l, ((mymask >> j) & 1u) != 0u,
                              [&](int key, float s, bool& valid) { const int d = tq - (j * 64 + key); valid = d >= 0; return s * 0.125f - slope * (float)d; }, lane);
            }
            float lt = l + __shfl_xor(l, 16); lt += __shfl_xor(lt, 32);
            const float sc = g1 / fmaxf(lt, 1e-30f);
#pragma unroll
            for (int dt = 0; dt < 4; ++dt) otot[dt] += o[dt] * sc;
        }
        {
            f32x4 o[4];
#pragma unroll
            for (int dt = 0; dt < 4; ++dt) o[dt] = (f32x4){0.f, 0.f, 0.f, 0.f};
            float m = NEGBIG, l = 0.f;
            const int kt0 = cur >= 8 ? cur - 8 : 0;
            for (int kt = kt0; kt <= cur; ++kt) {
                __syncthreads();
                stage_rows64(sK, U + ((size_t)b * 2048 + kt * 64) * LDU + 2368, LDU);
                stage_rows64(sVt, UT + ((size_t)(b * 1024 + 960)) * 2048 + kt * 64, 2048);
                __syncthreads();
                flash_step<4>(sK, sVt, 72, qh, o, m, l, true,
                              [&](int key, float s, bool& valid) { const int d = tq - (kt * 64 + key); valid = (d >= 0) && (d < 512); return s * 0.125f - slope * (float)d; }, lane);
            }
            float lt = l + __shfl_xor(l, 16); lt += __shfl_xor(lt, 32);
            const float sc = g2 / fmaxf(lt, 1e-30f);
#pragma unroll
            for (int dt = 0; dt < 4; ++dt) otot[dt] += o[dt] * sc;
        }
#pragma unroll
        for (int dt = 0; dt < 4; ++dt) *(uint2*)(ACT + tglob * LDACT + 1024 + h * 64 + 16 * dt + 4 * g) = pack4(otot[dt]);
    }
    __syncthreads();
}

__device__ __forceinline__ void p2b_phase(const Params& p, int layer, unsigned char* smem) {
    FOR_ITEMS(j, 0, 256) nsa_item(p, j, smem);
    FOR_ITEMS(j, 256, 512) retout_item(p, layer, j, smem);
}

__device__ __forceinline__ void merge_phase(const Params& p, unsigned char* smem) {
    unsigned char* ws = ws_opaque(p.ws);
    u16* sA = (u16*)smem; u16* sB = sA + 64 * 72;
    const u16* XB = (const u16*)(ws + OFF_XB); const u16* WINT = (const u16*)(ws + OFF_WINT); const u16* PT = (const u16*)(ws + OFF_PT);
    const u16* ACT = (const u16*)(ws + OFF_ACT); u16* MERGED = (u16*)(ws + OFF_MERGED);
    const int t_ = tid_opaque();
    const int lane = t_ & 63, wave = t_ >> 6, wm = wave >> 1, wn = wave & 1, fr = lane & 15, fg = lane >> 4;
    for (int it = blockIdx.x; it < 128 * 16; it += gridDim.x) {
        const int ct = it & 15, tt = it >> 4;
        f32x4 accm[2][4]; zero_acc<2, 4>(accm);
        auto rowX = [=](int r) { return XB + (size_t)(tt * 128 + r) * 1024; };
#pragma unroll 1
        for (int br = 0; br < 4; ++br) {
            const int Kb = (br == 2) ? 512 : 256;
            const size_t poff = (br == 0) ? 0 : (br == 1) ? 262144 : (br == 2) ? 524288 : 1048576;
            const int aoff = (br == 0) ? 0 : (br == 1) ? 256 : (br == 2) ? 512 : 1024;
            f32x4 accg[2][4]; zero_acc<2, 4>(accg);
            auto rowWg = [=](int r) { return WINT + (size_t)(3584 + br * 1024 + ct * 64 + r) * 1024; };
            gemm_acc<2, 4>(accg, rowWg, rowX, 1024, sA, sB);
#pragma unroll
            for (int i = 0; i < 2; ++i)
#pragma unroll
                for (int j = 0; j < 4; ++j)
#pragma unroll
                    for (int r = 0; r < 4; ++r) accg[i][j][r] = sigmoidf_(accg[i][j][r]);
            f32x4 accy[2][4]; zero_acc<2, 4>(accy);
            auto rowP = [=](int r) { return PT + poff + (size_t)(ct * 64 + r) * Kb; };
            auto rowAct = [=](int r) { return ACT + (size_t)(tt * 128 + r) * LDACT + aoff; };
            gemm_acc<2, 4>(accy, rowP, rowAct, Kb, sA, sB);
#pragma unroll
            for (int i = 0; i < 2; ++i)
#pragma unroll
                for (int j = 0; j < 4; ++j) accm[i][j] += accg[i][j] * accy[i][j];
        }
#pragma unroll
        for (int i = 0; i < 2; ++i)
#pragma unroll
            for (int j = 0; j < 4; ++j) {
                const int m = ct * 64 + wm * 32 + 16 * i + 4 * fg, n = tt * 128 + wn * 64 + 16 * j + fr;
                *(uint2*)(MERGED + (size_t)n * 1024 + m) = pack4(accm[i][j]);
            }
    }
}

__device__ __forceinline__ void wout_phase(const Params& p, unsigned char* smem) {
    unsigned char* ws = ws_opaque(p.ws);
    u16* sA = (u16*)smem; u16* sB = sA + 128 * 72;
    const u16* XB = (const u16*)(ws + OFF_XB); const u16* WOUT = (const u16*)(ws + OFF_WOUT); const u16* MERGED = (const u16*)(ws + OFF_MERGED);
    u16* Z = (u16*)(ws + OFF_Z);
    const int t_ = tid_opaque();
    const int lane = t_ & 63, wave = t_ >> 6, wm = wave >> 1, wn = wave & 1, fr = lane & 15, fg = lane >> 4;
    for (int it = blockIdx.x; it < 128 * 8; it += gridDim.x) {
        const int ct = it & 7, tt = it >> 3;
        f32x4 acc[4][4]; zero_acc<4, 4>(acc);
        auto rowW = [=](int r) { return WOUT + (size_t)(ct * 128 + r) * 1024; };
        auto rowM = [=](int r) { return MERGED + (size_t)(tt * 128 + r) * 1024; };
        gemm_acc<4, 4>(acc, rowW, rowM, 1024, sA, sB);
#pragma unroll
        for (int i = 0; i < 4; ++i)
#pragma unroll
            for (int j = 0; j < 4; ++j) {
                const int m = ct * 128 + wm * 64 + 16 * i + 4 * fg, n = tt * 128 + wn * 64 + 16 * j + fr;
                const uint2 xv = *(const uint2*)(XB + (size_t)n * 1024 + m);
                f32x4 v = acc[i][j];
                v[0] += ALPHA_F * bflo(xv.x); v[1] += ALPHA_F * bfhi(xv.x); v[2] += ALPHA_F * bflo(xv.y); v[3] += ALPHA_F * bfhi(xv.y);
                *(uint2*)(Z + (size_t)n * 1024 + m) = pack4(v);
            }
    }
}

__device__ __forceinline__ void ln_row16(float (&v)[16], const float* gam, const float* bet, int lane) {
    float s = 0.f;
#pragma unroll
    for (int i = 0; i < 16; ++i) s += v[i];
#pragma unroll
    for (int o = 32; o >= 1; o >>= 1) s += __shfl_xor(s, o);
    const float mu = s * (1.f / 1024.f);
    float q = 0.f;
#pragma unroll
    for (int i = 0; i < 16; ++i) { v[i] -= mu; q += v[i] * v[i]; }
#pragma unroll
    for (int o = 32; o >= 1; o >>= 1) q += __shfl_xor(q, o);
    const float rstd = rsqrtf(q * (1.f / 1024.f) + LN_EPS_F);
#pragma unroll
    for (int hh = 0; hh < 2; ++hh) {
        const int c = hh * 512 + lane * 8;
        const float4 g0 = *(const float4*)(gam + c), g1 = *(const float4*)(gam + c + 4), b0 = *(const float4*)(bet + c), b1 = *(const float4*)(bet + c + 4);
        v[8 * hh + 0] = v[8 * hh + 0] * rstd * g0.x + b0.x; v[8 * hh + 1] = v[8 * hh + 1] * rstd * g0.y + b0.y;
        v[8 * hh + 2] = v[8 * hh + 2] * rstd * g0.z + b0.z; v[8 * hh + 3] = v[8 * hh + 3] * rstd * g0.w + b0.w;
        v[8 * hh + 4] = v[8 * hh + 4] * rstd * g1.x + b1.x; v[8 * hh + 5] = v[8 * hh + 5] * rstd * g1.y + b1.y;
        v[8 * hh + 6] = v[8 * hh + 6] * rstd * g1.z + b1.z; v[8 * hh + 7] = v[8 * hh + 7] * rstd * g1.w + b1.w;
    }
}
__device__ __forceinline__ void unpack8(const uint4 w, float* v) {
    v[0] = bflo(w.x); v[1] = bfhi(w.x); v[2] = bflo(w.y); v[3] = bfhi(w.y); v[4] = bflo(w.z); v[5] = bfhi(w.z); v[6] = bflo(w.w); v[7] = bfhi(w.w);
}

__device__ __forceinline__ void router_phase(const Params& p, int layer, unsigned char* smem) {
    unsigned char* ws = ws_opaque(p.ws);
    u16* sA = (u16*)smem; u16* sB = sA + 128 * 72; float* L = (float*)smem;
    const u16* Z = (const u16*)(ws + OFF_Z); u16* XB = (u16*)(ws + OFF_XB); const u16* RW = (const u16*)(ws + OFF_RW);
    unsigned* cnt = (unsigned*)(ws + OFF_CNT); unsigned* LIST = (unsigned*)(ws + OFF_LIST); float* GATEW = (float*)(ws + OFF_GATEW);
    const float* gam = p.in[20] + layer * 1024; const float* bet = p.in[21] + layer * 1024; const float* rbias = p.in[23] + layer * 64;
    const int t = tid_opaque(), lane = t & 63, wave = t >> 6, wm = wave >> 1, wn = wave & 1, fr = lane & 15, fg = lane >> 4;
    for (int tt = blockIdx.x; tt < 128; tt += gridDim.x) {
        for (int i = 0; i < 32; ++i) {
            const size_t row = (size_t)tt * 128 + wave * 32 + i;
            float v[16];
            unpack8(*(const uint4*)(Z + row * 1024 + lane * 8), v); unpack8(*(const uint4*)(Z + row * 1024 + 512 + lane * 8), v + 8);
            ln_row16(v, gam, bet, lane);
            *(uint4*)(XB + row * 1024 + lane * 8) = make_uint4(pack2(v[0], v[1]), pack2(v[2], v[3]), pack2(v[4], v[5]), pack2(v[6], v[7]));
            *(uint4*)(XB + row * 1024 + 512 + lane * 8) = make_uint4(pack2(v[8], v[9]), pack2(v[10], v[11]), pack2(v[12], v[13]), pack2(v[14], v[15]));
        }
        __threadfence_block();
        __syncthreads();
        f32x4 acc[4][4]; zero_acc<4, 4>(acc);
        auto rowR = [=](int r) { return RW + (size_t)(r & 63) * 1024; };
        auto rowX = [=](int r) { return (const u16*)XB + (size_t)(tt * 128 + r) * 1024; };
        gemm_acc<4, 4>(acc, rowR, rowX, 1024, sA, sB);
        __syncthreads();
        if (wm == 0) {
#pragma unroll
            for (int i = 0; i < 4; ++i)
#pragma unroll
                for (int j = 0; j < 4; ++j)
#pragma unroll
                    for (int r = 0; r < 4; ++r) L[(wn * 64 + 16 * j + fr) * 65 + 16 * i + 4 * fg + r] = acc[i][j][r];
        }
        __syncthreads();
        if (t < 128) {
            float* Lr = L + t * 65;
            for (int e = 0; e < 64; ++e) Lr[e] = sigmoidf_(Lr[e]) + rbias[e];
            float gs[8];
#pragma unroll
            for (int gI = 0; gI < 8; ++gI) {
                float m1 = -3e38f, m2 = -3e38f;
#pragma unroll
                for (int k = 0; k < 8; ++k) { const float v = Lr[gI * 8 + k]; if (v > m1) { m2 = m1; m1 = v; } else if (v > m2) m2 = v; }
                gs[gI] = m1 + m2;
            }
            unsigned gmask = 0u;
#pragma unroll
            for (int nsel = 0; nsel < 4; ++nsel) {
                float best = -3e38f; int bi = 0;
#pragma unroll
                for (int gI = 0; gI < 8; ++gI) if (!((gmask >> gI) & 1u) && gs[gI] > best) { best = gs[gI]; bi = gI; }
                gmask |= 1u << bi;
            }
            unsigned long long chosen = 0ull; int eidx[6]; float sraw[6]; float ssum = 0.f;
#pragma unroll
            for (int k = 0; k < 6; ++k) {
                float best = -3e38f; int be = 0;
                for (int e = 0; e < 64; ++e) {
                    if (((gmask >> (e >> 3)) & 1u) && !((chosen >> e) & 1ull)) { const float v = Lr[e]; if (v > best) { best = v; be = e; } }
                }
                chosen |= 1ull << be; eidx[k] = be; sraw[k] = best - rbias[be]; ssum += sraw[k];
            }
            const unsigned tok = (unsigned)(tt * 128 + t);
#pragma unroll
            for (int k = 0; k < 6; ++k) {
                const unsigned pos = atomicAdd(&cnt[eidx[k]], 1u);
                LIST[(size_t)eidx[k] * 16384 + pos] = tok * 8u + (unsigned)k;
                GATEW[tok * 8u + k] = sraw[k] / ssum * 2.5f;
            }
        }
        __syncthreads();
    }
}

__device__ __forceinline__ void moe_prefix(const Params& p, int* pre) {
    if (threadIdx.x == 0) {
        const unsigned* cnt = (const unsigned*)(ws_opaque(p.ws) + OFF_CNT);
        int a = 0;
        for (int e = 0; e < 64; ++e) { pre[e] = a; a += (int)((cnt[e] + 127u) >> 7); }
        pre[64] = a; a += 128; pre[65] = a;
    }
    __syncthreads();
}

__device__ __forceinline__ void moe_up_phase(const Params& p, unsigned char* smem) {
    unsigned char* ws = ws_opaque(p.ws);
    u16* sA = (u16*)smem; u16* sB = sA + 128 * 72; int* pre = (int*)(smem + SMEM_PRE_OFF);
    const u16* XB = (const u16*)(ws + OFF_XB); const u16* WUP = (const u16*)(ws + OFF_WUP); u16* H = (u16*)(ws + OFF_H);
    const unsigned* cnt = (const unsigned*)(ws + OFF_CNT); const unsigned* LIST = (const unsigned*)(ws + OFF_LIST);
    const int t_ = tid_opaque();
    const int lane = t_ & 63, wave = t_ >> 6, wm = wave >> 1, wn = wave & 1, fr = lane & 15, fg = lane >> 4;
    moe_prefix(p, pre);
    const int total = pre[65] * 4;
    for (int it = blockIdx.x; it < total; it += gridDim.x) {
        const int bi = it >> 2, nt = it & 3;
        int e = 0; while (pre[e + 1] <= bi) ++e;
        const int rb = bi - pre[e]; const int ce = (e < 64) ? (int)cnt[e] : T_TOK;
        f32x4 acc[4][4]; zero_acc<4, 4>(acc);
        auto rowW = [=](int r) { return WUP + ((size_t)e * 512 + nt * 128 + r) * 1024; };
        auto rowX = [=](int r) {
            const int idx = rb * 128 + r; unsigned tok = 0u;
            if (idx < ce) tok = (e < 64) ? (LIST[(size_t)e * 16384 + idx] >> 3) : (unsigned)idx;
            return XB + (size_t)tok * 1024;
        };
        gemm_acc<4, 4>(acc, rowW, rowX, 1024, sA, sB);
        const size_t hrow0 = (size_t)pre[e] * 128 + (size_t)rb * 128;
#pragma unroll
        for (int i = 0; i < 4; i += 2)
#pragma unroll
            for (int j = 0; j < 4; ++j) {
                const int n = wn * 64 + 16 * j + fr;
                const int col = 16 * ((nt * 8 + wm * 4 + i) >> 1) + 4 * fg;
                f32x4 v;
#pragma unroll
                for (int r = 0; r < 4; ++r) v[r] = siluf_(acc[i][j][r]) * acc[i + 1][j][r];
                *(uint2*)(H + (hrow0 + n) * 256 + col) = pack4(v);
            }
    }
}

__device__ __forceinline__ void moe_down_phase(const Params& p, unsigned char* smem) {
    unsigned char* ws = ws_opaque(p.ws);
    u16* sA = (u16*)smem; u16* sB = sA + 128 * 72; int* pre = (int*)(smem + SMEM_PRE_OFF);
    const u16* XB = (const u16*)(ws + OFF_XB); const u16* WD = (const u16*)(ws + OFF_WD); const u16* H = (const u16*)(ws + OFF_H);
    u16* Z = (u16*)(ws + OFF_Z); u16* YS = (u16*)(ws + OFF_YSLOT);
    const unsigned* cnt = (const unsigned*)(ws + OFF_CNT); const unsigned* LIST = (const unsigned*)(ws + OFF_LIST); const float* GATEW = (const float*)(ws + OFF_GATEW);
    const int t_ = tid_opaque();
    const int lane = t_ & 63, wave = t_ >> 6, wm = wave >> 1, wn = wave & 1, fr = lane & 15, fg = lane >> 4;
    moe_prefix(p, pre);
    const int total = pre[65] * 8;
    for (int it = blockIdx.x; it < total; it += gridDim.x) {
        const int bi = it >> 3, nt = it & 7;
        int e = 0; while (pre[e + 1] <= bi) ++e;
        const int rb = bi - pre[e]; const int ce = (e < 64) ? (int)cnt[e] : T_TOK;
        const size_t hrow0 = (size_t)pre[e] * 128 + (size_t)rb * 128;
        f32x4 acc[4][4]; zero_acc<4, 4>(acc);
        auto rowW = [=](int r) { return WD + ((size_t)e * 1024 + nt * 128 + r) * 256; };
        auto rowH = [=](int r) { return H + (hrow0 + r) * 256; };
        gemm_acc<4, 4>(acc, rowW, rowH, 256, sA, sB);
#pragma unroll
        for (int j = 0; j < 4; ++j) {
            const int n = wn * 64 + 16 * j + fr, idx = rb * 128 + n;
            if (idx < ce) {
                if (e < 64) {
                    const unsigned ent = LIST[(size_t)e * 16384 + idx]; const float gw = GATEW[ent];
                    u16* dst = YS + ((size_t)(ent >> 3) * 6 + (ent & 7u)) * 1024 + nt * 128 + wm * 64 + 4 * fg;
#pragma unroll
                    for (int i = 0; i < 4; ++i) *(uint2*)(dst + 16 * i) = pack4(acc[i][j] * gw);
                } else {
                    const size_t o = (size_t)idx * 1024 + nt * 128 + wm * 64 + 4 * fg;
#pragma unroll
                    for (int i = 0; i < 4; ++i) {
                        const uint2 xv = *(const uint2*)(XB + o + 16 * i);
                        f32x4 v = acc[i][j];
                        v[0] += ALPHA_F * bflo(xv.x); v[1] += ALPHA_F * bfhi(xv.x); v[2] += ALPHA_F * bflo(xv.y); v[3] += ALPHA_F * bfhi(xv.y);
                        *(uint2*)(Z + o + 16 * i) = pack4(v);
                    }
                }
            }
        }
    }
}

__device__ __forceinline__ void combine_phase(const Params& p, int layer) {
    unsigned char* ws = ws_opaque(p.ws);
    const u16* Z = (const u16*)(ws + OFF_Z); const u16* YS = (const u16*)(ws + OFF_YSLOT); u16* XB = (u16*)(ws + OFF_XB);
    const float* gam = p.in[30] + layer * 1024; const float* bet = p.in[31] + layer * 1024;
    const int t = tid_opaque(), lane = t & 63, wave = t >> 6;
    for (int it = blockIdx.x; it < 512; it += gridDim.x) {
        for (int i = 0; i < 8; ++i) {
            const size_t row = (size_t)it * 32 + wave * 8 + i;
            float v[16];
            unpack8(*(const uint4*)(Z + row * 1024 + lane * 8), v); unpack8(*(const uint4*)(Z + row * 1024 + 512 + lane * 8), v + 8);
#pragma unroll
            for (int k = 0; k < 6; ++k) {
                float y[16];
                unpack8(*(const uint4*)(YS + (row * 6 + k) * 1024 + lane * 8), y); unpack8(*(const uint4*)(YS + (row * 6 + k) * 1024 + 512 + lane * 8), y + 8);
#pragma unroll
                for (int c = 0; c < 16; ++c) v[c] += y[c];
            }
            ln_row16(v, gam, bet, lane);
            *(uint4*)(XB + row * 1024 + lane * 8) = make_uint4(pack2(v[0], v[1]), pack2(v[2], v[3]), pack2(v[4], v[5]), pack2(v[6], v[7]));
            *(uint4*)(XB + row * 1024 + 512 + lane * 8) = make_uint4(pack2(v[8], v[9]), pack2(v[10], v[11]), pack2(v[12], v[13]), pack2(v[14], v[15]));
            if (layer == 1) {
                float* op = p.out + row * 1024;
                *(float4*)(op + lane * 8) = make_float4(v[0], v[1], v[2], v[3]); *(float4*)(op + lane * 8 + 4) = make_float4(v[4], v[5], v[6], v[7]);
                *(float4*)(op + 512 + lane * 8) = make_float4(v[8], v[9], v[10], v[11]); *(float4*)(op + 512 + lane * 8 + 4) = make_float4(v[12], v[13], v[14], v[15]);
            }
        }
    }
}

__device__ __forceinline__ void run_phase(const Params& p, int ph, int layer, unsigned char* smem) {
    switch (ph) {
        case 0: prep_phase(p, layer, layer == 0, smem); break;
        case 1: inproj_phase(p, layer, smem); break;
        case 2: p2a_phase(p, layer, smem); break;
        case 3: p2b_phase(p, layer, smem); break;
        case 4: merge_phase(p, smem); break;
        case 5: wout_phase(p, smem); break;
        case 6: router_phase(p, layer, smem); break;
        case 7: moe_up_phase(p, smem); break;
        case 8: moe_down_phase(p, smem); break;
        default: combine_phase(p, layer); if (layer == 0) prep_phase(p, 1, false, smem); break;
    }
}


#define XB_TMO      128
#define XB_XCNT(j)  (256  + 64 * (j))
#define XB_XSUB(j)  (1280 + 64 * (j))
#define XB_XGEN(j)  (2304 + 64 * (j))
#define XB_TOP      3328
#define XB_TOPGEN   3392
#define XCD_BAR_WORDS 3456
#define XB_SPIN_CAP (1u << 22)
#define LAS __attribute__((address_space(3)))
__device__ __forceinline__ unsigned xb_ld(unsigned* p)              { return __hip_atomic_load(p, __ATOMIC_RELAXED, __HIP_MEMORY_SCOPE_AGENT); }
__device__ __forceinline__ unsigned xb_add(unsigned* p, unsigned v) { return __hip_atomic_fetch_add(p, v, __ATOMIC_RELAXED, __HIP_MEMORY_SCOPE_AGENT); }
__device__ __forceinline__ unsigned xb_xcc_id() { return (unsigned)__builtin_amdgcn_s_getreg((3 << 11) | 20) & 0xFu; }
#define XB_SPIN(cond, bar) do { unsigned _sp = 0; while (cond) { __builtin_amdgcn_s_sleep(1); \
    if ((++_sp & 255u) == 0u) { if (xb_ld(&(bar)[XB_TMO])) break; if (_sp > XB_SPIN_CAP) { atomicAdd(&(bar)[XB_TMO], 1u); break; } } } } while (0)
struct XcdBarrier { unsigned* bar; unsigned x; volatile LAS unsigned* st; };
__device__ __forceinline__ XcdBarrier xcd_barrier_post(unsigned* bar, volatile LAS unsigned* st) {
    XcdBarrier b; b.bar = bar; b.x = xb_xcc_id(); b.st = st;
    if (threadIdx.x == 0) (void)xb_add(&bar[XB_XCNT(b.x)], 1u);
    return b;
}
__device__ __forceinline__ void xcd_barrier_complete(unsigned* bar, unsigned x, unsigned& nloc, unsigned& nx) {
    const unsigned G = gridDim.x * gridDim.y * gridDim.z;
    unsigned sum, cnt, mine, sp = 0u;
    for (;;) {
        sum = 0u; cnt = 0u; mine = 0u;
#pragma unroll
        for (unsigned j = 0; j < 16; ++j) { const unsigned c = xb_ld(&bar[XB_XCNT(j)]); sum += c; cnt += (c > 0u) ? 1u : 0u; mine = (j == x) ? c : mine; }
        if (sum == G) break;
        __builtin_amdgcn_s_sleep(1);
        if ((++sp & 255u) == 0u) { if (xb_ld(&bar[XB_TMO])) break; if (sp > XB_SPIN_CAP) { atomicAdd(&bar[XB_TMO], 1u); break; } }
    }
    nloc = mine > 0u ? mine : 1u; nx = cnt > 0u ? cnt : 1u;
}
__device__ __forceinline__ void xcd_barrier(const XcdBarrier& b) {
    asm volatile("s_waitcnt vmcnt(0)" ::: "memory");
    __syncthreads();
    if (threadIdx.x == 0) {
        unsigned* bar = b.bar;
        __builtin_amdgcn_s_waitcnt(0);
        unsigned nloc = b.st[0], nx = b.st[1];
        if (nloc == 0u) { xcd_barrier_complete(bar, b.x, nloc, nx); b.st[0] = nloc; b.st[1] = nx; }
        const unsigned old = xb_add(&bar[XB_XSUB(b.x)], 1u);
        const unsigned gen = old / nloc;
        if (old + 1u == (gen + 1u) * nloc) {
            __builtin_amdgcn_fence(__ATOMIC_RELEASE, "agent");
            asm volatile("s_waitcnt vmcnt(0)" ::: "memory");
            const unsigned og = xb_add(&bar[XB_TOP], 1u);
            const unsigned tg = og / nx;
            if (og + 1u == (tg + 1u) * nx) xb_add(&bar[XB_TOPGEN], 1u);
            else XB_SPIN(xb_ld(&bar[XB_TOPGEN]) == tg, bar);
            __builtin_amdgcn_fence(__ATOMIC_ACQUIRE, "agent");
            xb_add(&bar[XB_XGEN(b.x)], 1u);
            asm volatile("s_waitcnt vmcnt(0)" ::: "memory");
        } else {
            XB_SPIN(xb_ld(&bar[XB_XGEN(b.x)]) == gen, bar);
            __builtin_amdgcn_fence(__ATOMIC_ACQUIRE, "agent");
            asm volatile("s_waitcnt vmcnt(0)" ::: "memory");
        }
    }
    __syncthreads();
}

#if ONE_LAUNCH
__device__ __forceinline__ void run_layer(const Params& p, const int layer, unsigned char* smem, const XcdBarrier& xb) {
    inproj_phase(p, layer, smem);      xcd_barrier(xb);
    p2a_phase(p, layer, smem);         xcd_barrier(xb);
    p2b_phase(p, layer, smem);         xcd_barrier(xb);
    merge_phase(p, smem);              xcd_barrier(xb);
    wout_phase(p, smem);               xcd_barrier(xb);
    router_phase(p, layer, smem);      xcd_barrier(xb);
    moe_up_phase(p, smem);             xcd_barrier(xb);
    moe_down_phase(p, smem);           xcd_barrier(xb);
    combine_phase(p, layer);
    if (layer == 0) { prep_phase(p, 1, false, smem); xcd_barrier(xb); }
}
__global__ void __launch_bounds__(NTHR, 2) k_mega(Params p) {
    __shared__ __attribute__((aligned(16))) unsigned char smem[SMEM_BYTES];
    volatile LAS unsigned* st = (volatile LAS unsigned*)(smem + SMEM_BAR_OFF);
    if (threadIdx.x == 0) { st[0] = 0u; st[1] = 0u; st[2] = 0u; st[3] = 0u; }
    __syncthreads();
    XcdBarrier xb = xcd_barrier_post((unsigned*)(p.ws + OFF_BAR), st);
    prep_phase(p, 0, true, smem);
    xcd_barrier(xb);
    run_layer(p, 0, smem, xb);
    run_layer(p, 1, smem, xb);
}
#endif

#if !ONE_LAUNCH
template <int PH> __global__ void __launch_bounds__(NTHR, 2) k_phase(Params p, int layer) {
    __shared__ __attribute__((aligned(16))) unsigned char smem[SMEM_BYTES];
    run_phase(p, PH, layer, smem);
}
#endif

extern "C" void kernel_launch(void* const* d_in, const int* in_sizes, int n_in, void* d_out, int out_size, void* d_ws, size_t ws_size, hipStream_t stream) {
    if (ws_size < WS_TOTAL) { fprintf(stderr, "kernel_launch: workspace too small: %zu < %zu\n", ws_size, (size_t)WS_TOTAL); return; }
    Params p{};
    for (int i = 0; i < 32; ++i) p.in[i] = (const float*)d_in[i];
    p.out = (float*)d_out; p.ws = (unsigned char*)d_ws;
    (void)hipMemsetAsync((char*)d_ws + OFF_BAR, 0, 16384, stream);
#if ONE_LAUNCH
    static int grid_blocks = 0;
    if (!grid_blocks) {
        int dev = 0, cus = 0, per_cu = 0;
        (void)hipGetDevice(&dev);
        (void)hipDeviceGetAttribute(&cus, hipDeviceAttributeMultiprocessorCount, dev);
        if (hipOccupancyMaxActiveBlocksPerMultiprocessor(&per_cu, (const void*)k_mega, NTHR, 0) != hipSuccess || per_cu < 1) { fprintf(stderr, "kernel_launch: occupancy query failed\n"); return; }
        if (per_cu > 2) per_cu = 2;
        grid_blocks = cus * per_cu;
    }
    void* args[] = {&p};
    hipError_t e = hipLaunchCooperativeKernel((const void*)k_mega, dim3(grid_blocks), dim3(NTHR), args, 0, stream);
    if (e != hipSuccess) fprintf(stderr, "cooperative launch failed: %s (grid %d)\n", hipGetErrorString(e), grid_blocks);
#else
    const int G = 512;
    hipLaunchKernelGGL(k_phase<0>, dim3(G), dim3(NTHR), 0, stream, p, 0);
    for (int layer = 0; layer < 2; ++layer) {
        hipLaunchKernelGGL(k_phase<1>, dim3(G), dim3(NTHR), 0, stream, p, layer);
        hipLaunchKernelGGL(k_phase<2>, dim3(G), dim3(NTHR), 0, stream, p, layer);
        hipLaunchKernelGGL(k_phase<3>, dim3(G), dim3(NTHR), 0, stream, p, layer);
        hipLaunchKernelGGL(k_phase<4>, dim3(G), dim3(NTHR), 0, stream, p, layer);
        hipLaunchKernelGGL(k_phase<5>, dim3(G), dim3(NTHR), 0, stream, p, layer);
        hipLaunchKernelGGL(k_phase<6>, dim3(G), dim3(NTHR), 0, stream, p, layer);
        hipLaunchKernelGGL(k_phase<7>, dim3(G), dim3(NTHR), 0, stream, p, layer);
        hipLaunchKernelGGL(k_phase<8>, dim3(G), dim3(NTHR), 0, stream, p, layer);
        hipLaunchKernelGGL(k_phase<9>, dim3(G), dim3(NTHR), 0, stream, p, layer);
    }
#endif
}
```

```cpp
#include <hip/hip_runtime.h>
#include <stdint.h>
#include <stdio.h>

#ifndef ONE_LAUNCH
#define ONE_LAUNCH 1
#endif

typedef unsigned short u16;
typedef short bf16x8 __attribute__((ext_vector_type(8)));
typedef short bf16x4 __attribute__((ext_vector_type(4)));
typedef float f32x4 __attribute__((ext_vector_type(4)));
typedef unsigned u32x4 __attribute__((ext_vector_type(4)));
typedef unsigned u32x2 __attribute__((ext_vector_type(2)));

#define NTHR 256
#define T_TOK 16384
#define SEQ 2048
#define DM 1024
#define ALPHA_F 1.41421356237f
#define LN_EPS_F 1e-5f
#define NEGBIG (-1e30f)
#define LDU 2560
#define LDACT 1280
#define SMEM_BYTES 66560
#define SMEM_PRE_OFF 65536
#define SMEM_BAR_OFF 66048

struct Params { const float* in[32]; float* out; unsigned char* ws; };

constexpr size_t al256(size_t x) { return (x + 255) & ~(size_t)255; }
constexpr size_t OFF_BAR   = 0;
constexpr size_t OFF_CNT   = 16384;
constexpr size_t OFF_BIAS1 = OFF_CNT + 1024;
constexpr size_t OFF_XB    = 32768;
constexpr size_t SZ_TD     = (size_t)T_TOK * 1024 * 2;
constexpr size_t OFF_Z     = OFF_XB + SZ_TD;
constexpr size_t OFF_A     = OFF_Z + SZ_TD;
constexpr size_t OFF_U     = OFF_A;
constexpr size_t SZ_U      = (size_t)T_TOK * LDU * 2;
constexpr size_t OFF_UT    = OFF_U + SZ_U;
constexpr size_t SZ_UT     = (size_t)8 * 1024 * 2048 * 2;
constexpr size_t SZ_A      = (size_t)T_TOK * 6 * 1024 * 2;
static_assert(SZ_A >= SZ_U + SZ_UT, "region A");
constexpr size_t OFF_YSLOT = OFF_A;
constexpr size_t OFF_B     = OFF_A + SZ_A;
constexpr size_t OFF_ACT   = OFF_B;
constexpr size_t SZ_ACT    = (size_t)T_TOK * LDACT * 2;
constexpr size_t OFF_MERGED= OFF_ACT + SZ_ACT;
constexpr size_t SZ_B      = SZ_ACT + SZ_TD;
constexpr size_t OFF_H     = OFF_B;
static_assert(SZ_B >= (size_t)(98304 + 64 * 127 + 16384 + 128) * 256 * 2, "region B");
constexpr size_t OFF_KC    = OFF_B + SZ_B;
constexpr size_t SZ_KC     = al256(((size_t)T_TOK * 64 + 1024) * 2);
constexpr size_t OFF_VC    = OFF_KC + SZ_KC;
constexpr size_t OFF_KCMP  = OFF_VC + SZ_KC;
constexpr size_t OFF_VCMPT = OFF_KCMP + 1024 * 64 * 2;
constexpr size_t OFF_KVT   = OFF_VCMPT + 8 * 64 * 128 * 2;
constexpr size_t OFF_LIST  = OFF_KVT + (size_t)512 * 8192 * 4;
constexpr size_t OFF_GATEW = OFF_LIST + (size_t)64 * 16384 * 4;
constexpr size_t OFF_WINT  = OFF_GATEW + (size_t)T_TOK * 8 * 4;
constexpr size_t OFF_PT    = OFF_WINT + (size_t)7680 * 1024 * 2;
constexpr size_t OFF_WOUT  = OFF_PT + (size_t)1280 * 1024 * 2;
constexpr size_t OFF_RW    = OFF_WOUT + (size_t)1024 * 1024 * 2;
constexpr size_t OFF_WUP   = OFF_RW + (size_t)64 * 1024 * 2;
constexpr size_t OFF_WD    = OFF_WUP + (size_t)65 * 512 * 1024 * 2;
constexpr size_t OFF_W1T   = OFF_WD + (size_t)65 * 1024 * 256 * 2;
constexpr size_t OFF_W2T   = OFF_W1T + (size_t)2 * 256 * 2048 * 2;
constexpr size_t WS_TOTAL  = OFF_W2T + (size_t)2 * 64 * 256 * 2;

#define MFMA16(a, b, c) __builtin_amdgcn_mfma_f32_16x16x32_bf16((a), (b), (c), 0, 0, 0)

__device__ __forceinline__ u16 f2bf(float f) { uint32_t u = __float_as_uint(f); u += 0x7fffu + ((u >> 16) & 1u); return (u16)(u >> 16); }
__device__ __forceinline__ float bf2f(u16 h) { return __uint_as_float(((uint32_t)h) << 16); }
__device__ __forceinline__ uint32_t pack2(float a, float b) { return (uint32_t)f2bf(a) | ((uint32_t)f2bf(b) << 16); }
__device__ __forceinline__ uint2 pack4(f32x4 v) { return make_uint2(pack2(v[0], v[1]), pack2(v[2], v[3])); }
__device__ __forceinline__ float sigmoidf_(float x) { return 1.f / (1.f + __expf(-x)); }
__device__ __forceinline__ float siluf_(float x) { return x / (1.f + __expf(-x)); }
__device__ __forceinline__ float bflo(uint32_t w) { return __uint_as_float(w << 16); }
__device__ __forceinline__ float bfhi(uint32_t w) { return __uint_as_float(w & 0xffff0000u); }

__device__ __forceinline__ int tid_opaque() { int t = threadIdx.x; asm volatile("" : "+v"(t)); return t; }
__device__ __forceinline__ unsigned char* ws_opaque(unsigned char* w) {
    unsigned lo = (unsigned)(uintptr_t)w, hi = (unsigned)((uintptr_t)w >> 32);
    asm volatile("" : "+v"(lo), "+v"(hi));
    lo = __builtin_amdgcn_readfirstlane(lo); hi = __builtin_amdgcn_readfirstlane(hi);
    return (unsigned char*)(((uintptr_t)hi << 32) | (uintptr_t)lo);
}

template <int WM, int WN> __device__ __forceinline__ void zero_acc(f32x4 (&acc)[WM][WN]) {
#pragma unroll
    for (int i = 0; i < WM; ++i)
#pragma unroll
        for (int j = 0; j < WN; ++j) acc[i][j] = (f32x4){0.f, 0.f, 0.f, 0.f};
}

template <int WM, int WN, class FA, class FB>
__device__ __forceinline__ void gemm_acc(f32x4 (&acc)[WM][WN], FA rowA, FB rowB, int K, unsigned char* sbase) {
    constexpr int A_BYTES = 32 * WM * 128, B_BYTES = 32 * WN * 128, BUF = A_BYTES + B_BYTES;
    const int tid = tid_opaque(), lane = tid & 63, wave = tid >> 6;
    const int wm = wave >> 1, wn = wave & 1;
    const int fr = lane & 15, fg = lane >> 4;
    const int lrow = lane >> 3, lch = (lane & 7) ^ lrow;
    const u16* pa[WM]; const u16* pb[WN];
#pragma unroll
    for (int i = 0; i < WM; ++i) pa[i] = rowA((wave + 4 * i) * 8 + lrow) + lch * 8;
#pragma unroll
    for (int j = 0; j < WN; ++j) pb[j] = rowB((wave + 4 * j) * 8 + lrow) + lch * 8;
    unsigned char* const ldst = sbase + wave * 1024 + lane * 16;
    __syncthreads();
#pragma unroll
    for (int i = 0; i < WM; ++i) __builtin_amdgcn_global_load_lds((const unsigned*)(pa[i]), (unsigned*)(ldst + i * 4096), 16, 0, 0);
#pragma unroll
    for (int j = 0; j < WN; ++j) __builtin_amdgcn_global_load_lds((const unsigned*)(pb[j]), (unsigned*)(ldst + A_BYTES + j * 4096), 16, 0, 0);
    const int nk = K >> 6;
    for (int kt = 0; kt < nk; ++kt) {
        __syncthreads();
        if (kt + 1 < nk) {
            unsigned char* const d = ldst + ((kt + 1) & 1) * BUF;
            const int ko = (kt + 1) * 64;
#pragma unroll
            for (int i = 0; i < WM; ++i) __builtin_amdgcn_global_load_lds((const unsigned*)(pa[i] + ko), (unsigned*)(d + i * 4096), 16, 0, 0);
#pragma unroll
            for (int j = 0; j < WN; ++j) __builtin_amdgcn_global_load_lds((const unsigned*)(pb[j] + ko), (unsigned*)(d + A_BYTES + j * 4096), 16, 0, 0);
        }
        const unsigned char* a0 = sbase + (kt & 1) * BUF + (wm * 16 * WM + fr) * 128;
        const unsigned char* b0 = sbase + (kt & 1) * BUF + A_BYTES + (wn * 16 * WN + fr) * 128;
#pragma unroll
        for (int ks = 0; ks < 2; ++ks) {
            const int co = ((4 * ks + fg) ^ (fr & 7)) << 4;
            bf16x8 a[WM], b[WN];
#pragma unroll
            for (int i = 0; i < WM; ++i) a[i] = *(const bf16x8*)(a0 + i * 2048 + co);
#pragma unroll
            for (int j = 0; j < WN; ++j) b[j] = *(const bf16x8*)(b0 + j * 2048 + co);
#pragma unroll
            for (int i = 0; i < WM; ++i)
#pragma unroll
                for (int j = 0; j < WN; ++j) acc[i][j] = MFMA16(a[i], b[j], acc[i][j]);
        }
    }
}

__device__ __forceinline__ void stage_rows64(u16* s, const u16* g, int ld) {
    const int t = tid_opaque(), r = t >> 2, c = (t & 3) * 16;
    const uint4* p = (const uint4*)(g + (size_t)r * ld + c);
    const uint4 v0 = p[0], v1 = p[1];
    *(uint4*)&s[r * 72 + c] = v0; *(uint4*)&s[r * 72 + c + 8] = v1;
}
__device__ __forceinline__ void qk64(const u16* sK, const bf16x8 (&qf)[2], f32x4 (&s)[4], int lane) {
    const int r = lane & 15, g = lane >> 4;
#pragma unroll
    for (int mt = 0; mt < 4; ++mt) {
        s[mt] = (f32x4){0.f, 0.f, 0.f, 0.f};
#pragma unroll
        for (int ks = 0; ks < 2; ++ks) {
            const bf16x8 a = *(const bf16x8*)&sK[(16 * mt + r) * 72 + 32 * ks + 8 * g];
            s[mt] = MFMA16(a, qf[ks], s[mt]);
        }
    }
}
template <int DT>
__device__ __forceinline__ void pv64(const u16* sVt, int vstride, const bf16x8 (&pb)[2], f32x4 (&o)[DT], int lane) {
    const int r = lane & 15, g = lane >> 4;
#pragma unroll
    for (int dt = 0; dt < DT; ++dt)
#pragma unroll
        for (int s2 = 0; s2 < 2; ++s2) {
            const u16* p = &sVt[(16 * dt + r) * vstride + 32 * s2 + 4 * g];
            const u32x2 lo = *(const u32x2*)p, hi = *(const u32x2*)(p + 16);
            const u32x4 av = {lo.x, lo.y, hi.x, hi.y};
            o[dt] = MFMA16(__builtin_bit_cast(bf16x8, av), pb[s2], o[dt]);
        }
}
__device__ __forceinline__ void pack_p(const float (&x)[16], bf16x8 (&pb)[2]) {
#pragma unroll
    for (int s2 = 0; s2 < 2; ++s2) {
        const u32x4 tv = {pack2(x[8 * s2 + 0], x[8 * s2 + 1]), pack2(x[8 * s2 + 2], x[8 * s2 + 3]),
                          pack2(x[8 * s2 + 4], x[8 * s2 + 5]), pack2(x[8 * s2 + 6], x[8 * s2 + 7])};
        pb[s2] = __builtin_bit_cast(bf16x8, tv);
    }
}
template <int DT, class F>
__device__ __forceinline__ void flash_step(const u16* sK, const u16* sVt, int vstride, const bf16x8 (&qf)[2],
                                           f32x4 (&o)[DT], float& m, float& l, bool lane_active, F logit, int lane) {
    if (__ballot(lane_active) == 0ull) return;
    f32x4 s[4]; qk64(sK, qf, s, lane);
    const int g = lane >> 4;
    float x[16]; float mx = NEGBIG;
#pragma unroll
    for (int mt = 0; mt < 4; ++mt)
#pragma unroll
        for (int rr = 0; rr < 4; ++rr) {
            bool valid; float v = logit(16 * mt + 4 * g + rr, s[mt][rr], valid);
            v = (valid && lane_active) ? v : NEGBIG; x[mt * 4 + rr] = v; mx = fmaxf(mx, v);
        }
    mx = fmaxf(mx, __shfl_xor(mx, 16)); mx = fmaxf(mx, __shfl_xor(mx, 32));
    const float mn = fmaxf(m, mx), alpha = __expf(m - mn);
    float ps = 0.f;
#pragma unroll
    for (int i = 0; i < 16; ++i) { const float pv = (x[i] > -1e29f) ? __expf(x[i] - mn) : 0.f; x[i] = pv; ps += pv; }
    l = l * alpha + ps; m = mn;
#pragma unroll
    for (int dt = 0; dt < DT; ++dt) o[dt] *= alpha;
    bf16x8 pb[2]; pack_p(x, pb);
    pv64<DT>(sVt, vstride, pb, o, lane);
}

__device__ __forceinline__ void prep_tile(const float* __restrict__ src, int ld_src, int k0, int c0, int nvalid,
                                          u16* __restrict__ dst, int ld_dst, int drow_base, int grp_stride, float* tile) {
    const int t = tid_opaque();
    {
        const int rr = t >> 4, cc = (t & 15) * 4;
#pragma unroll
        for (int ii = 0; ii < 4; ++ii) {
            const int row = rr + 16 * ii;
            float4 v = make_float4(0.f, 0.f, 0.f, 0.f);
            if (cc < nvalid) v = *(const float4*)(src + (size_t)(k0 + row) * ld_src + c0 + cc);
            float* tp = tile + row * 65 + cc; tp[0] = v.x; tp[1] = v.y; tp[2] = v.z; tp[3] = v.w;
        }
    }
    __syncthreads();
    {
        const int j = t >> 2, kk = (t & 3) * 16;
        uint32_t w[8];
#pragma unroll
        for (int i = 0; i < 8; ++i) w[i] = pack2(tile[(kk + 2 * i) * 65 + j], tile[(kk + 2 * i + 1) * 65 + j]);
        u16* dp = dst + (size_t)(drow_base + (j >> 4) * grp_stride + (j & 15)) * ld_dst + k0 + kk;
        *(uint4*)dp = make_uint4(w[0], w[1], w[2], w[3]); *(uint4*)(dp + 8) = make_uint4(w[4], w[5], w[6], w[7]);
    }
    __syncthreads();
}
__device__ __forceinline__ void win_seg(int drow, int& src, int& nvalid) {
    nvalid = 64;
    if (drow < 896) src = drow;
    else if (drow < 1152) src = 1024 + (drow - 896);
    else if (drow < 1408) src = 1280 + (drow - 1152);
    else if (drow < 1920) src = 2048 + (drow - 1408);
    else if (drow < 2176) src = 2560 + (drow - 1920);
    else if (drow < 2240) src = 2816;
    else if (drow < 2304) src = 2880;
    else if (drow < 2368) src = 2944;
    else if (drow < 2432) src = 3072;
    else if (drow < 2496) { src = 3200; nvalid = 12; }
    else if (drow < 2560) { src = 0; nvalid = 0; }
    else if (drow < 2688) src = 896 + (drow - 2560);
    else if (drow < 2944) src = 1280 + (drow - 2688);
    else if (drow < 3456) src = 1536 + (drow - 2944);
    else if (drow < 3520) src = 3008;
    else if (drow < 3584) src = 3136;
    else src = 3212 + (drow - 3584);
}
__device__ __forceinline__ void cvt16(const float* src, u16* dst) {
    const float4 a = ((const float4*)src)[0], b = ((const float4*)src)[1], c = ((const float4*)src)[2], d = ((const float4*)src)[3];
    *(uint4*)dst = make_uint4(pack2(a.x, a.y), pack2(a.z, a.w), pack2(b.x, b.y), pack2(b.z, b.w));
    *(uint4*)(dst + 8) = make_uint4(pack2(c.x, c.y), pack2(c.z, c.w), pack2(d.x, d.y), pack2(d.z, d.w));
}
__device__ __forceinline__ void prep_phase(const Params& p, int layer, bool with_x, unsigned char* smem) {
    float* tile = (float*)smem;
    unsigned char* ws = ws_opaque(p.ws);
    const int nA = 1920, nB = 320, nC = 256, nD = 8320, nE = 4160, nF = 256, nG = 8, nH = 16, nI = 2, nJ = 1, nX = with_x ? 4096 : 0;
    const int total = nA + nB + nC + nD + nE + nF + nG + nH + nI + nJ + nX;
    const int t = tid_opaque();
    for (int it = blockIdx.x; it < total; it += gridDim.x) {
        int idx = it;
        if (idx < nA) {
            const int dg = idx >> 4, kt = idx & 15; int src, nv; win_seg(dg * 64, src, nv);
            prep_tile(p.in[1] + (size_t)layer * 1024 * 7308, 7308, kt * 64, src, nv, (u16*)(ws + OFF_WINT), 1024, dg * 64, 16, tile);
            continue;
        }
        idx -= nA;
        if (idx < nB) {
            const float* src; int K, local; size_t off;
            if (idx < 64) { src = p.in[15] + (size_t)layer * 256 * 1024; K = 256; local = idx; off = 0; }
            else if (idx < 128) { src = p.in[16] + (size_t)layer * 256 * 1024; K = 256; local = idx - 64; off = 262144; }
            else if (idx < 256) { src = p.in[17] + (size_t)layer * 512 * 1024; K = 512; local = idx - 128; off = 524288; }
            else { src = p.in[18] + (size_t)layer * 256 * 1024; K = 256; local = idx - 256; off = 1048576; }
            const int nk = K >> 6, ct = local / nk, kt = local % nk;
            prep_tile(src, 1024, kt * 64, ct * 64, 64, (u16*)(ws + OFF_PT) + off, K, ct * 64, 16, tile);
            continue;
        }
        idx -= nB;
        if (idx < nC) {
            const int ct = idx >> 4, kt = idx & 15;
            prep_tile(p.in[19] + (size_t)layer * 1024 * 1024, 1024, kt * 64, ct * 64, 64, (u16*)(ws + OFF_WOUT), 1024, ct * 64, 16, tile);
            continue;
        }
        idx -= nC;
        if (idx < nD) {
            const int e = idx >> 7, rem = idx & 127, isUp = rem >> 6, r2 = rem & 63, ct = r2 >> 4, kt = r2 & 15;
            const float* src = (e < 64) ? p.in[24 + isUp] + ((size_t)layer * 64 + e) * 1024 * 256 : p.in[27 + isUp] + (size_t)layer * 1024 * 256;
            prep_tile(src, 256, kt * 64, ct * 64, 64, (u16*)(ws + OFF_WUP) + (size_t)e * 512 * 1024, 1024, 32 * (ct * 4) + 16 * isUp, 32, tile);
            continue;
        }
        idx -= nD;
        if (idx < nE) {
            const int e = idx >> 6, r2 = idx & 63, ct = r2 >> 2, kt = r2 & 3;
            const float* src = (e < 64) ? p.in[26] + ((size_t)layer * 64 + e) * 256 * 1024 : p.in[29] + (size_t)layer * 256 * 1024;
            prep_tile(src, 1024, kt * 64, ct * 64, 64, (u16*)(ws + OFF_WD) + (size_t)e * 1024 * 256, 256, ct * 64, 16, tile);
            continue;
        }
        idx -= nE;
        if (idx < nF) {
            const int which = idx >> 7, r2 = idx & 127, ct = r2 >> 5, kt = r2 & 31;
            prep_tile(p.in[which ? 13 : 10] + (size_t)layer * 2048 * 256, 256, kt * 64, ct * 64, 64, (u16*)(ws + OFF_W1T) + (size_t)which * 256 * 2048, 2048, ct * 64, 16, tile);
            continue;
        }
        idx -= nF;
        if (idx < nG) {
            const int which = idx >> 2, kt = idx & 3;
            prep_tile(p.in[which ? 14 : 11] + (size_t)layer * 256 * 64, 64, kt * 64, 0, 64, (u16*)(ws + OFF_W2T) + (size_t)which * 64 * 256, 256, 0, 16, tile);
            continue;
        }
        idx -= nG;
        if (idx < nH) {
            cvt16(p.in[22] + (size_t)layer * 65536 + (size_t)idx * 4096 + t * 16, (u16*)(ws + OFF_RW) + (size_t)idx * 4096 + t * 16);
            continue;
        }
        idx -= nH;
        if (idx < nI) {
            const float* pe = p.in[idx ? 12 : 9] + (size_t)layer * 2048;
            const float* w1 = p.in[idx ? 13 : 10] + (size_t)layer * 2048 * 256;
            float s = 0.f;
            for (int i = 0; i < 2048; ++i) s += pe[i] * w1[(size_t)i * 256 + t];
            ((float*)(ws + OFF_BIAS1))[idx * 256 + t] = s;
            continue;
        }
        idx -= nI;
        if (idx < nJ) {
            if (t < 128) ((unsigned*)(ws + OFF_CNT))[t] = 0u;
            u16* kcp = (u16*)(ws + OFF_KC) + (size_t)T_TOK * 64; u16* vcp = (u16*)(ws + OFF_VC) + (size_t)T_TOK * 64;
            for (int i = t; i < 1024; i += NTHR) { kcp[i] = 0; vcp[i] = 0; }
            continue;
        }
        idx -= nJ;
        cvt16(p.in[0] + (size_t)idx * 4096 + t * 16, (u16*)(ws + OFF_XB) + (size_t)idx * 4096 + t * 16);
    }
}

__device__ __forceinline__ void inproj_phase(const Params& p, int layer, unsigned char* smem) {
    unsigned char* ws = ws_opaque(p.ws);
    const u16* XB = (const u16*)(ws + OFF_XB); const u16* WINT = (const u16*)(ws + OFF_WINT);
    u16* U = (u16*)(ws + OFF_U); u16* UT = (u16*)(ws + OFF_UT); u16* KC = (u16*)(ws + OFF_KC); u16* VC = (u16*)(ws + OFF_VC);
    const int t_ = tid_opaque();
    const int lane = t_ & 63, wave = t_ >> 6, wm = wave >> 1, wn = wave & 1, fr = lane & 15, fg = lane >> 4;
    for (int it = blockIdx.x; it < 128 * 28; it += gridDim.x) {
        const int ft = it % 28, tt = it / 28;
        f32x4 acc[4][4]; zero_acc<4, 4>(acc);
        auto rowX = [=](int r) { return XB + (size_t)(tt * 128 + r) * 1024; };
        auto rowW = [=](int r) { return WINT + (size_t)(ft * 128 + r) * 1024; };
        if (ft < 20) {
            gemm_acc<4, 4>(acc, rowW, rowX, 1024, smem);
#pragma unroll
            for (int i = 0; i < 4; ++i)
#pragma unroll
                for (int j = 0; j < 4; ++j) {
                    const int m = ft * 128 + wm * 64 + 16 * i + 4 * fg, n = tt * 128 + wn * 64 + 16 * j + fr;
                    const uint2 v = pack4(acc[i][j]);
                    if (ft == 17) {
                        const int f = m - 2176;
                        if (f < 64) *(uint2*)(KC + (size_t)n * 64 + f) = v; else *(uint2*)(VC + (size_t)n * 64 + (f - 64)) = v;
                    } else *(uint2*)(U + (size_t)n * LDU + m) = v;
                }
        } else {
            gemm_acc<4, 4>(acc, rowX, rowW, 1024, smem);
#pragma unroll
            for (int i = 0; i < 4; ++i)
#pragma unroll
                for (int j = 0; j < 4; ++j) {
                    const int m = tt * 128 + wm * 64 + 16 * i + 4 * fg, n = ft * 128 + wn * 64 + 16 * j + fr;
                    const int trow = n - 2560, b = m >> 11, s = m & 2047;
                    f32x4 v = acc[i][j];
                    if (trow >= 128 && trow < 384) {
                        const int h = (trow - 128) >> 6; const float l2g = log2f(1.f - exp2f(-5.f - (float)h));
#pragma unroll
                        for (int r = 0; r < 4; ++r) v[r] *= 0.125f * exp2f((float)(127 - ((s + r) & 127)) * l2g);
                    }
                    *(uint2*)(UT + ((size_t)(b * 1024 + trow)) * 2048 + s) = pack4(v);
                }
        }
    }
}

__device__ __forceinline__ void compress_item(const Params& p, int item, unsigned char* smem) {
    unsigned char* ws = ws_opaque(p.ws);
    u16* sH = (u16*)(smem + 40960);
    const int which = item >> 5, r0 = (item & 31) * 32;
    const u16* src = (const u16*)(ws + (which ? OFF_VC : OFF_KC));
    const u16* W1 = (const u16*)(ws + OFF_W1T) + (size_t)which * 256 * 2048;
    const u16* W2 = (const u16*)(ws + OFF_W2T) + (size_t)which * 64 * 256;
    const float* bias = (const float*)(ws + OFF_BIAS1) + which * 256;
    const int t = tid_opaque();
    const int lane = t & 63, wave = t >> 6, wm = wave >> 1, wn = wave & 1, fr = lane & 15, fg = lane >> 4;
    for (int half = 0; half < 2; ++half) {
        f32x4 acc[4][1]; zero_acc<4, 1>(acc);
        auto rowW = [=](int r) { return W1 + (size_t)(half * 128 + r) * 2048; };
        auto rowA = [=](int r) { return src + (size_t)(r0 + r) * 1024; };
        gemm_acc<4, 1>(acc, rowW, rowA, 2048, smem);
#pragma unroll
        for (int i = 0; i < 4; ++i) {
            const int m = half * 128 + wm * 64 + 16 * i + 4 * fg, n = wn * 16 + fr;
            f32x4 v = acc[i][0];
#pragma unroll
            for (int r = 0; r < 4; ++r) { const float xx = v[r] + bias[m + r]; v[r] = 0.5f * xx * (1.f + erff(xx * 0.70710678118f)); }
            *(uint2*)&sH[n * 264 + m] = pack4(v);
        }
    }
    __syncthreads();
    if (which == 0) {
        f32x4 acc2[2];
        acc2[0] = (f32x4){0.f, 0.f, 0.f, 0.f}; acc2[1] = acc2[0];
#pragma unroll
        for (int ks = 0; ks < 8; ++ks) {
            const bf16x8 a = *(const bf16x8*)(W2 + (size_t)(16 * wave + fr) * 256 + 32 * ks + 8 * fg);
#pragma unroll
            for (int nt = 0; nt < 2; ++nt) { const bf16x8 b = *(const bf16x8*)&sH[(16 * nt + fr) * 264 + 32 * ks + 8 * fg]; acc2[nt] = MFMA16(a, b, acc2[nt]); }
        }
        u16* KCMP = (u16*)(ws + OFF_KCMP);
#pragma unroll
        for (int nt = 0; nt < 2; ++nt) *(uint2*)(KCMP + (size_t)(r0 + 16 * nt + fr) * 64 + 16 * wave + 4 * fg) = pack4(acc2[nt]);
    } else {
        f32x4 acc2[2];
        acc2[0] = (f32x4){0.f, 0.f, 0.f, 0.f}; acc2[1] = acc2[0];
        const int mt = wave >> 1, nb = (wave & 1) * 2;
#pragma unroll
        for (int ks = 0; ks < 8; ++ks) {
            const bf16x8 a = *(const bf16x8*)&sH[(16 * mt + fr) * 264 + 32 * ks + 8 * fg];
#pragma unroll
            for (int nt = 0; nt < 2; ++nt) { const bf16x8 b = *(const bf16x8*)(W2 + (size_t)(16 * (nb + nt) + fr) * 256 + 32 * ks + 8 * fg); acc2[nt] = MFMA16(a, b, acc2[nt]); }
        }
        u16* VCMPT = (u16*)(ws + OFF_VCMPT);
        const int rg = r0 + 16 * mt + 4 * fg, bb = rg >> 7, ii = rg & 127;
#pragma unroll
        for (int nt = 0; nt < 2; ++nt) *(uint2*)(VCMPT + (size_t)(bb * 64 + 16 * (nb + nt) + fr) * 128 + ii) = pack4(acc2[nt]);
    }
    __syncthreads();
}

__device__ __forceinline__ void retkv_item(const Params& p, int item) {
    unsigned char* ws = ws_opaque(p.ws);
    const int bh = item >> 4, mc = item & 15, b = bh >> 2, h = bh & 3;
    const u16* Vt = (const u16*)(ws + OFF_UT) + ((size_t)(b * 1024 + 384 + h * 128)) * 2048 + mc * 128;
    const u16* Kt = (const u16*)(ws + OFF_UT) + ((size_t)(b * 1024 + 128 + h * 64)) * 2048 + mc * 128;
    const int t = tid_opaque();
    const int lane = t & 63, wave = t >> 6, fr = lane & 15, fg = lane >> 4;
    f32x4 acc[2][4]; zero_acc<2, 4>(acc);
#pragma unroll
    for (int ks = 0; ks < 4; ++ks) {
        bf16x8 a[2], bb[4];
#pragma unroll
        for (int mt = 0; mt < 2; ++mt) a[mt] = *(const bf16x8*)(Vt + (size_t)(32 * wave + 16 * mt + fr) * 2048 + 32 * ks + 8 * fg);
#pragma unroll
        for (int nt = 0; nt < 4; ++nt) bb[nt] = *(const bf16x8*)(Kt + (size_t)(16 * nt + fr) * 2048 + 32 * ks + 8 * fg);
#pragma unroll
        for (int mt = 0; mt < 2; ++mt)
#pragma unroll
            for (int nt = 0; nt < 4; ++nt) acc[mt][nt] = MFMA16(a[mt], bb[nt], acc[mt][nt]);
    }
    float* KVT = (float*)(ws + OFF_KVT) + (size_t)item * 8192;
#pragma unroll
    for (int mt = 0; mt < 2; ++mt)
#pragma unroll
        for (int nt = 0; nt < 4; ++nt)
#pragma unroll
            for (int r = 0; r < 4; ++r) KVT[(32 * wave + 16 * mt + 4 * fg + r) * 64 + 16 * nt + fr] = acc[mt][nt][r];
}

__device__ __forceinline__ void swa_item(const Params& p, int layer, int item, unsigned char* smem) {
    unsigned char* ws = ws_opaque(p.ws);
    u16* sK = (u16*)smem; u16* sVt = sK + 64 * 72;
    const u16* U = (const u16*)(ws + OFF_U); const u16* UT = (const u16*)(ws + OFF_UT); u16* ACT = (u16*)(ws + OFF_ACT);
    const int b = item >> 7, h = (item >> 5) & 3, qb = item & 31, kvh = h >> 1;
    const int t = tid_opaque();
    const int lane = t & 63, wave = t >> 6, q = lane & 15, g = lane >> 4;
    const int tq = qb * 64 + wave * 16 + q; const size_t tglob = (size_t)b * 2048 + tq;
    bf16x8 qf[2];
#pragma unroll
    for (int ks = 0; ks < 2; ++ks) qf[ks] = *(const bf16x8*)(U + tglob * LDU + 512 + h * 64 + 32 * ks + 8 * g);
    const float slope = exp2f(-(float)(h + 1)); const float sink = p.in[6][layer * 4 + h];
    f32x4 o[4];
#pragma unroll
    for (int dt = 0; dt < 4; ++dt) o[dt] = (f32x4){0.f, 0.f, 0.f, 0.f};
    float m = NEGBIG, l = 0.f;
    const int kt0 = qb >= 2 ? qb - 2 : 0;
    for (int kt = kt0; kt <= qb; ++kt) {
        __syncthreads();
        stage_rows64(sK, U + ((size_t)b * 2048 + kt * 64) * LDU + 768 + kvh * 64, LDU);
        stage_rows64(sVt, UT + ((size_t)(b * 1024 + kvh * 64)) * 2048 + kt * 64, 2048);
        __syncthreads();
        flash_step<4>(sK, sVt, 72, qf, o, m, l, true,
                      [&](int key, float s, bool& valid) { const int d = tq - (kt * 64 + key); valid = (d >= 0) && (d < 128); return s * 0.125f - slope * (float)d; }, lane);
    }
    float lt = l + __shfl_xor(l, 16); lt += __shfl_xor(lt, 32);
    const float m2 = fmaxf(m, sink), sc = __expf(m - m2), den = lt * sc + __expf(sink - m2), inv = sc / fmaxf(den, 1e-30f);
#pragma unroll
    for (int dt = 0; dt < 4; ++dt) *(uint2*)(ACT + tglob * LDACT + 256 + h * 64 + 16 * dt + 4 * g) = pack4(o[dt] * inv);
    __syncthreads();
}

__device__ __forceinline__ void conv_item(const Params& p, int layer, int item, unsigned char* smem) {
    unsigned char* ws = ws_opaque(p.ws);
    u16* sh = (u16*)smem; float* sy = (float*)(smem + 62 * 256 * 2);
    const u16* U = (const u16*)(ws + OFF_U); u16* ACT = (u16*)(ws + OFF_ACT);
    const int b = item >> 6, s0 = (item & 63) * 32, t = tid_opaque();
#pragma unroll 2
    for (int r = 0; r < 62; ++r) {
        const int sp = s0 - 30 + r; float hv = 0.f;
        if (sp >= 0) { const u16* row = U + ((size_t)b * 2048 + sp) * LDU; hv = bf2f(row[t]) * sigmoidf_(bf2f(row[256 + t])); }
        sh[r * 256 + t] = f2bf(hv);
    }
    __syncthreads();
    float w[31];
#pragma unroll
    for (int k = 0; k < 31; ++k) w[k] = p.in[2][(size_t)layer * 31 * 256 + k * 256 + t];
    const float db = p.in[3][layer * 256 + t];
#pragma unroll 1
    for (int tt = 0; tt < 32; ++tt) {
        float a = db;
#pragma unroll
        for (int k = 0; k < 31; ++k) a += bf2f(sh[(tt + k) * 256 + t]) * w[k];
        sy[tt * 256 + t] = a;
    }
    __syncthreads();
    const int lane = t & 63, wave = t >> 6, c = lane * 4;
    const float4 gg = *(const float4*)(p.in[4] + layer * 256 + c), bb = *(const float4*)(p.in[5] + layer * 256 + c);
    for (int i = 0; i < 8; ++i) {
        const int tt = wave * 8 + i;
        const float4 v = *(const float4*)&sy[tt * 256 + c];
        float s = v.x + v.y + v.z + v.w;
#pragma unroll
        for (int o = 32; o >= 1; o >>= 1) s += __shfl_xor(s, o);
        const float mu = s * (1.f / 256.f);
        const float dx = v.x - mu, dy = v.y - mu, dz = v.z - mu, dw = v.w - mu;
        float q = dx * dx + dy * dy + dz * dz + dw * dw;
#pragma unroll
        for (int o = 32; o >= 1; o >>= 1) q += __shfl_xor(q, o);
        const float rstd = rsqrtf(q * (1.f / 256.f) + LN_EPS_F);
        f32x4 ov; ov[0] = siluf_(dx * rstd * gg.x + bb.x); ov[1] = siluf_(dy * rstd * gg.y + bb.y); ov[2] = siluf_(dz * rstd * gg.z + bb.z); ov[3] = siluf_(dw * rstd * gg.w + bb.w);
        *(uint2*)(ACT + ((size_t)b * 2048 + s0 + tt) * LDACT + c) = pack4(ov);
    }
    __syncthreads();
}

#define FOR_ITEMS(j, base, n) for (int j = (int)((blockIdx.x + gridDim.x - ((base) % gridDim.x)) % gridDim.x); j < (n); j += gridDim.x)
__device__ __forceinline__ void p2a_phase(const Params& p, int layer, unsigned char* smem) {
    FOR_ITEMS(j, 0, 64) compress_item(p, j, smem);
    FOR_ITEMS(j, 64, 512) retkv_item(p, j);
    FOR_ITEMS(j, 576, 1024) swa_item(p, layer, j, smem);
    FOR_ITEMS(j, 1600, 512) conv_item(p, layer, j, smem);
}

__device__ __forceinline__ void retout_item(const Params& p, int layer, int item, unsigned char* smem) {
    unsigned char* ws = ws_opaque(p.ws);
    u16* sS = (u16*)smem; u16* sK = sS + 128 * 72; u16* sVt = sK + 64 * 72;
    const u16* U = (const u16*)(ws + OFF_U); const u16* UT = (const u16*)(ws + OFF_UT); u16* ACT = (u16*)(ws + OFF_ACT);
    const int bh = item >> 4, n = item & 15, b = bh >> 2, h = bh & 3, t = tid_opaque();
    const float l2g = log2f(1.f - exp2f(-5.f - (float)h));
    {
        float as[32];
#pragma unroll
        for (int i = 0; i < 32; ++i) as[i] = 0.f;
        for (int mm = 0; mm < n; ++mm) {
            const float wgt = exp2f(128.f * (float)(n - 1 - mm) * l2g);
            const float4* src = (const float4*)((const float*)(ws + OFF_KVT) + (size_t)(bh * 16 + mm) * 8192 + t * 32);
#pragma unroll
            for (int i = 0; i < 8; ++i) { const float4 v = src[i]; as[4 * i] += wgt * v.x; as[4 * i + 1] += wgt * v.y; as[4 * i + 2] += wgt * v.z; as[4 * i + 3] += wgt * v.w; }
        }
        u16* dp = &sS[(t >> 1) * 72 + (t & 1) * 32];
#pragma unroll
        for (int i = 0; i < 4; ++i) *(uint4*)(dp + 8 * i) = make_uint4(pack2(as[8 * i], as[8 * i + 1]), pack2(as[8 * i + 2], as[8 * i + 3]), pack2(as[8 * i + 4], as[8 * i + 5]), pack2(as[8 * i + 6], as[8 * i + 7]));
    }
    __syncthreads();
    const int lane = t & 63, wave = t >> 6, q = lane & 15, g = lane >> 4;
    bf16x8 qf[2][2]; f32x4 o[2][8];
#pragma unroll
    for (int qt = 0; qt < 2; ++qt) {
        const size_t tglob = (size_t)b * 2048 + n * 128 + 32 * wave + 16 * qt + q;
#pragma unroll
        for (int ks = 0; ks < 2; ++ks) qf[qt][ks] = *(const bf16x8*)(U + tglob * LDU + 896 + h * 64 + 32 * ks + 8 * g);
#pragma unroll
        for (int dt = 0; dt < 8; ++dt) {
            o[qt][dt] = (f32x4){0.f, 0.f, 0.f, 0.f};
#pragma unroll
            for (int ks = 0; ks < 2; ++ks) { const bf16x8 a = *(const bf16x8*)&sS[(16 * dt + q) * 72 + 32 * ks + 8 * g]; o[qt][dt] = MFMA16(a, qf[qt][ks], o[qt][dt]); }
        }
        const float xi = exp2f((float)(32 * wave + 16 * qt + q + 1) * l2g);
#pragma unroll
        for (int dt = 0; dt < 8; ++dt) o[qt][dt] *= xi;
    }
    for (int kt = 0; kt < 2; ++kt) {
        __syncthreads();
        stage_rows64(sK, U + ((size_t)b * 2048 + n * 128 + kt * 64) * LDU + 1152 + h * 64, LDU);
        stage_rows64(sVt, UT + ((size_t)(b * 1024 + 384 + h * 128)) * 2048 + n * 128 + kt * 64, 2048);
        stage_rows64(sVt + 64 * 72, UT + ((size_t)(b * 1024 + 384 + h * 128 + 64)) * 2048 + n * 128 + kt * 64, 2048);
        __syncthreads();
#pragma unroll
        for (int qt = 0; qt < 2; ++qt) {
            if (kt * 64 > 32 * wave + 16 * qt + 15) continue;
            const int tql = 32 * wave + 16 * qt + q;
            f32x4 s[4]; qk64(sK, qf[qt], s, lane);
            float x[16];
#pragma unroll
            for (int mt = 0; mt < 4; ++mt)
#pragma unroll
                for (int rr = 0; rr < 4; ++rr) { const int d = tql - (kt * 64 + 16 * mt + 4 * g + rr); x[mt * 4 + rr] = (d >= 0) ? s[mt][rr] * 0.125f * exp2f((float)d * l2g) : 0.f; }
            bf16x8 pb[2]; pack_p(x, pb);
            pv64<8>(sVt, 72, pb, o[qt], lane);
        }
    }
#pragma unroll
    for (int qt = 0; qt < 2; ++qt) {
        const size_t tglob = (size_t)b * 2048 + n * 128 + 32 * wave + 16 * qt + q;
        float s = 0.f;
#pragma unroll
        for (int dt = 0; dt < 8; ++dt) s += o[qt][dt][0] + o[qt][dt][1] + o[qt][dt][2] + o[qt][dt][3];
        s += __shfl_xor(s, 16); s += __shfl_xor(s, 32);
        const float mu = s * (1.f / 128.f);
        float v = 0.f;
#pragma unroll
        for (int dt = 0; dt < 8; ++dt)
#pragma unroll
            for (int r = 0; r < 4; ++r) { const float d = o[qt][dt][r] - mu; v += d * d; }
        v += __shfl_xor(v, 16); v += __shfl_xor(v, 32);
        const float rstd = rsqrtf(v * (1.f / 128.f) + LN_EPS_F);
#pragma unroll
        for (int dt = 0; dt < 8; ++dt) {
            const int c = h * 128 + 16 * dt + 4 * g;
            const float4 gn = *(const float4*)(p.in[7] + layer * 512 + c), gb = *(const float4*)(p.in[8] + layer * 512 + c);
            const uint2 gv = *(const uint2*)(U + tglob * LDU + 1408 + c);
            f32x4 ov;
            ov[0] = ((o[qt][dt][0] - mu) * rstd * gn.x + gb.x) * siluf_(bflo(gv.x));
            ov[1] = ((o[qt][dt][1] - mu) * rstd * gn.y + gb.y) * siluf_(bfhi(gv.x));
            ov[2] = ((o[qt][dt][2] - mu) * rstd * gn.z + gb.z) * siluf_(bflo(gv.y));
            ov[3] = ((o[qt][dt][3] - mu) * rstd * gn.w + gb.w) * siluf_(bfhi(gv.y));
            *(uint2*)(ACT + tglob * LDACT + 512 + c) = pack4(ov);
        }
    }
    __syncthreads();
}

__device__ __forceinline__ void nsa_item(const Params& p, int item, unsigned char* smem) {
    unsigned char* ws = ws_opaque(p.ws);
    u16* sKc = (u16*)smem;
    u16* sVc = sKc + 128 * 72;
    u16* sK = sVc + 64 * 136;
    u16* sVt = sK + 64 * 72;
    float* impL = (float*)(sVt + 64 * 72);
    unsigned* qmask = (unsigned*)(impL + 4 * 16 * 32);
    unsigned* wgor = qmask + 64;
    const u16* U = (const u16*)(ws + OFF_U); const u16* UT = (const u16*)(ws + OFF_UT); u16* ACT = (u16*)(ws + OFF_ACT);
    const int b = item >> 5, blk = item & 31, t = tid_opaque();
    const int lane = t & 63, wave = t >> 6, q = lane & 15, g = lane >> 4;
    const int tq = blk * 64 + wave * 16 + q; const size_t tglob = (size_t)b * 2048 + tq;
    __syncthreads();
    {
        const u16* kc = (const u16*)(ws + OFF_KCMP) + (size_t)b * 128 * 64;
        stage_rows64(sKc, kc, 64); stage_rows64(sKc + 64 * 72, kc + 64 * 64, 64);
        const u16* vc = (const u16*)(ws + OFF_VCMPT) + (size_t)b * 64 * 128;
        const int r = t >> 2, c = (t & 3) * 32;
        const uint4* src = (const uint4*)(vc + (size_t)r * 128 + c);
#pragma unroll
        for (int i = 0; i < 4; ++i) *(uint4*)&sVc[r * 136 + c + 8 * i] = src[i];
        if (t == 0) *wgor = 0u;
    }
    __syncthreads();
    const u16* qrow = U + tglob * LDU + 1920 + 8 * g;
    float impm[8], impc[8];
#pragma unroll
    for (int i = 0; i < 8; ++i) { impm[i] = 0.f; impc[i] = 0.f; }
#pragma unroll 1
    for (int h = 0; h < 4; ++h) {
        const float slope = exp2f(-(float)(h + 5));
        bf16x8 qh[2];
        qh[0] = *(const bf16x8*)(qrow + h * 64); qh[1] = *(const bf16x8*)(qrow + h * 64 + 32);
        f32x4 s0[4], s1[4]; qk64(sKc, qh, s0, lane); qk64(sKc + 64 * 72, qh, s1, lane);
        float x[32]; float mx = NEGBIG;
#pragma unroll
        for (int mt = 0; mt < 4; ++mt)
#pragma unroll
            for (int rr = 0; rr < 4; ++rr) {
                const int c0 = 16 * mt + 4 * g + rr, c1 = 64 + c0;
                const int d0 = tq - (16 * c0 + 31), d1 = tq - (16 * c1 + 31);
                const float v0 = d0 >= 0 ? s0[mt][rr] * 0.125f - slope * (float)d0 : NEGBIG;
                const float v1 = d1 >= 0 ? s1[mt][rr] * 0.125f - slope * (float)d1 : NEGBIG;
                x[mt * 4 + rr] = v0; x[16 + mt * 4 + rr] = v1; mx = fmaxf(mx, fmaxf(v0, v1));
            }
        mx = fmaxf(mx, __shfl_xor(mx, 16)); mx = fmaxf(mx, __shfl_xor(mx, 32));
        float ps = 0.f;
#pragma unroll
        for (int i = 0; i < 32; ++i) { const float pv = (x[i] > -1e29f) ? __expf(x[i] - mx) : 0.f; x[i] = pv; ps += pv; }
        ps += __shfl_xor(ps, 16); ps += __shfl_xor(ps, 32);
        const float inv = 1.f / fmaxf(ps, 1e-30f);
#pragma unroll
        for (int tm = 0; tm < 8; ++tm) {
            impm[tm] += (x[tm * 4] + x[tm * 4 + 1] + x[tm * 4 + 2] + x[tm * 4 + 3]) * inv;
            impc[tm] += x[tm * 4 + 3] * inv;
        }
    }
    float* myimp = impL + (wave * 16 + q) * 32;
#pragma unroll
    for (int tm = 0; tm < 8; ++tm) myimp[4 * tm + g] = impm[tm];
    __syncthreads();
#pragma unroll
    for (int tm = 0; tm < 8; ++tm) { const int j1 = 4 * tm + g + 1; if (j1 < 32) myimp[j1] += impc[tm]; }
    __syncthreads();
    if (g == 0) {
        const int cur = blk;
        for (int j = 0; j < 32; ++j) {
            float v = myimp[j];
            if (j == 0 || j == cur || j == cur - 1) v = 1e4f; else if (j > cur) v = -1.f;
            myimp[j] = v;
        }
        unsigned mask = 0u;
        for (int nsel = 0; nsel < 8; ++nsel) {
            float best = -3e38f; int bj = 0;
            for (int j = 0; j < 32; ++j) { const float v = myimp[j]; if (!((mask >> j) & 1u) && v > best) { best = v; bj = j; } }
            mask |= 1u << bj;
        }
        qmask[wave * 16 + q] = mask;
        atomicOr(wgor, mask);
    }
    __syncthreads();
    const unsigned mymask = qmask[wave * 16 + q];
    const unsigned allmask = *wgor;
    const int cur = blk;
#pragma unroll 1
    for (int h = 0; h < 4; ++h) {
        const float slope = exp2f(-(float)(h + 5));
        bf16x8 qh[2];
        qh[0] = *(const bf16x8*)(qrow + h * 64); qh[1] = *(const bf16x8*)(qrow + h * 64 + 32);
        const u16* grow = U + tglob * LDU + 2432;
        const float g0 = sigmoidf_(bf2f(grow[h])), g1 = sigmoidf_(bf2f(grow[4 + h])), g2 = sigmoidf_(bf2f(grow[8 + h]));
        f32x4 otot[4];
        {
            f32x4 o[4];
#pragma unroll
            for (int dt = 0; dt < 4; ++dt) o[dt] = (f32x4){0.f, 0.f, 0.f, 0.f};
            float m = NEGBIG, l = 0.f;
#pragma unroll
            for (int tile = 0; tile < 2; ++tile)
                flash_step<4>(sKc + tile * 64 * 72, sVc + tile * 64, 136, qh, o, m, l, true,
                              [&](int key, float s, bool& valid) { const int d = tq - (16 * (tile * 64 + key) + 31); valid = d >= 0; return s * 0.125f - slope * (float)d; }, lane);
            float lt = l + __shfl_xor(l, 16); lt += __shfl_xor(lt, 32);
            const float sc = g0 / fmaxf(lt, 1e-30f);
#pragma unroll
            for (int dt = 0; dt < 4; ++dt) otot[dt] = o[dt] * sc;
        }
        {
            f32x4 o[4];
#pragma unroll
            for (int dt = 0; dt < 4; ++dt) o[dt] = (f32x4){0.f, 0.f, 0.f, 0.f};
            float m = NEGBIG, l = 0.f;
            for (int j = 0; j <= cur; ++j) {
                if (!((allmask >> j) & 1u)) continue;
                __syncthreads();
                stage_rows64(sK, U + ((size_t)b * 2048 + j * 64) * LDU + 2304, LDU);
                stage_rows64(sVt, UT + ((size_t)(b * 1024 + 896)) * 2048 + j * 64, 2048);
                __syncthreads();
                flash_step<4>(sK, sVt, 72, qh, o, m, l, ((mymask >> j) & 1u) != 0u,
                              [&](int key, float s, bool& valid) { const int d = tq - (j * 64 + key); valid = d >= 0; return s * 0.125f - slope * (float)d; }, lane);
            }
            float lt = l + __shfl_xor(l, 16); lt += __shfl_xor(lt, 32);
            const float sc = g1 / fmaxf(lt, 1e-30f);
#pragma unroll
            for (int dt = 0; dt < 4; ++dt) otot[dt] += o[dt] * sc;
        }
        {
            f32x4 o[4];
#pragma unroll
            for (int dt = 0; dt < 4; ++dt) o[dt] = (f32x4){0.f, 0.f, 0.f, 0.f};
            float m = NEGBIG, l = 0.f;
            const int kt0 = cur >= 8 ? cur - 8 : 0;
            for (int kt = kt0; kt <= cur; ++kt) {
                __syncthreads();
                stage_rows64(sK, U + ((size_t)b * 2048 + kt * 64) * LDU + 2368, LDU);
                stage_rows64(sVt, UT + ((size_t)(b * 1024 + 960)) * 2048 + kt * 64, 2048);
                __syncthreads();
                flash_step<4>(sK, sVt, 72, qh, o, m, l, true,
                              [&](int key, float s, bool& valid) { const int d = tq - (kt * 64 + key); valid = (d >= 0) && (d < 512); return s * 0.125f - slope * (float)d; }, lane);
            }
            float lt = l + __shfl_xor(l, 16); lt += __shfl_xor(lt, 32);
            const float sc = g2 / fmaxf(lt, 1e-30f);
#pragma unroll
            for (int dt = 0; dt < 4; ++dt) otot[dt] += o[dt] * sc;
        }
#pragma unroll
        for (int dt = 0; dt < 4; ++dt) *(uint2*)(ACT + tglob * LDACT + 1024 + h * 64 + 16 * dt + 4 * g) = pack4(otot[dt]);
    }
    __syncthreads();
}

__device__ __forceinline__ void p2b_phase(const Params& p, int layer, unsigned char* smem) {
    FOR_ITEMS(j, 0, 256) nsa_item(p, j, smem);
    FOR_ITEMS(j, 256, 512) retout_item(p, layer, j, smem);
}

__device__ __forceinline__ void merge_phase(const Params& p, unsigned char* smem) {
    unsigned char* ws = ws_opaque(p.ws);
    const u16* XB = (const u16*)(ws + OFF_XB); const u16* WINT = (const u16*)(ws + OFF_WINT); const u16* PT = (const u16*)(ws + OFF_PT);
    const u16* ACT = (const u16*)(ws + OFF_ACT); u16* MERGED = (u16*)(ws + OFF_MERGED);
    const int t_ = tid_opaque();
    const int lane = t_ & 63, wave = t_ >> 6, wm = wave >> 1, wn = wave & 1, fr = lane & 15, fg = lane >> 4;
    for (int it = blockIdx.x; it < 128 * 16; it += gridDim.x) {
        const int ct = it & 15, tt = it >> 4;
        f32x4 accm[2][4]; zero_acc<2, 4>(accm);
        auto rowX = [=](int r) { return XB + (size_t)(tt * 128 + r) * 1024; };
#pragma unroll 1
        for (int br = 0; br < 4; ++br) {
            const int Kb = (br == 2) ? 512 : 256;
            const size_t poff = (br == 0) ? 0 : (br == 1) ? 262144 : (br == 2) ? 524288 : 1048576;
            const int aoff = (br == 0) ? 0 : (br == 1) ? 256 : (br == 2) ? 512 : 1024;
            f32x4 accg[2][4]; zero_acc<2, 4>(accg);
            auto rowWg = [=](int r) { return WINT + (size_t)(3584 + br * 1024 + ct * 64 + r) * 1024; };
            gemm_acc<2, 4>(accg, rowWg, rowX, 1024, smem);
#pragma unroll
            for (int i = 0; i < 2; ++i)
#pragma unroll
                for (int j = 0; j < 4; ++j)
#pragma unroll
                    for (int r = 0; r < 4; ++r) accg[i][j][r] = sigmoidf_(accg[i][j][r]);
            f32x4 accy[2][4]; zero_acc<2, 4>(accy);
            auto rowP = [=](int r) { return PT + poff + (size_t)(ct * 64 + r) * Kb; };
            auto rowAct = [=](int r) { return ACT + (size_t)(tt * 128 + r) * LDACT + aoff; };
            gemm_acc<2, 4>(accy, rowP, rowAct, Kb, smem);
#pragma unroll
            for (int i = 0; i < 2; ++i)
#pragma unroll
                for (int j = 0; j < 4; ++j) accm[i][j] += accg[i][j] * accy[i][j];
        }
#pragma unroll
        for (int i = 0; i < 2; ++i)
#pragma unroll
            for (int j = 0; j < 4; ++j) {
                const int m = ct * 64 + wm * 32 + 16 * i + 4 * fg, n = tt * 128 + wn * 64 + 16 * j + fr;
                *(uint2*)(MERGED + (size_t)n * 1024 + m) = pack4(accm[i][j]);
            }
    }
}

__device__ __forceinline__ void wout_phase(const Params& p, unsigned char* smem) {
    unsigned char* ws = ws_opaque(p.ws);
    const u16* XB = (const u16*)(ws + OFF_XB); const u16* WOUT = (const u16*)(ws + OFF_WOUT); const u16* MERGED = (const u16*)(ws + OFF_MERGED);
    u16* Z = (u16*)(ws + OFF_Z);
    const int t_ = tid_opaque();
    const int lane = t_ & 63, wave = t_ >> 6, wm = wave >> 1, wn = wave & 1, fr = lane & 15, fg = lane >> 4;
    for (int it = blockIdx.x; it < 128 * 8; it += gridDim.x) {
        const int ct = it & 7, tt = it >> 3;
        f32x4 acc[4][4]; zero_acc<4, 4>(acc);
        auto rowW = [=](int r) { return WOUT + (size_t)(ct * 128 + r) * 1024; };
        auto rowM = [=](int r) { return MERGED + (size_t)(tt * 128 + r) * 1024; };
        gemm_acc<4, 4>(acc, rowW, rowM, 1024, smem);
#pragma unroll
        for (int i = 0; i < 4; ++i)
#pragma unroll
            for (int j = 0; j < 4; ++j) {
                const int m = ct * 128 + wm * 64 + 16 * i + 4 * fg, n = tt * 128 + wn * 64 + 16 * j + fr;
                const uint2 xv = *(const uint2*)(XB + (size_t)n * 1024 + m);
                f32x4 v = acc[i][j];
                v[0] += ALPHA_F * bflo(xv.x); v[1] += ALPHA_F * bfhi(xv.x); v[2] += ALPHA_F * bflo(xv.y); v[3] += ALPHA_F * bfhi(xv.y);
                *(uint2*)(Z + (size_t)n * 1024 + m) = pack4(v);
            }
    }
}

__device__ __forceinline__ void ln_row16(float (&v)[16], const float* gam, const float* bet, int lane) {
    float s = 0.f;
#pragma unroll
    for (int i = 0; i < 16; ++i) s += v[i];
#pragma unroll
    for (int o = 32; o >= 1; o >>= 1) s += __shfl_xor(s, o);
    const float mu = s * (1.f / 1024.f);
    float q = 0.f;
#pragma unroll
    for (int i = 0; i < 16; ++i) { v[i] -= mu; q += v[i] * v[i]; }
#pragma unroll
    for (int o = 32; o >= 1; o >>= 1) q += __shfl_xor(q, o);
    const float rstd = rsqrtf(q * (1.f / 1024.f) + LN_EPS_F);
#pragma unroll
    for (int hh = 0; hh < 2; ++hh) {
        const int c = hh * 512 + lane * 8;
        const float4 g0 = *(const float4*)(gam + c), g1 = *(const float4*)(gam + c + 4), b0 = *(const float4*)(bet + c), b1 = *(const float4*)(bet + c + 4);
        v[8 * hh + 0] = v[8 * hh + 0] * rstd * g0.x + b0.x; v[8 * hh + 1] = v[8 * hh + 1] * rstd * g0.y + b0.y;
        v[8 * hh + 2] = v[8 * hh + 2] * rstd * g0.z + b0.z; v[8 * hh + 3] = v[8 * hh + 3] * rstd * g0.w + b0.w;
        v[8 * hh + 4] = v[8 * hh + 4] * rstd * g1.x + b1.x; v[8 * hh + 5] = v[8 * hh + 5] * rstd * g1.y + b1.y;
        v[8 * hh + 6] = v[8 * hh + 6] * rstd * g1.z + b1.z; v[8 * hh + 7] = v[8 * hh + 7] * rstd * g1.w + b1.w;
    }
}
__device__ __forceinline__ void unpack8(const uint4 w, float* v) {
    v[0] = bflo(w.x); v[1] = bfhi(w.x); v[2] = bflo(w.y); v[3] = bfhi(w.y); v[4] = bflo(w.z); v[5] = bfhi(w.z); v[6] = bflo(w.w); v[7] = bfhi(w.w);
}

__device__ __forceinline__ void router_phase(const Params& p, int layer, unsigned char* smem) {
    unsigned char* ws = ws_opaque(p.ws);
    float* L = (float*)smem;
    const u16* Z = (const u16*)(ws + OFF_Z); u16* XB = (u16*)(ws + OFF_XB); const u16* RW = (const u16*)(ws + OFF_RW);
    unsigned* cnt = (unsigned*)(ws + OFF_CNT); unsigned* LIST = (unsigned*)(ws + OFF_LIST); float* GATEW = (float*)(ws + OFF_GATEW);
    const float* gam = p.in[20] + layer * 1024; const float* bet = p.in[21] + layer * 1024; const float* rbias = p.in[23] + layer * 64;
    const int t = tid_opaque(), lane = t & 63, wave = t >> 6, wm = wave >> 1, wn = wave & 1, fr = lane & 15, fg = lane >> 4;
    for (int tt = blockIdx.x; tt < 128; tt += gridDim.x) {
        for (int i = 0; i < 32; ++i) {
            const size_t row = (size_t)tt * 128 + wave * 32 + i;
            float v[16];
            unpack8(*(const uint4*)(Z + row * 1024 + lane * 8), v); unpack8(*(const uint4*)(Z + row * 1024 + 512 + lane * 8), v + 8);
            ln_row16(v, gam, bet, lane);
            *(uint4*)(XB + row * 1024 + lane * 8) = make_uint4(pack2(v[0], v[1]), pack2(v[2], v[3]), pack2(v[4], v[5]), pack2(v[6], v[7]));
            *(uint4*)(XB + row * 1024 + 512 + lane * 8) = make_uint4(pack2(v[8], v[9]), pack2(v[10], v[11]), pack2(v[12], v[13]), pack2(v[14], v[15]));
        }
        __threadfence_block();
        __syncthreads();
        f32x4 acc[4][4]; zero_acc<4, 4>(acc);
        auto rowR = [=](int r) { return RW + (size_t)(r & 63) * 1024; };
        auto rowX = [=](int r) { return (const u16*)XB + (size_t)(tt * 128 + r) * 1024; };
        gemm_acc<4, 4>(acc, rowR, rowX, 1024, smem);
        __syncthreads();
        if (wm == 0) {
#pragma unroll
            for (int i = 0; i < 4; ++i)
#pragma unroll
                for (int j = 0; j < 4; ++j)
#pragma unroll
                    for (int r = 0; r < 4; ++r) L[(wn * 64 + 16 * j + fr) * 65 + 16 * i + 4 * fg + r] = acc[i][j][r];
        }
        __syncthreads();
        if (t < 128) {
            float* Lr = L + t * 65;
            for (int e = 0; e < 64; ++e) Lr[e] = sigmoidf_(Lr[e]) + rbias[e];
            float gs[8];
#pragma unroll
            for (int gI = 0; gI < 8; ++gI) {
                float m1 = -3e38f, m2 = -3e38f;
#pragma unroll
                for (int k = 0; k < 8; ++k) { const float v = Lr[gI * 8 + k]; if (v > m1) { m2 = m1; m1 = v; } else if (v > m2) m2 = v; }
                gs[gI] = m1 + m2;
            }
            unsigned gmask = 0u;
#pragma unroll
            for (int nsel = 0; nsel < 4; ++nsel) {
                float best = -3e38f; int bi = 0;
#pragma unroll
                for (int gI = 0; gI < 8; ++gI) if (!((gmask >> gI) & 1u) && gs[gI] > best) { best = gs[gI]; bi = gI; }
                gmask |= 1u << bi;
            }
            unsigned long long chosen = 0ull; int eidx[6]; float sraw[6]; float ssum = 0.f;
#pragma unroll
            for (int k = 0; k < 6; ++k) {
                float best = -3e38f; int be = 0;
                for (int e = 0; e < 64; ++e) {
                    if (((gmask >> (e >> 3)) & 1u) && !((chosen >> e) & 1ull)) { const float v = Lr[e]; if (v > best) { best = v; be = e; } }
                }
                chosen |= 1ull << be; eidx[k] = be; sraw[k] = best - rbias[be]; ssum += sraw[k];
            }
            const unsigned tok = (unsigned)(tt * 128 + t);
#pragma unroll
            for (int k = 0; k < 6; ++k) {
                const unsigned pos = atomicAdd(&cnt[eidx[k]], 1u);
                LIST[(size_t)eidx[k] * 16384 + pos] = tok * 8u + (unsigned)k;
                GATEW[tok * 8u + k] = sraw[k] / ssum * 2.5f;
            }
        }
        __syncthreads();
    }
}

__device__ __forceinline__ void moe_prefix(const Params& p, int* pre) {
    if (threadIdx.x == 0) {
        const unsigned* cnt = (const unsigned*)(ws_opaque(p.ws) + OFF_CNT);
        int a = 0;
        for (int e = 0; e < 64; ++e) { pre[e] = a; a += (int)((cnt[e] + 127u) >> 7); }
        pre[64] = a; a += 128; pre[65] = a;
    }
    __syncthreads();
}

__device__ __forceinline__ void moe_up_phase(const Params& p, unsigned char* smem) {
    unsigned char* ws = ws_opaque(p.ws);
    int* pre = (int*)(smem + SMEM_PRE_OFF);
    const u16* XB = (const u16*)(ws + OFF_XB); const u16* WUP = (const u16*)(ws + OFF_WUP); u16* H = (u16*)(ws + OFF_H);
    const unsigned* cnt = (const unsigned*)(ws + OFF_CNT); const unsigned* LIST = (const unsigned*)(ws + OFF_LIST);
    const int t_ = tid_opaque();
    const int lane = t_ & 63, wave = t_ >> 6, wm = wave >> 1, wn = wave & 1, fr = lane & 15, fg = lane >> 4;
    moe_prefix(p, pre);
    const int total = pre[65] * 4;
    for (int it = blockIdx.x; it < total; it += gridDim.x) {
        const int bi = it >> 2, nt = it & 3;
        int e = 0; while (pre[e + 1] <= bi) ++e;
        const int rb = bi - pre[e]; const int ce = (e < 64) ? (int)cnt[e] : T_TOK;
        f32x4 acc[4][4]; zero_acc<4, 4>(acc);
        auto rowW = [=](int r) { return WUP + ((size_t)e * 512 + nt * 128 + r) * 1024; };
        auto rowX = [=](int r) {
            const int idx = rb * 128 + r; unsigned tok = 0u;
            if (idx < ce) tok = (e < 64) ? (LIST[(size_t)e * 16384 + idx] >> 3) : (unsigned)idx;
            return XB + (size_t)tok * 1024;
        };
        gemm_acc<4, 4>(acc, rowW, rowX, 1024, smem);
        const size_t hrow0 = (size_t)pre[e] * 128 + (size_t)rb * 128;
#pragma unroll
        for (int i = 0; i < 4; i += 2)
#pragma unroll
            for (int j = 0; j < 4; ++j) {
                const int n = wn * 64 + 16 * j + fr;
                const int col = 16 * ((nt * 8 + wm * 4 + i) >> 1) + 4 * fg;
                f32x4 v;
#pragma unroll
                for (int r = 0; r < 4; ++r) v[r] = siluf_(acc[i][j][r]) * acc[i + 1][j][r];
                *(uint2*)(H + (hrow0 + n) * 256 + col) = pack4(v);
            }
    }
}

__device__ __forceinline__ void moe_down_phase(const Params& p, unsigned char* smem) {
    unsigned char* ws = ws_opaque(p.ws);
    int* pre = (int*)(smem + SMEM_PRE_OFF);
    const u16* XB = (const u16*)(ws + OFF_XB); const u16* WD = (const u16*)(ws + OFF_WD); const u16* H = (const u16*)(ws + OFF_H);
    u16* Z = (u16*)(ws + OFF_Z); u16* YS = (u16*)(ws + OFF_YSLOT);
    const unsigned* cnt = (const unsigned*)(ws + OFF_CNT); const unsigned* LIST = (const unsigned*)(ws + OFF_LIST); const float* GATEW = (const float*)(ws + OFF_GATEW);
    const int t_ = tid_opaque();
    const int lane = t_ & 63, wave = t_ >> 6, wm = wave >> 1, wn = wave & 1, fr = lane & 15, fg = lane >> 4;
    moe_prefix(p, pre);
    const int total = pre[65] * 8;
    for (int it = blockIdx.x; it < total; it += gridDim.x) {
        const int bi = it >> 3, nt = it & 7;
        int e = 0; while (pre[e + 1] <= bi) ++e;
        const int rb = bi - pre[e]; const int ce = (e < 64) ? (int)cnt[e] : T_TOK;
        const size_t hrow0 = (size_t)pre[e] * 128 + (size_t)rb * 128;
        f32x4 acc[4][4]; zero_acc<4, 4>(acc);
        auto rowW = [=](int r) { return WD + ((size_t)e * 1024 + nt * 128 + r) * 256; };
        auto rowH = [=](int r) { return H + (hrow0 + r) * 256; };
        gemm_acc<4, 4>(acc, rowW, rowH, 256, smem);
#pragma unroll
        for (int j = 0; j < 4; ++j) {
            const int n = wn * 64 + 16 * j + fr, idx = rb * 128 + n;
            if (idx < ce) {
                if (e < 64) {
                    const unsigned ent = LIST[(size_t)e * 16384 + idx]; const float gw = GATEW[ent];
                    u16* dst = YS + ((size_t)(ent >> 3) * 6 + (ent & 7u)) * 1024 + nt * 128 + wm * 64 + 4 * fg;
#pragma unroll
                    for (int i = 0; i < 4; ++i) *(uint2*)(dst + 16 * i) = pack4(acc[i][j] * gw);
                } else {
                    const size_t o = (size_t)idx * 1024 + nt * 128 + wm * 64 + 4 * fg;
#pragma unroll
                    for (int i = 0; i < 4; ++i) {
                        const uint2 xv = *(const uint2*)(XB + o + 16 * i);
                        f32x4 v = acc[i][j];
                        v[0] += ALPHA_F * bflo(xv.x); v[1] += ALPHA_F * bfhi(xv.x); v[2] += ALPHA_F * bflo(xv.y); v[3] += ALPHA_F * bfhi(xv.y);
                        *(uint2*)(Z + o + 16 * i) = pack4(v);
                    }
                }
            }
        }
    }
}

__device__ __forceinline__ void combine_phase(const Params& p, int layer) {
    unsigned char* ws = ws_opaque(p.ws);
    const u16* Z = (const u16*)(ws + OFF_Z); const u16* YS = (const u16*)(ws + OFF_YSLOT); u16* XB = (u16*)(ws + OFF_XB);
    const float* gam = p.in[30] + layer * 1024; const float* bet = p.in[31] + layer * 1024;
    const int t = tid_opaque(), lane = t & 63, wave = t >> 6;
    for (int it = blockIdx.x; it < 512; it += gridDim.x) {
        for (int i = 0; i < 8; ++i) {
            const size_t row = (size_t)it * 32 + wave * 8 + i;
            float v[16];
            unpack8(*(const uint4*)(Z + row * 1024 + lane * 8), v); unpack8(*(const uint4*)(Z + row * 1024 + 512 + lane * 8), v + 8);
#pragma unroll
            for (int k = 0; k < 6; ++k) {
                float y[16];
                unpack8(*(const uint4*)(YS + (row * 6 + k) * 1024 + lane * 8), y); unpack8(*(const uint4*)(YS + (row * 6 + k) * 1024 + 512 + lane * 8), y + 8);
#pragma unroll
                for (int c = 0; c < 16; ++c) v[c] += y[c];
            }
            ln_row16(v, gam, bet, lane);
            *(uint4*)(XB + row * 1024 + lane * 8) = make_uint4(pack2(v[0], v[1]), pack2(v[2], v[3]), pack2(v[4], v[5]), pack2(v[6], v[7]));
            *(uint4*)(XB + row * 1024 + 512 + lane * 8) = make_uint4(pack2(v[8], v[9]), pack2(v[10], v[11]), pack2(v[12], v[13]), pack2(v[14], v[15]));
            if (layer == 1) {
                float* op = p.out + row * 1024;
                *(float4*)(op + lane * 8) = make_float4(v[0], v[1], v[2], v[3]); *(float4*)(op + lane * 8 + 4) = make_float4(v[4], v[5], v[6], v[7]);
                *(float4*)(op + 512 + lane * 8) = make_float4(v[8], v[9], v[10], v[11]); *(float4*)(op + 512 + lane * 8 + 4) = make_float4(v[12], v[13], v[14], v[15]);
            }
        }
    }
}

__device__ __forceinline__ void run_phase(const Params& p, int ph, int layer, unsigned char* smem) {
    switch (ph) {
        case 0: prep_phase(p, layer, layer == 0, smem); break;
        case 1: inproj_phase(p, layer, smem); break;
        case 2: p2a_phase(p, layer, smem); break;
        case 3: p2b_phase(p, layer, smem); break;
        case 4: merge_phase(p, smem); break;
        case 5: wout_phase(p, smem); break;
        case 6: router_phase(p, layer, smem); break;
        case 7: moe_up_phase(p, smem); break;
        case 8: moe_down_phase(p, smem); break;
        default: combine_phase(p, layer); if (layer == 0) prep_phase(p, 1, false, smem); break;
    }
}


#define XB_TMO      128
#define XB_XCNT(j)  (256  + 64 * (j))
#define XB_XSUB(j)  (1280 + 64 * (j))
#define XB_XGEN(j)  (2304 + 64 * (j))
#define XB_TOP      3328
#define XB_TOPGEN   3392
#define XCD_BAR_WORDS 3456
#define XB_SPIN_CAP (1u << 22)
#define LAS __attribute__((address_space(3)))
__device__ __forceinline__ unsigned xb_ld(unsigned* p)              { return __hip_atomic_load(p, __ATOMIC_RELAXED, __HIP_MEMORY_SCOPE_AGENT); }
__device__ __forceinline__ unsigned xb_add(unsigned* p, unsigned v) { return __hip_atomic_fetch_add(p, v, __ATOMIC_RELAXED, __HIP_MEMORY_SCOPE_AGENT); }
__device__ __forceinline__ unsigned xb_xcc_id() { return (unsigned)__builtin_amdgcn_s_getreg((3 << 11) | 20) & 0xFu; }
#define XB_SPIN(cond, bar) do { unsigned _sp = 0; while (cond) { __builtin_amdgcn_s_sleep(1); \
    if ((++_sp & 255u) == 0u) { if (xb_ld(&(bar)[XB_TMO])) break; if (_sp > XB_SPIN_CAP) { atomicAdd(&(bar)[XB_TMO], 1u); break; } } } } while (0)
struct XcdBarrier { unsigned* bar; unsigned x; volatile LAS unsigned* st; };
__device__ __forceinline__ XcdBarrier xcd_barrier_post(unsigned* bar, volatile LAS unsigned* st) {
    XcdBarrier b; b.bar = bar; b.x = xb_xcc_id(); b.st = st;
    if (threadIdx.x == 0) (void)xb_add(&bar[XB_XCNT(b.x)], 1u);
    return b;
}
__device__ __forceinline__ void xcd_barrier_complete(unsigned* bar, unsigned x, unsigned& nloc, unsigned& nx) {
    const unsigned G = gridDim.x * gridDim.y * gridDim.z;
    unsigned sum, cnt, mine, sp = 0u;
    for (;;) {
        sum = 0u; cnt = 0u; mine = 0u;
#pragma unroll
        for (unsigned j = 0; j < 16; ++j) { const unsigned c = xb_ld(&bar[XB_XCNT(j)]); sum += c; cnt += (c > 0u) ? 1u : 0u; mine = (j == x) ? c : mine; }
        if (sum == G) break;
        __builtin_amdgcn_s_sleep(1);
        if ((++sp & 255u) == 0u) { if (xb_ld(&bar[XB_TMO])) break; if (sp > XB_SPIN_CAP) { atomicAdd(&bar[XB_TMO], 1u); break; } }
    }
    nloc = mine > 0u ? mine : 1u; nx = cnt > 0u ? cnt : 1u;
}
__device__ __forceinline__ void xcd_barrier(const XcdBarrier& b) {
    asm volatile("s_waitcnt vmcnt(0)" ::: "memory");
    __syncthreads();
    if (threadIdx.x == 0) {
        unsigned* bar = b.bar;
        __builtin_amdgcn_s_waitcnt(0);
        unsigned nloc = b.st[0], nx = b.st[1];
        if (nloc == 0u) { xcd_barrier_complete(bar, b.x, nloc, nx); b.st[0] = nloc; b.st[1] = nx; }
        const unsigned old = xb_add(&bar[XB_XSUB(b.x)], 1u);
        const unsigned gen = old / nloc;
        if (old + 1u == (gen + 1u) * nloc) {
            __builtin_amdgcn_fence(__ATOMIC_RELEASE, "agent");
            asm volatile("s_waitcnt vmcnt(0)" ::: "memory");
            const unsigned og = xb_add(&bar[XB_TOP], 1u);
            const unsigned tg = og / nx;
            if (og + 1u == (tg + 1u) * nx) xb_add(&bar[XB_TOPGEN], 1u);
            else XB_SPIN(xb_ld(&bar[XB_TOPGEN]) == tg, bar);
            __builtin_amdgcn_fence(__ATOMIC_ACQUIRE, "agent");
            xb_add(&bar[XB_XGEN(b.x)], 1u);
            asm volatile("s_waitcnt vmcnt(0)" ::: "memory");
        } else {
            XB_SPIN(xb_ld(&bar[XB_XGEN(b.x)]) == gen, bar);
            __builtin_amdgcn_fence(__ATOMIC_ACQUIRE, "agent");
            asm volatile("s_waitcnt vmcnt(0)" ::: "memory");
        }
    }
    __syncthreads();
}

#if ONE_LAUNCH
__device__ __forceinline__ void run_layer(const Params& p, const int layer, unsigned char* smem, const XcdBarrier& xb) {
    inproj_phase(p, layer, smem);      xcd_barrier(xb);
    p2a_phase(p, layer, smem);         xcd_barrier(xb);
    p2b_phase(p, layer, smem);         xcd_barrier(xb);
    merge_phase(p, smem);              xcd_barrier(xb);
    wout_phase(p, smem);               xcd_barrier(xb);
    router_phase(p, layer, smem);      xcd_barrier(xb);
    moe_up_phase(p, smem);             xcd_barrier(xb);
    moe_down_phase(p, smem);           xcd_barrier(xb);
    combine_phase(p, layer);
    if (layer == 0) { prep_phase(p, 1, false, smem); xcd_barrier(xb); }
}
__global__ void __launch_bounds__(NTHR, 2) k_mega(Params p) {
    __shared__ __attribute__((aligned(16))) unsigned char smem[SMEM_BYTES];
    volatile LAS unsigned* st = (volatile LAS unsigned*)(smem + SMEM_BAR_OFF);
    if (threadIdx.x == 0) { st[0] = 0u; st[1] = 0u; st[2] = 0u; st[3] = 0u; }
    __syncthreads();
    XcdBarrier xb = xcd_barrier_post((unsigned*)(p.ws + OFF_BAR), st);
    prep_phase(p, 0, true, smem);
    xcd_barrier(xb);
    run_layer(p, 0, smem, xb);
    run_layer(p, 1, smem, xb);
}
#endif

#if !ONE_LAUNCH
template <int PH> __global__ void __launch_bounds__(NTHR, 2) k_phase(Params p, int layer) {
    __shared__ __attribute__((aligned(16))) unsigned char smem[SMEM_BYTES];
    run_phase(p, PH, layer, smem);
}
#endif

extern "C" void kernel_launch(void* const* d_in, const int* in_sizes, int n_in, void* d_out, int out_size, void* d_ws, size_t ws_size, hipStream_t stream) {
    if (ws_size < WS_TOTAL) { fprintf(stderr, "kernel_launch: workspace too small: %zu < %zu\n", ws_size, (size_t)WS_TOTAL); return; }
    Params p{};
    for (int i = 0; i < 32; ++i) p.in[i] = (const float*)d_in[i];
    p.out = (float*)d_out; p.ws = (unsigned char*)d_ws;
    (void)hipMemsetAsync((char*)d_ws + OFF_BAR, 0, 16384, stream);
#if ONE_LAUNCH
    static int grid_blocks = 0;
    if (!grid_blocks) {
        int dev = 0, cus = 0, per_cu = 0;
        (void)hipGetDevice(&dev);
        (void)hipDeviceGetAttribute(&cus, hipDeviceAttributeMultiprocessorCount, dev);
        if (hipOccupancyMaxActiveBlocksPerMultiprocessor(&per_cu, (const void*)k_mega, NTHR, 0) != hipSuccess || per_cu < 1) { fprintf(stderr, "kernel_launch: occupancy query failed\n"); return; }
        if (per_cu > 2) per_cu = 2;
        grid_blocks = cus * per_cu;
    }
    void* args[] = {&p};
    hipError_t e = hipLaunchCooperativeKernel((const void*)k_mega, dim3(grid_blocks), dim3(NTHR), args, 0, stream);
    if (e != hipSuccess) fprintf(stderr, "cooperative launch failed: %s (grid %d)\n", hipGetErrorString(e), grid_blocks);
#else
    const int G = 512;
    hipLaunchKernelGGL(k_phase<0>, dim3(G), dim3(NTHR), 0, stream, p, 0);
    for (int layer = 0; layer < 2; ++layer) {
        hipLaunchKernelGGL(k_phase<1>, dim3(G), dim3(NTHR), 0, stream, p, layer);
        hipLaunchKernelGGL(k_phase<2>, dim3(G), dim3(NTHR), 0, stream, p, layer);
        hipLaunchKernelGGL(k_phase<3>, dim3(G), dim3(NTHR), 0, stream, p, layer);
        hipLaunchKernelGGL(k_phase<4>, dim3(G), dim3(NTHR), 0, stream, p, layer);
        hipLaunchKernelGGL(k_phase<5>, dim3(G), dim3(NTHR), 0, stream, p, layer);
        hipLaunchKernelGGL(k_phase<6>, dim3(G), dim3(NTHR), 0, stream, p, layer);
        hipLaunchKernelGGL(k_phase<7>, dim3(G), dim3(NTHR), 0, stream, p, layer);
        hipLaunchKernelGGL(k_phase<8>, dim3(G), dim3(NTHR), 0, stream, p, layer);
        hipLaunchKernelGGL(k_phase<9>, dim3(G), dim3(NTHR), 0, stream, p, layer);
    }
#endif
}
```

```cpp
#include <hip/hip_runtime.h>
#include <stdint.h>
#include <stdio.h>


typedef unsigned short u16;
typedef short bf16x8 __attribute__((ext_vector_type(8)));
typedef short bf16x4 __attribute__((ext_vector_type(4)));
typedef float f32x4 __attribute__((ext_vector_type(4)));
typedef unsigned u32x4 __attribute__((ext_vector_type(4)));
typedef unsigned u32x2 __attribute__((ext_vector_type(2)));

#define NTHR 512
#define T_TOK 16384
#define SEQ 2048
#define DM 1024
#define ALPHA_F 1.41421356237f
#define LN_EPS_F 1e-5f
#define NEGBIG (-1e30f)
#define LDU 2560
#define LDACT 1280
#define SMEM_HALF 65536
#define SMEM_BYTES 136192
#define SMEM_ROWINFO_OFF 132096
#define SMEM_PRE_OFF 131072
#define SMEM_GS_OFF 132064
#define SMEM_BAR_OFF 132080
#define SMEM_PROBE_OFF 132048

struct Params { const float* in[32]; float* out; unsigned char* ws; };

constexpr size_t al256(size_t x) { return (x + 255) & ~(size_t)255; }
constexpr size_t OFF_BAR   = 0;
constexpr size_t OFF_CNT   = 16384;
constexpr size_t OFF_BIAS1 = 32768;
constexpr size_t OFF_XB    = 65536;
constexpr size_t SZ_TD     = (size_t)T_TOK * 1024 * 2;
constexpr size_t OFF_Z     = OFF_XB + SZ_TD;
constexpr size_t OFF_A     = OFF_Z + SZ_TD;
constexpr size_t OFF_U     = OFF_A;
constexpr size_t SZ_U      = (size_t)T_TOK * LDU * 2;
constexpr size_t OFF_UT    = OFF_U + SZ_U;
constexpr size_t SZ_UT     = (size_t)8 * 1024 * 2048 * 2;
constexpr size_t SZ_A      = (size_t)T_TOK * 6 * 1024 * 2;
static_assert(SZ_A >= SZ_U + SZ_UT, "region A");
constexpr size_t OFF_YSLOT = OFF_A;
constexpr size_t OFF_B     = OFF_A + SZ_A;
constexpr size_t OFF_ACT   = OFF_B;
constexpr size_t SZ_ACT    = (size_t)T_TOK * LDACT * 2;
constexpr size_t OFF_MERGED= OFF_ACT + SZ_ACT;
constexpr size_t SZ_B      = SZ_ACT + SZ_TD;
constexpr size_t OFF_H     = OFF_B;
static_assert(SZ_B >= (size_t)(98304 + 64 * 255 + 16384 + 256) * 256 * 2, "region B");
constexpr size_t OFF_KC    = OFF_B + SZ_B;
constexpr size_t SZ_KC     = al256(((size_t)T_TOK * 64 + 1024) * 2);
constexpr size_t OFF_VC    = OFF_KC + SZ_KC;
constexpr size_t OFF_KCMP  = OFF_VC + SZ_KC;
constexpr size_t OFF_VCMPT = OFF_KCMP + 1024 * 64 * 2;
constexpr size_t OFF_KVT   = OFF_VCMPT + 8 * 64 * 128 * 2;
constexpr size_t OFF_LIST  = OFF_KVT + (size_t)512 * 8192 * 4;
constexpr size_t OFF_GATEW = OFF_LIST + (size_t)64 * 16384 * 4;
constexpr size_t OFF_WINT  = OFF_GATEW + (size_t)T_TOK * 8 * 4;
constexpr size_t OFF_PT    = OFF_WINT + (size_t)7680 * 1024 * 2;
constexpr size_t OFF_WOUT  = OFF_PT + (size_t)1280 * 1024 * 2;
constexpr size_t OFF_RW    = OFF_WOUT + (size_t)1024 * 1024 * 2;
constexpr size_t OFF_WUP   = OFF_RW + (size_t)64 * 1024 * 2;
constexpr size_t OFF_WD    = OFF_WUP + (size_t)65 * 512 * 1024 * 2;
constexpr size_t OFF_W1T   = OFF_WD + (size_t)65 * 1024 * 256 * 2;
constexpr size_t OFF_W2T   = OFF_W1T + (size_t)2 * 256 * 2048 * 2;
constexpr size_t WS_TOTAL  = OFF_W2T + (size_t)2 * 64 * 256 * 2;

#define MFMA16(a, b, c) __builtin_amdgcn_mfma_f32_16x16x32_bf16((a), (b), (c), 0, 0, 0)

__device__ __forceinline__ u16 f2bf(float f) { uint32_t u = __float_as_uint(f); u += 0x7fffu + ((u >> 16) & 1u); return (u16)(u >> 16); }
__device__ __forceinline__ float bf2f(u16 h) { return __uint_as_float(((uint32_t)h) << 16); }
__device__ __forceinline__ uint32_t pack2(float a, float b) { return (uint32_t)f2bf(a) | ((uint32_t)f2bf(b) << 16); }
__device__ __forceinline__ uint2 pack4(f32x4 v) { return make_uint2(pack2(v[0], v[1]), pack2(v[2], v[3])); }
__device__ __forceinline__ float sigmoidf_(float x) { return 1.f / (1.f + __expf(-x)); }
__device__ __forceinline__ float siluf_(float x) { return x / (1.f + __expf(-x)); }
__device__ __forceinline__ float bflo(uint32_t w) { return __uint_as_float(w << 16); }
__device__ __forceinline__ float bfhi(uint32_t w) { return __uint_as_float(w & 0xffff0000u); }

#define LAS __attribute__((address_space(3)))
__shared__ __attribute__((aligned(16))) unsigned char g_smem[SMEM_BYTES];
#define VBID  ((int)(blockIdx.x * 2 + __builtin_amdgcn_readfirstlane((int)(threadIdx.x >> 8))))
#define VGRID ((int)(gridDim.x * 2))
__device__ __forceinline__ void gsync() {
    unsigned* ctr = (unsigned*)(g_smem + SMEM_GS_OFF) + (threadIdx.x >> 8);
    __builtin_amdgcn_fence(__ATOMIC_RELEASE, "workgroup");
    unsigned old = 0u;
    if ((threadIdx.x & 63) == 0) old = __hip_atomic_fetch_add(ctr, 1u, __ATOMIC_RELAXED, __HIP_MEMORY_SCOPE_WORKGROUP);
    old = (unsigned)__builtin_amdgcn_readfirstlane((int)old);
    const unsigned want = ((old >> 2) + 1u) << 2;
    while (__hip_atomic_load(ctr, __ATOMIC_RELAXED, __HIP_MEMORY_SCOPE_WORKGROUP) < want) __builtin_amdgcn_s_sleep(0);
    __builtin_amdgcn_fence(__ATOMIC_ACQUIRE, "workgroup");
}
#define GSYNC() gsync()

#ifndef PROBE_ID
#define PROBE_ID -1
#endif
#define PROBE_AMP 8
#define PB(id) do { if ((id) == PROBE_ID && blockIdx.x == 0 && threadIdx.x == 0) { *(volatile unsigned long long*)(g_smem + SMEM_PROBE_OFF + 8) = __builtin_amdgcn_s_memrealtime(); } } while (0)
#define PE(id) do { if ((id) == PROBE_ID && blockIdx.x == 0 && threadIdx.x == 0) { volatile unsigned long long* q_ = (volatile unsigned long long*)(g_smem + SMEM_PROBE_OFF); q_[0] += __builtin_amdgcn_s_memrealtime() - q_[1]; } } while (0)

__device__ __forceinline__ int tid_opaque() { int t = threadIdx.x & 255; asm volatile("" : "+v"(t)); return t; }
__device__ __forceinline__ unsigned char* ws_opaque(unsigned char* w) {
    unsigned lo = (unsigned)(uintptr_t)w, hi = (unsigned)((uintptr_t)w >> 32);
    asm volatile("" : "+v"(lo), "+v"(hi));
    lo = __builtin_amdgcn_readfirstlane(lo); hi = __builtin_amdgcn_readfirstlane(hi);
    return (unsigned char*)(((uintptr_t)hi << 32) | (uintptr_t)lo);
}

template <int WM, int WN> __device__ __forceinline__ void zero_acc(f32x4 (&acc)[WM][WN]) {
#pragma unroll
    for (int i = 0; i < WM; ++i)
#pragma unroll
        for (int j = 0; j < WN; ++j) acc[i][j] = (f32x4){0.f, 0.f, 0.f, 0.f};
}

template <int WM, int WN, class FA, class FB>
__device__ __forceinline__ void gemm_acc(f32x4 (&acc)[WM][WN], FA rowA, FB rowB, int K, unsigned char* sbase) {
    constexpr int A_BYTES = 32 * WM * 128, B_BYTES = 32 * WN * 128, BUF = A_BYTES + B_BYTES;
    const int tid = tid_opaque(), lane = tid & 63, wave = tid >> 6;
    const int wm = wave >> 1, wn = wave & 1;
    const int fr = lane & 15, fg = lane >> 4;
    const int lrow = lane >> 3, lch = (lane & 7) ^ lrow;
    const u16* pa[WM]; const u16* pb[WN];
#pragma unroll
    for (int i = 0; i < WM; ++i) pa[i] = rowA((wave + 4 * i) * 8 + lrow) + lch * 8;
#pragma unroll
    for (int j = 0; j < WN; ++j) pb[j] = rowB((wave + 4 * j) * 8 + lrow) + lch * 8;
    unsigned char* const ldst = sbase + wave * 1024 + lane * 16;
    GSYNC();
#pragma unroll
    for (int i = 0; i < WM; ++i) __builtin_amdgcn_global_load_lds((const unsigned*)(pa[i]), (unsigned*)(ldst + i * 4096), 16, 0, 0);
#pragma unroll
    for (int j = 0; j < WN; ++j) __builtin_amdgcn_global_load_lds((const unsigned*)(pb[j]), (unsigned*)(ldst + A_BYTES + j * 4096), 16, 0, 0);
    const int nk = K >> 6;
    for (int kt = 0; kt < nk; ++kt) {
        GSYNC();
        if (kt + 1 < nk) {
            unsigned char* const d = ldst + ((kt + 1) & 1) * BUF;
            const int ko = (kt + 1) * 64;
#pragma unroll
            for (int i = 0; i < WM; ++i) __builtin_amdgcn_global_load_lds((const unsigned*)(pa[i] + ko), (unsigned*)(d + i * 4096), 16, 0, 0);
#pragma unroll
            for (int j = 0; j < WN; ++j) __builtin_amdgcn_global_load_lds((const unsigned*)(pb[j] + ko), (unsigned*)(d + A_BYTES + j * 4096), 16, 0, 0);
        }
        const unsigned char* a0 = sbase + (kt & 1) * BUF + (wm * 16 * WM + fr) * 128;
        const unsigned char* b0 = sbase + (kt & 1) * BUF + A_BYTES + (wn * 16 * WN + fr) * 128;
#pragma unroll
        for (int ks = 0; ks < 2; ++ks) {
            const int co = ((4 * ks + fg) ^ (fr & 7)) << 4;
            bf16x8 a[WM], b[WN];
#pragma unroll
            for (int i = 0; i < WM; ++i) a[i] = *(const bf16x8*)(a0 + i * 2048 + co);
#pragma unroll
            for (int j = 0; j < WN; ++j) b[j] = *(const bf16x8*)(b0 + j * 2048 + co);
#pragma unroll
            for (int i = 0; i < WM; ++i)
#pragma unroll
                for (int j = 0; j < WN; ++j) acc[i][j] = MFMA16(a[i], b[j], acc[i][j]);
        }
    }
}

template <int TM, int TN> struct G8 {
    static constexpr int A_BYTES = 32 * TM * 64, B_BYTES = 64 * TN * 64, SLOT = A_BYTES + B_BYTES, PA = TM / 4, PB = TN / 2, NP = PA + PB;
    static_assert(4 * SLOT <= 131072, "ring");
    const u16* pp[NP];
};
template <int TM, int TN, class FA, class FB>
__device__ __forceinline__ void g8_setup(G8<TM, TN>& g, FA rowA, FB rowB) {
    int tid = threadIdx.x; asm volatile("" : "+v"(tid));
    const int lane = tid & 63, wave = tid >> 6;
    const int srow = lane >> 2, sch = (lane & 3) ^ ((0 - (lane >> 4)) & 3);
#pragma unroll
    for (int i = 0; i < G8<TM, TN>::PA; ++i) g.pp[i] = rowA(16 * (wave + 8 * i) + srow) + sch * 8;
#pragma unroll
    for (int j = 0; j < G8<TM, TN>::PB; ++j) g.pp[G8<TM, TN>::PA + j] = rowB(16 * (wave + 8 * j) + srow) + sch * 8;
}
#define G8_ISSUE(g, sl) do { unsigned char* const d_ = ldst + ((sl) & 3) * GT::SLOT; const int ko_ = (sl) * 32; \
        _Pragma("unroll") for (int q = 0; q < GT::NP; ++q) \
            __builtin_amdgcn_global_load_lds((const unsigned*)((g).pp[q] + ko_), (unsigned*)(d_ + (q < GT::PA ? q * 8192 : GT::A_BYTES + (q - GT::PA) * 8192)), 16, 0, 0); } while (0)
template <int TM, int TN>
__device__ __forceinline__ void g8_prefetch(const G8<TM, TN>& g, int K) {
    typedef G8<TM, TN> GT;
    int tid = threadIdx.x; asm volatile("" : "+v"(tid));
    unsigned char* const ldst = g_smem + (tid >> 6) * 1024 + (tid & 63) * 16;
    G8_ISSUE(g, 0);
    if (K > 32) G8_ISSUE(g, 1);
}
template <int TM, int TN>
__device__ __forceinline__ void g8_run(const G8<TM, TN>& g, f32x4 (&acc)[TM][TN], int K) {
    typedef G8<TM, TN> GT;
    int tid = threadIdx.x; asm volatile("" : "+v"(tid));
    const int lane = tid & 63, wave = tid >> 6, wr = wave >> 2, wc = wave & 3;
    const int fr = lane & 15, fg = lane >> 4;
    unsigned char* const ldst = g_smem + wave * 1024 + lane * 16;
    const int swz = (fg ^ ((0 - (fr >> 2)) & 3)) << 4;
    const int aoff = (wr * 16 * TM + fr) * 64 + swz, boff = GT::A_BYTES + (wc * 16 * TN + fr) * 64 + swz;
    const int ns = K >> 5;
    const int wr_u = __builtin_amdgcn_readfirstlane(wr);
    asm volatile("s_waitcnt vmcnt(0)" ::: "memory");
    __builtin_amdgcn_s_barrier();
    __builtin_amdgcn_sched_barrier(0);
    if (wr_u == 1) __builtin_amdgcn_s_barrier();
    __builtin_amdgcn_sched_barrier(0);
    for (int s = 0; s < ns; ++s) {
        const unsigned char* sl = g_smem + (s & 3) * GT::SLOT;
        bf16x8 a[TM], b[TN];
#pragma unroll
        for (int j = 0; j < TN; ++j) b[j] = *(const bf16x8*)(sl + boff + j * 1024);
#pragma unroll
        for (int i = 0; i < TM; ++i) a[i] = *(const bf16x8*)(sl + aoff + i * 1024);
        if (s + 2 < ns) { G8_ISSUE(g, s + 2); asm volatile("s_waitcnt vmcnt(%0)" :: "i"(GT::NP) : "memory"); }
        else asm volatile("s_waitcnt vmcnt(0)" ::: "memory");
        asm volatile("s_waitcnt lgkmcnt(0)" ::: "memory");
        __builtin_amdgcn_sched_barrier(0);
        __builtin_amdgcn_s_barrier();
        __builtin_amdgcn_sched_barrier(0);
        __builtin_amdgcn_s_setprio(1);
#pragma unroll
        for (int i = 0; i < TM; ++i)
#pragma unroll
            for (int j = 0; j < TN; ++j) acc[i][j] = MFMA16(a[i], b[j], acc[i][j]);
        __builtin_amdgcn_s_setprio(0);
        __builtin_amdgcn_sched_barrier(0);
        __builtin_amdgcn_s_barrier();
        __builtin_amdgcn_sched_barrier(0);
    }
    if (wr_u == 0) __builtin_amdgcn_s_barrier();
    __builtin_amdgcn_sched_barrier(0);
}
template <int TM, int TN, class F>
__device__ __forceinline__ void g8_store_rows(const uint2 (&pk)[TM][TN], F sink) {
    typedef G8<8, 4> GS;
    constexpr int RB = 32 * TM;
    constexpr int C16 = 2 * TM;
    static_assert(64 * TN * RB <= 65536, "staging");
    int tid = threadIdx.x; asm volatile("" : "+v"(tid));
    const int lane = tid & 63, wave = tid >> 6, wr = wave >> 2, wc = wave & 3, fr = lane & 15, fg = lane >> 4;
    unsigned char* const stg = g_smem + 2 * GS::SLOT;
#pragma unroll
    for (int h = 0; h < 2; ++h) {
        if (h == 1) { asm volatile("s_waitcnt lgkmcnt(0)" ::: "memory"); __builtin_amdgcn_s_barrier(); }
        __builtin_amdgcn_sched_barrier(0);
        if (wr == h) {
#pragma unroll
            for (int i = 0; i < TM; ++i)
#pragma unroll
                for (int j = 0; j < TN; ++j) {
                    const int n = wc * 16 * TN + 16 * j + fr, c = 4 * i + fg;
                    *(uint2*)(stg + n * RB + ((c ^ ((n & 7) << 1)) << 3)) = pk[i][j];
                }
        }
        asm volatile("s_waitcnt lgkmcnt(0)" ::: "memory");
        __builtin_amdgcn_s_barrier();
        __builtin_amdgcn_sched_barrier(0);
#pragma unroll
        for (int it = 0; it < (64 * TN * C16) / 512; ++it) {
            const int idx = it * 512 + tid, n = idx / C16, k = idx % C16;
            const u32x4 v = *(const u32x4*)(stg + n * RB + ((k ^ (n & 7)) << 4));
            sink(h * 16 * TM + 8 * k, n, v);
        }
    }
}
#define FULL_LANE_VARS int t_ = threadIdx.x; asm volatile("" : "+v"(t_)); const int lane = t_ & 63, wave = t_ >> 6, wr = wave >> 2, wc = wave & 3, fr = lane & 15, fg = lane >> 4; (void)wr; (void)wc; (void)fr; (void)fg; (void)lane;

__device__ __forceinline__ void stage_rows64(u16* s, const u16* g, int ld) {
    const int t = tid_opaque(), r = t >> 2, c = (t & 3) * 16;
    const uint4* p = (const uint4*)(g + (size_t)r * ld + c);
    const uint4 v0 = p[0], v1 = p[1];
    *(uint4*)&s[r * 72 + c] = v0; *(uint4*)&s[r * 72 + c + 8] = v1;
}
__device__ __forceinline__ void qk64(const u16* sK, const bf16x8 (&qf)[2], f32x4 (&s)[4], int lane) {
    const int r = lane & 15, g = lane >> 4;
#pragma unroll
    for (int mt = 0; mt < 4; ++mt) {
        s[mt] = (f32x4){0.f, 0.f, 0.f, 0.f};
#pragma unroll
        for (int ks = 0; ks < 2; ++ks) {
            const bf16x8 a = *(const bf16x8*)&sK[(16 * mt + r) * 72 + 32 * ks + 8 * g];
            s[mt] = MFMA16(a, qf[ks], s[mt]);
        }
    }
}
template <int DT>
__device__ __forceinline__ void pv64(const u16* sVt, int vstride, const bf16x8 (&pb)[2], f32x4 (&o)[DT], int lane) {
    const int r = lane & 15, g = lane >> 4;
#pragma unroll
    for (int dt = 0; dt < DT; ++dt)
#pragma unroll
        for (int s2 = 0; s2 < 2; ++s2) {
            const u16* p = &sVt[(16 * dt + r) * vstride + 32 * s2 + 4 * g];
            const u32x2 lo = *(const u32x2*)p, hi = *(const u32x2*)(p + 16);
            const u32x4 av = {lo.x, lo.y, hi.x, hi.y};
            o[dt] = MFMA16(__builtin_bit_cast(bf16x8, av), pb[s2], o[dt]);
        }
}
__device__ __forceinline__ void pack_p(const float (&x)[16], bf16x8 (&pb)[2]) {
#pragma unroll
    for (int s2 = 0; s2 < 2; ++s2) {
        const u32x4 tv = {pack2(x[8 * s2 + 0], x[8 * s2 + 1]), pack2(x[8 * s2 + 2], x[8 * s2 + 3]),
                          pack2(x[8 * s2 + 4], x[8 * s2 + 5]), pack2(x[8 * s2 + 6], x[8 * s2 + 7])};
        pb[s2] = __builtin_bit_cast(bf16x8, tv);
    }
}
template <int DT, class F>
__device__ __forceinline__ void flash_step(const u16* sK, const u16* sVt, int vstride, const bf16x8 (&qf)[2],
                                           f32x4 (&o)[DT], float& m, float& l, bool lane_active, F logit, int lane) {
    if (__ballot(lane_active) == 0ull) return;
    f32x4 s[4]; qk64(sK, qf, s, lane);
    const int g = lane >> 4;
    float x[16]; float mx = NEGBIG;
#pragma unroll
    for (int mt = 0; mt < 4; ++mt)
#pragma unroll
        for (int rr = 0; rr < 4; ++rr) {
            bool valid; float v = logit(16 * mt + 4 * g + rr, s[mt][rr], valid);
            v = (valid && lane_active) ? v : NEGBIG; x[mt * 4 + rr] = v; mx = fmaxf(mx, v);
        }
    mx = fmaxf(mx, __shfl_xor(mx, 16)); mx = fmaxf(mx, __shfl_xor(mx, 32));
    const float mn = fmaxf(m, mx), alpha = __expf(m - mn);
    float ps = 0.f;
#pragma unroll
    for (int i = 0; i < 16; ++i) { const float pv = (x[i] > -1e29f) ? __expf(x[i] - mn) : 0.f; x[i] = pv; ps += pv; }
    l = l * alpha + ps; m = mn;
#pragma unroll
    for (int dt = 0; dt < DT; ++dt) o[dt] *= alpha;
    bf16x8 pb[2]; pack_p(x, pb);
    pv64<DT>(sVt, vstride, pb, o, lane);
}

__device__ __forceinline__ void prep_tile(const float* __restrict__ src, int ld_src, int k0, int c0, int nvalid,
                                          u16* __restrict__ dst, int ld_dst, int drow_base, int grp_stride, float* tile) {
    const int t = tid_opaque();
    {
        const int rr = t >> 4, cc = (t & 15) * 4;
#pragma unroll
        for (int ii = 0; ii < 4; ++ii) {
            const int row = rr + 16 * ii;
            float4 v = make_float4(0.f, 0.f, 0.f, 0.f);
            if (cc < nvalid) v = *(const float4*)(src + (size_t)(k0 + row) * ld_src + c0 + cc);
            float* tp = tile + row * 65 + cc; tp[0] = v.x; tp[1] = v.y; tp[2] = v.z; tp[3] = v.w;
        }
    }
    GSYNC();
    {
        const int j = t >> 2, kk = (t & 3) * 16;
        uint32_t w[8];
#pragma unroll
        for (int i = 0; i < 8; ++i) w[i] = pack2(tile[(kk + 2 * i) * 65 + j], tile[(kk + 2 * i + 1) * 65 + j]);
        u16* dp = dst + (size_t)(drow_base + (j >> 4) * grp_stride + (j & 15)) * ld_dst + k0 + kk;
        *(uint4*)dp = make_uint4(w[0], w[1], w[2], w[3]); *(uint4*)(dp + 8) = make_uint4(w[4], w[5], w[6], w[7]);
    }
    GSYNC();
}
__device__ __forceinline__ void win_seg(int drow, int& src, int& nvalid) {
    nvalid = 64;
    if (drow < 896) src = drow;
    else if (drow < 1152) src = 1024 + (drow - 896);
    else if (drow < 1408) src = 1280 + (drow - 1152);
    else if (drow < 1920) src = 2048 + (drow - 1408);
    else if (drow < 2176) src = 2560 + (drow - 1920);
    else if (drow < 2240) src = 2816;
    else if (drow < 2304) src = 2880;
    else if (drow < 2368) src = 2944;
    else if (drow < 2432) src = 3072;
    else if (drow < 2496) { src = 3200; nvalid = 12; }
    else if (drow < 2560) { src = 0; nvalid = 0; }
    else if (drow < 2688) src = 896 + (drow - 2560);
    else if (drow < 2944) src = 1280 + (drow - 2688);
    else if (drow < 3456) src = 1536 + (drow - 2944);
    else if (drow < 3520) src = 3008;
    else if (drow < 3584) src = 3136;
    else src = 3212 + (drow - 3584);
}
__device__ __forceinline__ void cvt16(const float* src, u16* dst) {
    const float4 a = ((const float4*)src)[0], b = ((const float4*)src)[1], c = ((const float4*)src)[2], d = ((const float4*)src)[3];
    *(uint4*)dst = make_uint4(pack2(a.x, a.y), pack2(a.z, a.w), pack2(b.x, b.y), pack2(b.z, b.w));
    *(uint4*)(dst + 8) = make_uint4(pack2(c.x, c.y), pack2(c.z, c.w), pack2(d.x, d.y), pack2(d.z, d.w));
}
__device__ __forceinline__ void prep_phase(const Params& p, int layer, bool with_x, unsigned char* smem) {
    float* tile = (float*)smem;
    unsigned char* ws = ws_opaque(p.ws);
    const int nA = 1920, nB = 320, nC = 256, nD = 8320, nE = 4160, nF = 256, nG = 8, nH = 16, nI = 32, nJ = 1, nX = with_x ? 4096 : 0;
    const int total = nA + nB + nC + nD + nE + nF + nG + nH + nI + nJ + nX;
    const int t = tid_opaque();
    for (int it = VBID; it < total; it += VGRID) {
        int idx = it;
        if (idx < nA) {
            const int dg = idx >> 4, kt = idx & 15; int src, nv; win_seg(dg * 64, src, nv);
            prep_tile(p.in[1] + (size_t)layer * 1024 * 7308, 7308, kt * 64, src, nv, (u16*)(ws + OFF_WINT), 1024, dg * 64, 16, tile);
            continue;
        }
        idx -= nA;
        if (idx < nB) {
            const float* src; int K, local; size_t off;
            if (idx < 64) { src = p.in[15] + (size_t)layer * 256 * 1024; K = 256; local = idx; off = 0; }
            else if (idx < 128) { src = p.in[16] + (size_t)layer * 256 * 1024; K = 256; local = idx - 64; off = 262144; }
            else if (idx < 256) { src = p.in[17] + (size_t)layer * 512 * 1024; K = 512; local = idx - 128; off = 524288; }
            else { src = p.in[18] + (size_t)layer * 256 * 1024; K = 256; local = idx - 256; off = 1048576; }
            const int nk = K >> 6, ct = local / nk, kt = local % nk;
            prep_tile(src, 1024, kt * 64, ct * 64, 64, (u16*)(ws + OFF_PT) + off, K, ct * 64, 16, tile);
            continue;
        }
        idx -= nB;
        if (idx < nC) {
            const int ct = idx >> 4, kt = idx & 15;
            prep_tile(p.in[19] + (size_t)layer * 1024 * 1024, 1024, kt * 64, ct * 64, 64, (u16*)(ws + OFF_WOUT), 1024, ct * 64, 16, tile);
            continue;
        }
        idx -= nC;
        if (idx < nD) {
            const int e = idx >> 7, rem = idx & 127, isUp = rem >> 6, r2 = rem & 63, ct = r2 >> 4, kt = r2 & 15;
            const float* src = (e < 64) ? p.in[24 + isUp] + ((size_t)layer * 64 + e) * 1024 * 256 : p.in[27 + isUp] + (size_t)layer * 1024 * 256;
            prep_tile(src, 256, kt * 64, ct * 64, 64, (u16*)(ws + OFF_WUP) + (size_t)e * 512 * 1024, 1024, 32 * (ct * 4) + 16 * isUp, 32, tile);
            continue;
        }
        idx -= nD;
        if (idx < nE) {
            const int e = idx >> 6, r2 = idx & 63, ct = r2 >> 2, kt = r2 & 3;
            const float* src = (e < 64) ? p.in[26] + ((size_t)layer * 64 + e) * 256 * 1024 : p.in[29] + (size_t)layer * 256 * 1024;
            prep_tile(src, 1024, kt * 64, ct * 64, 64, (u16*)(ws + OFF_WD) + (size_t)e * 1024 * 256, 256, ct * 64, 16, tile);
            continue;
        }
        idx -= nE;
        if (idx < nF) {
            const int which = idx >> 7, r2 = idx & 127, ct = r2 >> 5, kt = r2 & 31;
            prep_tile(p.in[which ? 13 : 10] + (size_t)layer * 2048 * 256, 256, kt * 64, ct * 64, 64, (u16*)(ws + OFF_W1T) + (size_t)which * 256 * 2048, 2048, ct * 64, 16, tile);
            continue;
        }
        idx -= nF;
        if (idx < nG) {
            const int which = idx >> 2, kt = idx & 3;
            prep_tile(p.in[which ? 14 : 11] + (size_t)layer * 256 * 64, 64, kt * 64, 0, 64, (u16*)(ws + OFF_W2T) + (size_t)which * 64 * 256, 256, 0, 16, tile);
            continue;
        }
        idx -= nG;
        if (idx < nH) {
            cvt16(p.in[22] + (size_t)layer * 65536 + (size_t)idx * 4096 + t * 16, (u16*)(ws + OFF_RW) + (size_t)idx * 4096 + t * 16);
            continue;
        }
        idx -= nH;
        if (idx < nI) {
            const int which = idx >> 4, part = idx & 15;
            const float* pe = p.in[which ? 12 : 9] + (size_t)layer * 2048 + part * 128;
            const float* w1 = p.in[which ? 13 : 10] + (size_t)layer * 2048 * 256 + (size_t)part * 128 * 256;
            float s0 = 0.f, s1 = 0.f, s2 = 0.f, s3 = 0.f;
#pragma unroll 4
            for (int i = 0; i < 128; i += 4) {
                s0 += pe[i] * w1[(size_t)i * 256 + t]; s1 += pe[i + 1] * w1[(size_t)(i + 1) * 256 + t];
                s2 += pe[i + 2] * w1[(size_t)(i + 2) * 256 + t]; s3 += pe[i + 3] * w1[(size_t)(i + 3) * 256 + t];
            }
            ((float*)(ws + OFF_BIAS1))[(which * 16 + part) * 256 + t] = (s0 + s1) + (s2 + s3);
            continue;
        }
        idx -= nI;
        if (idx < nJ) {
            for (int i = t; i < 2048; i += 256) ((unsigned*)(ws + OFF_CNT))[i] = 0u;
            u16* kcp = (u16*)(ws + OFF_KC) + (size_t)T_TOK * 64; u16* vcp = (u16*)(ws + OFF_VC) + (size_t)T_TOK * 64;
            for (int i = t; i < 1024; i += 256) { kcp[i] = 0; vcp[i] = 0; }
            continue;
        }
        idx -= nJ;
        cvt16(p.in[0] + (size_t)idx * 4096 + t * 16, (u16*)(ws + OFF_XB) + (size_t)idx * 4096 + t * 16);
    }
}

__device__ __forceinline__ void inproj_phase(const Params& p, int layer, unsigned char* smem) {
    unsigned char* ws = ws_opaque(p.ws);
    const u16* XB = (const u16*)(ws + OFF_XB); const u16* WINT = (const u16*)(ws + OFF_WINT);
    u16* U = (u16*)(ws + OFF_U); u16* UT = (u16*)(ws + OFF_UT); u16* KC = (u16*)(ws + OFF_KC); u16* VC = (u16*)(ws + OFF_VC);
    FULL_LANE_VARS
    const int xcd = blockIdx.x & 7, loc = blockIdx.x >> 3, nloc = gridDim.x >> 3;
    G8<8, 4> g;
    auto setup = [&](int l) {
        const int ft = l >> 3, tt = xcd * 8 + (l & 7);
        auto rowX = [=](int r) { return XB + (size_t)(tt * 256 + r) * 1024; };
        auto rowW = [=](int r) { return WINT + (size_t)(ft * 256 + r) * 1024; };
        if (ft < 10) g8_setup<8, 4>(g, rowW, rowX); else g8_setup<8, 4>(g, rowX, rowW);
    };
    __syncthreads();
    if (loc < 112) { setup(loc); g8_prefetch<8, 4>(g, 1024); }
    for (int l = loc; l < 8 * 14; l += nloc) {
        const int ft = l >> 3, tt = xcd * 8 + (l & 7);
        f32x4 acc[8][4]; zero_acc<8, 4>(acc);
        PB(43); g8_run<8, 4>(g, acc, 1024); PE(43);
        if (l + nloc < 112) { setup(l + nloc); g8_prefetch<8, 4>(g, 1024); }
        PB(44);
        uint2 pk[8][4];
        if (ft < 10) {
#pragma unroll
            for (int i = 0; i < 8; ++i)
#pragma unroll
                for (int j = 0; j < 4; ++j) pk[i][j] = pack4(acc[i][j]);
            g8_store_rows<8, 4>(pk, [&](int mloc, int n, u32x4 v) {
                const int m = ft * 256 + mloc; const size_t tok = (size_t)tt * 256 + n;
                if (m >= 2176 && m < 2304) { const int f = m - 2176; if (f < 64) *(u32x4*)(KC + tok * 64 + f) = v; else *(u32x4*)(VC + tok * 64 + (f - 64)) = v; }
                else *(u32x4*)(U + tok * LDU + m) = v;
            });
        } else {
            const int trow0 = __builtin_amdgcn_readfirstlane(ft * 256 + wc * 64 - 2560);
            const bool scaled = (trow0 >= 128) && (trow0 < 384);
            const float l2g = __log2f(1.f - __builtin_amdgcn_exp2f(-5.f - (float)((trow0 - 128) >> 6)));
            int tl_ = threadIdx.x; asm volatile("" : "+v"(tl_));
            const int sq0 = ((tl_ >> 8) * 128 + 4 * ((tl_ & 63) >> 4)) & 127;
#pragma unroll
            for (int i = 0; i < 8; ++i) {
                float sc[4];
#pragma unroll
                for (int r = 0; r < 4; ++r) {
                    const int sq = (sq0 + 16 * i + r) & 127;
                    sc[r] = scaled ? 0.125f * __builtin_amdgcn_exp2f((float)(127 - sq) * l2g) : 1.f;
                }
#pragma unroll
                for (int j = 0; j < 4; ++j) {
                    f32x4 v = acc[i][j];
                    v[0] *= sc[0]; v[1] *= sc[1]; v[2] *= sc[2]; v[3] *= sc[3];
                    pk[i][j] = pack4(v);
                }
            }
            g8_store_rows<8, 4>(pk, [&](int mloc, int n, u32x4 v) {
                const int m = tt * 256 + mloc, trow = ft * 256 + n - 2560, b = m >> 11, sq = m & 2047;
                *(u32x4*)(UT + ((size_t)(b * 1024 + trow)) * 2048 + sq) = v;
            });
        }
        PE(44);
    }
}

__device__ __forceinline__ void compress_item(const Params& p, int item, unsigned char* smem) {
    unsigned char* ws = ws_opaque(p.ws);
    u16* sH = (u16*)(smem + 40960);
    const int which = item >> 5, r0 = (item & 31) * 32;
    const u16* src = (const u16*)(ws + (which ? OFF_VC : OFF_KC));
    const u16* W1 = (const u16*)(ws + OFF_W1T) + (size_t)which * 256 * 2048;
    const u16* W2 = (const u16*)(ws + OFF_W2T) + (size_t)which * 64 * 256;
    const int t = tid_opaque();
    const int lane = t & 63, wave = t >> 6, wm = wave >> 1, wn = wave & 1, fr = lane & 15, fg = lane >> 4;
    float* bias = (float*)(smem + 40960 + 32 * 264 * 2);
    {
        const float* bp = (const float*)(ws + OFF_BIAS1) + which * 16 * 256 + t;
        float bs = 0.f;
#pragma unroll
        for (int k = 0; k < 16; ++k) bs += bp[k * 256];
        bias[t] = bs;
    }
    for (int half = 0; half < 2; ++half) {
        f32x4 acc[4][1]; zero_acc<4, 1>(acc);
        auto rowW = [=](int r) { return W1 + (size_t)(half * 128 + r) * 2048; };
        auto rowA = [=](int r) { return src + (size_t)(r0 + r) * 1024; };
        gemm_acc<4, 1>(acc, rowW, rowA, 2048, smem);
#pragma unroll
        for (int i = 0; i < 4; ++i) {
            const int m = half * 128 + wm * 64 + 16 * i + 4 * fg, n = wn * 16 + fr;
            f32x4 v = acc[i][0];
#pragma unroll
            for (int r = 0; r < 4; ++r) { const float xx = v[r] + bias[m + r]; v[r] = 0.5f * xx * (1.f + erff(xx * 0.70710678118f)); }
            *(uint2*)&sH[n * 264 + m] = pack4(v);
        }
    }
    GSYNC();
    if (which == 0) {
        f32x4 acc2[2];
        acc2[0] = (f32x4){0.f, 0.f, 0.f, 0.f}; acc2[1] = acc2[0];
#pragma unroll
        for (int ks = 0; ks < 8; ++ks) {
            const bf16x8 a = *(const bf16x8*)(W2 + (size_t)(16 * wave + fr) * 256 + 32 * ks + 8 * fg);
#pragma unroll
            for (int nt = 0; nt < 2; ++nt) { const bf16x8 b = *(const bf16x8*)&sH[(16 * nt + fr) * 264 + 32 * ks + 8 * fg]; acc2[nt] = MFMA16(a, b, acc2[nt]); }
        }
        u16* KCMP = (u16*)(ws + OFF_KCMP);
#pragma unroll
        for (int nt = 0; nt < 2; ++nt) *(uint2*)(KCMP + (size_t)(r0 + 16 * nt + fr) * 64 + 16 * wave + 4 * fg) = pack4(acc2[nt]);
    } else {
        f32x4 acc2[2];
        acc2[0] = (f32x4){0.f, 0.f, 0.f, 0.f}; acc2[1] = acc2[0];
        const int mt = wave >> 1, nb = (wave & 1) * 2;
#pragma unroll
        for (int ks = 0; ks < 8; ++ks) {
            const bf16x8 a = *(const bf16x8*)&sH[(16 * mt + fr) * 264 + 32 * ks + 8 * fg];
#pragma unroll
            for (int nt = 0; nt < 2; ++nt) { const bf16x8 b = *(const bf16x8*)(W2 + (size_t)(16 * (nb + nt) + fr) * 256 + 32 * ks + 8 * fg); acc2[nt] = MFMA16(a, b, acc2[nt]); }
        }
        u16* VCMPT = (u16*)(ws + OFF_VCMPT);
        const int rg = r0 + 16 * mt + 4 * fg, bb = rg >> 7, ii = rg & 127;
#pragma unroll
        for (int nt = 0; nt < 2; ++nt) *(uint2*)(VCMPT + (size_t)(bb * 64 + 16 * (nb + nt) + fr) * 128 + ii) = pack4(acc2[nt]);
    }
    GSYNC();
}

__device__ __forceinline__ void retkv_item(const Params& p, int item) {
    unsigned char* ws = ws_opaque(p.ws);
    const int bh = item >> 4, mc = item & 15, b = bh >> 2, h = bh & 3;
    const u16* Vt = (const u16*)(ws + OFF_UT) + ((size_t)(b * 1024 + 384 + h * 128)) * 2048 + mc * 128;
    const u16* Kt = (const u16*)(ws + OFF_UT) + ((size_t)(b * 1024 + 128 + h * 64)) * 2048 + mc * 128;
    const int t = tid_opaque();
    const int lane = t & 63, wave = t >> 6, fr = lane & 15, fg = lane >> 4;
    f32x4 acc[2][4]; zero_acc<2, 4>(acc);
#pragma unroll
    for (int ks = 0; ks < 4; ++ks) {
        bf16x8 a[2], bb[4];
#pragma unroll
        for (int mt = 0; mt < 2; ++mt) a[mt] = *(const bf16x8*)(Vt + (size_t)(32 * wave + 16 * mt + fr) * 2048 + 32 * ks + 8 * fg);
#pragma unroll
        for (int nt = 0; nt < 4; ++nt) bb[nt] = *(const bf16x8*)(Kt + (size_t)(16 * nt + fr) * 2048 + 32 * ks + 8 * fg);
#pragma unroll
        for (int mt = 0; mt < 2; ++mt)
#pragma unroll
            for (int nt = 0; nt < 4; ++nt) acc[mt][nt] = MFMA16(a[mt], bb[nt], acc[mt][nt]);
    }
    float* KVT = (float*)(ws + OFF_KVT) + (size_t)item * 8192;
#pragma unroll
    for (int mt = 0; mt < 2; ++mt)
#pragma unroll
        for (int nt = 0; nt < 4; ++nt)
#pragma unroll
            for (int r = 0; r < 4; ++r) KVT[(32 * wave + 16 * mt + 4 * fg + r) * 64 + 16 * nt + fr] = acc[mt][nt][r];
}

__device__ __forceinline__ void swa_item(const Params& p, int layer, int item, unsigned char* smem) {
    unsigned char* ws = ws_opaque(p.ws);
    u16* sK = (u16*)smem; u16* sVt = sK + 64 * 72;
    const u16* U = (const u16*)(ws + OFF_U); const u16* UT = (const u16*)(ws + OFF_UT); u16* ACT = (u16*)(ws + OFF_ACT);
    const int b = item >> 7, h = (item >> 5) & 3, qb = item & 31, kvh = h >> 1;
    const int t = tid_opaque();
    const int lane = t & 63, wave = t >> 6, q = lane & 15, g = lane >> 4;
    const int tq = qb * 64 + wave * 16 + q; const size_t tglob = (size_t)b * 2048 + tq;
    bf16x8 qf[2];
#pragma unroll
    for (int ks = 0; ks < 2; ++ks) qf[ks] = *(const bf16x8*)(U + tglob * LDU + 512 + h * 64 + 32 * ks + 8 * g);
    const float slope = exp2f(-(float)(h + 1)); const float sink = p.in[6][layer * 4 + h];
    f32x4 o[4];
#pragma unroll
    for (int dt = 0; dt < 4; ++dt) o[dt] = (f32x4){0.f, 0.f, 0.f, 0.f};
    float m = NEGBIG, l = 0.f;
    const int kt0 = qb >= 2 ? qb - 2 : 0;
    for (int kt = kt0; kt <= qb; ++kt) {
        GSYNC();
        stage_rows64(sK, U + ((size_t)b * 2048 + kt * 64) * LDU + 768 + kvh * 64, LDU);
        stage_rows64(sVt, UT + ((size_t)(b * 1024 + kvh * 64)) * 2048 + kt * 64, 2048);
        GSYNC();
        flash_step<4>(sK, sVt, 72, qf, o, m, l, true,
                      [&](int key, float s, bool& valid) { const int d = tq - (kt * 64 + key); valid = (d >= 0) && (d < 128); return s * 0.125f - slope * (float)d; }, lane);
    }
    float lt = l + __shfl_xor(l, 16); lt += __shfl_xor(lt, 32);
    const float m2 = fmaxf(m, sink), sc = __expf(m - m2), den = lt * sc + __expf(sink - m2), inv = sc / fmaxf(den, 1e-30f);
#pragma unroll
    for (int dt = 0; dt < 4; ++dt) *(uint2*)(ACT + tglob * LDACT + 256 + h * 64 + 16 * dt + 4 * g) = pack4(o[dt] * inv);
    GSYNC();
}

__device__ __forceinline__ void conv_item(const Params& p, int layer, int item, unsigned char* smem) {
    unsigned char* ws = ws_opaque(p.ws);
    u16* sh = (u16*)smem; float* sy = (float*)(smem + 62 * 256 * 2);
    const u16* U = (const u16*)(ws + OFF_U); u16* ACT = (u16*)(ws + OFF_ACT);
    const int b = item >> 6, s0 = (item & 63) * 32, t = tid_opaque();
#pragma unroll 2
    for (int r = 0; r < 62; ++r) {
        const int sp = s0 - 30 + r; float hv = 0.f;
        if (sp >= 0) { const u16* row = U + ((size_t)b * 2048 + sp) * LDU; hv = bf2f(row[t]) * sigmoidf_(bf2f(row[256 + t])); }
        sh[r * 256 + t] = f2bf(hv);
    }
    GSYNC();
    float w[31];
#pragma unroll
    for (int k = 0; k < 31; ++k) w[k] = p.in[2][(size_t)layer * 31 * 256 + k * 256 + t];
    const float db = p.in[3][layer * 256 + t];
#pragma unroll 1
    for (int tt = 0; tt < 32; ++tt) {
        float a = db;
#pragma unroll
        for (int k = 0; k < 31; ++k) a += bf2f(sh[(tt + k) * 256 + t]) * w[k];
        sy[tt * 256 + t] = a;
    }
    GSYNC();
    const int lane = t & 63, wave = t >> 6, c = lane * 4;
    const float4 gg = *(const float4*)(p.in[4] + layer * 256 + c), bb = *(const float4*)(p.in[5] + layer * 256 + c);
    for (int i = 0; i < 8; ++i) {
        const int tt = wave * 8 + i;
        const float4 v = *(const float4*)&sy[tt * 256 + c];
        float s = v.x + v.y + v.z + v.w;
#pragma unroll
        for (int o = 32; o >= 1; o >>= 1) s += __shfl_xor(s, o);
        const float mu = s * (1.f / 256.f);
        const float dx = v.x - mu, dy = v.y - mu, dz = v.z - mu, dw = v.w - mu;
        float q = dx * dx + dy * dy + dz * dz + dw * dw;
#pragma unroll
        for (int o = 32; o >= 1; o >>= 1) q += __shfl_xor(q, o);
        const float rstd = rsqrtf(q * (1.f / 256.f) + LN_EPS_F);
        f32x4 ov; ov[0] = siluf_(dx * rstd * gg.x + bb.x); ov[1] = siluf_(dy * rstd * gg.y + bb.y); ov[2] = siluf_(dz * rstd * gg.z + bb.z); ov[3] = siluf_(dw * rstd * gg.w + bb.w);
        *(uint2*)(ACT + ((size_t)b * 2048 + s0 + tt) * LDACT + c) = pack4(ov);
    }
    GSYNC();
}

#define FOR_ITEMS(j, base, n) for (int j = (int)((VBID + VGRID - ((base) % VGRID)) % VGRID); j < (n); j += VGRID)
__device__ __forceinline__ void p2a_phase(const Params& p, int layer, unsigned char* smem) {
    FOR_ITEMS(j, 0, 64) compress_item(p, j, smem);
    FOR_ITEMS(j, 64, 512) retkv_item(p, j);
    FOR_ITEMS(j, 576, 1024) swa_item(p, layer, j, smem);
    FOR_ITEMS(j, 1600, 512) conv_item(p, layer, j, smem);
}

__device__ __forceinline__ void retout_item(const Params& p, int layer, int item, unsigned char* smem) {
    unsigned char* ws = ws_opaque(p.ws);
    u16* sS = (u16*)smem; u16* sK = sS + 128 * 72; u16* sVt = sK + 64 * 72;
    const u16* U = (const u16*)(ws + OFF_U); const u16* UT = (const u16*)(ws + OFF_UT); u16* ACT = (u16*)(ws + OFF_ACT);
    const int bh = item >> 4, n = item & 15, b = bh >> 2, h = bh & 3, t = tid_opaque();
    const float l2g = log2f(1.f - exp2f(-5.f - (float)h));
    {
        float as[32];
#pragma unroll
        for (int i = 0; i < 32; ++i) as[i] = 0.f;
        for (int mm = 0; mm < n; ++mm) {
            const float wgt = exp2f(128.f * (float)(n - 1 - mm) * l2g);
            const float4* src = (const float4*)((const float*)(ws + OFF_KVT) + (size_t)(bh * 16 + mm) * 8192 + t * 32);
#pragma unroll
            for (int i = 0; i < 8; ++i) { const float4 v = src[i]; as[4 * i] += wgt * v.x; as[4 * i + 1] += wgt * v.y; as[4 * i + 2] += wgt * v.z; as[4 * i + 3] += wgt * v.w; }
        }
        u16* dp = &sS[(t >> 1) * 72 + (t & 1) * 32];
#pragma unroll
        for (int i = 0; i < 4; ++i) *(uint4*)(dp + 8 * i) = make_uint4(pack2(as[8 * i], as[8 * i + 1]), pack2(as[8 * i + 2], as[8 * i + 3]), pack2(as[8 * i + 4], as[8 * i + 5]), pack2(as[8 * i + 6], as[8 * i + 7]));
    }
    GSYNC();
    const int lane = t & 63, wave = t >> 6, q = lane & 15, g = lane >> 4;
    bf16x8 qf[2][2]; f32x4 o[2][8];
#pragma unroll
    for (int qt = 0; qt < 2; ++qt) {
        const size_t tglob = (size_t)b * 2048 + n * 128 + 32 * wave + 16 * qt + q;
#pragma unroll
        for (int ks = 0; ks < 2; ++ks) qf[qt][ks] = *(const bf16x8*)(U + tglob * LDU + 896 + h * 64 + 32 * ks + 8 * g);
#pragma unroll
        for (int dt = 0; dt < 8; ++dt) {
            o[qt][dt] = (f32x4){0.f, 0.f, 0.f, 0.f};
#pragma unroll
            for (int ks = 0; ks < 2; ++ks) { const bf16x8 a = *(const bf16x8*)&sS[(16 * dt + q) * 72 + 32 * ks + 8 * g]; o[qt][dt] = MFMA16(a, qf[qt][ks], o[qt][dt]); }
        }
        const float xi = exp2f((float)(32 * wave + 16 * qt + q + 1) * l2g);
#pragma unroll
        for (int dt = 0; dt < 8; ++dt) o[qt][dt] *= xi;
    }
    for (int kt = 0; kt < 2; ++kt) {
        GSYNC();
        stage_rows64(sK, U + ((size_t)b * 2048 + n * 128 + kt * 64) * LDU + 1152 + h * 64, LDU);
        stage_rows64(sVt, UT + ((size_t)(b * 1024 + 384 + h * 128)) * 2048 + n * 128 + kt * 64, 2048);
        stage_rows64(sVt + 64 * 72, UT + ((size_t)(b * 1024 + 384 + h * 128 + 64)) * 2048 + n * 128 + kt * 64, 2048);
        GSYNC();
#pragma unroll
        for (int qt = 0; qt < 2; ++qt) {
            if (kt * 64 > 32 * wave + 16 * qt + 15) continue;
            const int tql = 32 * wave + 16 * qt + q;
            f32x4 s[4]; qk64(sK, qf[qt], s, lane);
            float x[16];
#pragma unroll
            for (int mt = 0; mt < 4; ++mt)
#pragma unroll
                for (int rr = 0; rr < 4; ++rr) { const int d = tql - (kt * 64 + 16 * mt + 4 * g + rr); x[mt * 4 + rr] = (d >= 0) ? s[mt][rr] * 0.125f * exp2f((float)d * l2g) : 0.f; }
            bf16x8 pb[2]; pack_p(x, pb);
            pv64<8>(sVt, 72, pb, o[qt], lane);
        }
    }
#pragma unroll
    for (int qt = 0; qt < 2; ++qt) {
        const size_t tglob = (size_t)b * 2048 + n * 128 + 32 * wave + 16 * qt + q;
        float s = 0.f;
#pragma unroll
        for (int dt = 0; dt < 8; ++dt) s += o[qt][dt][0] + o[qt][dt][1] + o[qt][dt][2] + o[qt][dt][3];
        s += __shfl_xor(s, 16); s += __shfl_xor(s, 32);
        const float mu = s * (1.f / 128.f);
        float v = 0.f;
#pragma unroll
        for (int dt = 0; dt < 8; ++dt)
#pragma unroll
            for (int r = 0; r < 4; ++r) { const float d = o[qt][dt][r] - mu; v += d * d; }
        v += __shfl_xor(v, 16); v += __shfl_xor(v, 32);
        const float rstd = rsqrtf(v * (1.f / 128.f) + LN_EPS_F);
#pragma unroll
        for (int dt = 0; dt < 8; ++dt) {
            const int c = h * 128 + 16 * dt + 4 * g;
            const float4 gn = *(const float4*)(p.in[7] + layer * 512 + c), gb = *(const float4*)(p.in[8] + layer * 512 + c);
            const uint2 gv = *(const uint2*)(U + tglob * LDU + 1408 + c);
            f32x4 ov;
            ov[0] = ((o[qt][dt][0] - mu) * rstd * gn.x + gb.x) * siluf_(bflo(gv.x));
            ov[1] = ((o[qt][dt][1] - mu) * rstd * gn.y + gb.y) * siluf_(bfhi(gv.x));
            ov[2] = ((o[qt][dt][2] - mu) * rstd * gn.z + gb.z) * siluf_(bflo(gv.y));
            ov[3] = ((o[qt][dt][3] - mu) * rstd * gn.w + gb.w) * siluf_(bfhi(gv.y));
            *(uint2*)(ACT + tglob * LDACT + 512 + c) = pack4(ov);
        }
    }
    GSYNC();
}

__device__ __forceinline__ void nsa_item(const Params& p, int item, unsigned char* smem) {
    unsigned char* ws = ws_opaque(p.ws);
    u16* sKc = (u16*)smem;
    u16* sVc = sKc + 128 * 72;
    u16* sK = sVc + 64 * 136;
    u16* sVt = sK + 64 * 72;
    float* impL = (float*)(sVt + 64 * 72);
    unsigned* qmask = (unsigned*)(impL + 4 * 16 * 32);
    unsigned* wgor = qmask + 64;
    const u16* U = (const u16*)(ws + OFF_U); const u16* UT = (const u16*)(ws + OFF_UT); u16* ACT = (u16*)(ws + OFF_ACT);
    const int rnk = item >> 5, bhh = item & 31, b = bhh >> 2, hsel = bhh & 3;
    const int blk = (item < 512) ? 31 - rnk : rnk - 16;
    const int t = tid_opaque();
    const int lane = t & 63, wave = t >> 6, q = lane & 15, g = lane >> 4;
    const int tq = blk * 64 + wave * 16 + q; const size_t tglob = (size_t)b * 2048 + tq;
    GSYNC();
    {
        const u16* kc = (const u16*)(ws + OFF_KCMP) + (size_t)b * 128 * 64;
        stage_rows64(sKc, kc, 64); stage_rows64(sKc + 64 * 72, kc + 64 * 64, 64);
        const u16* vc = (const u16*)(ws + OFF_VCMPT) + (size_t)b * 64 * 128;
        const int r = t >> 2, c = (t & 3) * 32;
        const uint4* src = (const uint4*)(vc + (size_t)r * 128 + c);
#pragma unroll
        for (int i = 0; i < 4; ++i) *(uint4*)&sVc[r * 136 + c + 8 * i] = src[i];
        if (t == 0) *wgor = 0u;
    }
    GSYNC();
    const u16* qrow = U + tglob * LDU + 1920 + 8 * g;
    float impm[8], impc[8];
#pragma unroll
    for (int i = 0; i < 8; ++i) { impm[i] = 0.f; impc[i] = 0.f; }
#pragma unroll 1
    for (int h = 0; h < 4; ++h) {
        const float slope = exp2f(-(float)(h + 5));
        bf16x8 qh[2];
        qh[0] = *(const bf16x8*)(qrow + h * 64); qh[1] = *(const bf16x8*)(qrow + h * 64 + 32);
        f32x4 s0[4], s1[4]; qk64(sKc, qh, s0, lane); qk64(sKc + 64 * 72, qh, s1, lane);
        float x[32]; float mx = NEGBIG;
#pragma unroll
        for (int mt = 0; mt < 4; ++mt)
#pragma unroll
            for (int rr = 0; rr < 4; ++rr) {
                const int c0 = 16 * mt + 4 * g + rr, c1 = 64 + c0;
                const int d0 = tq - (16 * c0 + 31), d1 = tq - (16 * c1 + 31);
                const float v0 = d0 >= 0 ? s0[mt][rr] * 0.125f - slope * (float)d0 : NEGBIG;
                const float v1 = d1 >= 0 ? s1[mt][rr] * 0.125f - slope * (float)d1 : NEGBIG;
                x[mt * 4 + rr] = v0; x[16 + mt * 4 + rr] = v1; mx = fmaxf(mx, fmaxf(v0, v1));
            }
        mx = fmaxf(mx, __shfl_xor(mx, 16)); mx = fmaxf(mx, __shfl_xor(mx, 32));
        float ps = 0.f;
#pragma unroll
        for (int i = 0; i < 32; ++i) { const float pv = (x[i] > -1e29f) ? __expf(x[i] - mx) : 0.f; x[i] = pv; ps += pv; }
        ps += __shfl_xor(ps, 16); ps += __shfl_xor(ps, 32);
        const float inv = 1.f / fmaxf(ps, 1e-30f);
#pragma unroll
        for (int tm = 0; tm < 8; ++tm) {
            impm[tm] += (x[tm * 4] + x[tm * 4 + 1] + x[tm * 4 + 2] + x[tm * 4 + 3]) * inv;
            impc[tm] += x[tm * 4 + 3] * inv;
        }
    }
    float* myimp = impL + (wave * 16 + q) * 32;
#pragma unroll
    for (int tm = 0; tm < 8; ++tm) myimp[4 * tm + g] = impm[tm];
    GSYNC();
#pragma unroll
    for (int tm = 0; tm < 8; ++tm) { const int j1 = 4 * tm + g + 1; if (j1 < 32) myimp[j1] += impc[tm]; }
    GSYNC();
    if (g == 0) {
        const int cur = blk;
        for (int j = 0; j < 32; ++j) {
            float v = myimp[j];
            if (j == 0 || j == cur || j == cur - 1) v = 1e4f; else if (j > cur) v = -1.f;
            myimp[j] = v;
        }
        unsigned mask = 0u;
        for (int nsel = 0; nsel < 8; ++nsel) {
            float best = -3e38f; int bj = 0;
            for (int j = 0; j < 32; ++j) { const float v = myimp[j]; if (!((mask >> j) & 1u) && v > best) { best = v; bj = j; } }
            mask |= 1u << bj;
        }
        qmask[wave * 16 + q] = mask;
        atomicOr(wgor, mask);
    }
    GSYNC();
    const unsigned mymask = qmask[wave * 16 + q];
    const unsigned allmask = *wgor;
    const int cur = blk;
    {
        const int h = hsel;
        const float slope = exp2f(-(float)(h + 5));
        bf16x8 qh[2];
        qh[0] = *(const bf16x8*)(qrow + h * 64); qh[1] = *(const bf16x8*)(qrow + h * 64 + 32);
        const u16* grow = U + tglob * LDU + 2432;
        const float g0 = sigmoidf_(bf2f(grow[h])), g1 = sigmoidf_(bf2f(grow[4 + h])), g2 = sigmoidf_(bf2f(grow[8 + h]));
        f32x4 otot[4];
        {
            f32x4 o[4];
#pragma unroll
            for (int dt = 0; dt < 4; ++dt) o[dt] = (f32x4){0.f, 0.f, 0.f, 0.f};
            float m = NEGBIG, l = 0.f;
#pragma unroll
            for (int tile = 0; tile < 2; ++tile)
                flash_step<4>(sKc + tile * 64 * 72, sVc + tile * 64, 136, qh, o, m, l, true,
                              [&](int key, float s, bool& valid) { const int d = tq - (16 * (tile * 64 + key) + 31); valid = d >= 0; return s * 0.125f - slope * (float)d; }, lane);
            float lt = l + __shfl_xor(l, 16); lt += __shfl_xor(lt, 32);
            const float sc = g0 / fmaxf(lt, 1e-30f);
#pragma unroll
            for (int dt = 0; dt < 4; ++dt) otot[dt] = o[dt] * sc;
        }
        {
            f32x4 o[4];
#pragma unroll
            for (int dt = 0; dt < 4; ++dt) o[dt] = (f32x4){0.f, 0.f, 0.f, 0.f};
            float m = NEGBIG, l = 0.f;
            for (int j = 0; j <= cur; ++j) {
                if (!((allmask >> j) & 1u)) continue;
                GSYNC();
                stage_rows64(sK, U + ((size_t)b * 2048 + j * 64) * LDU + 2304, LDU);
                stage_rows64(sVt, UT + ((size_t)(b * 1024 + 896)) * 2048 + j * 64, 2048);
                GSYNC();
                flash_step<4>(sK, sVt, 72, qh, o, m, l, ((mymask >> j) & 1u) != 0u,
                              [&](int key, float s, bool& valid) { const int d = tq - (j * 64 + key); valid = d >= 0; return s * 0.125f - slope * (float)d; }, lane);
            }
            float lt = l + __shfl_xor(l, 16); lt += __shfl_xor(lt, 32);
            const float sc = g1 / fmaxf(lt, 1e-30f);
#pragma unroll
            for (int dt = 0; dt < 4; ++dt) otot[dt] += o[dt] * sc;
        }
        {
            f32x4 o[4];
#pragma unroll
            for (int dt = 0; dt < 4; ++dt) o[dt] = (f32x4){0.f, 0.f, 0.f, 0.f};
            float m = NEGBIG, l = 0.f;
            const int kt0 = cur >= 8 ? cur - 8 : 0;
            for (int kt = kt0; kt <= cur; ++kt) {
                GSYNC();
                stage_rows64(sK, U + ((size_t)b * 2048 + kt * 64) * LDU + 2368, LDU);
                stage_rows64(sVt, UT + ((size_t)(b * 1024 + 960)) * 2048 + kt * 64, 2048);
                GSYNC();
                flash_step<4>(sK, sVt, 72, qh, o, m, l, true,
                              [&](int key, float s, bool& valid) { const int d = tq - (kt * 64 + key); valid = (d >= 0) && (d < 512); return s * 0.125f - slope * (float)d; }, lane);
            }
            float lt = l + __shfl_xor(l, 16); lt += __shfl_xor(lt, 32);
            const float sc = g2 / fmaxf(lt, 1e-30f);
#pragma unroll
            for (int dt = 0; dt < 4; ++dt) otot[dt] += o[dt] * sc;
        }
#pragma unroll
        for (int dt = 0; dt < 4; ++dt) *(uint2*)(ACT + tglob * LDACT + 1024 + h * 64 + 16 * dt + 4 * g) = pack4(otot[dt]);
    }
    GSYNC();
}

__device__ __forceinline__ void p2b_phase(const Params& p, int layer, unsigned char* smem) {
    FOR_ITEMS(j, 0, 1024) nsa_item(p, j, smem);
    FOR_ITEMS(j, 1024, 512) retout_item(p, layer, j, smem);
}

__device__ __forceinline__ void merge_phase(const Params& p, unsigned char* smem) {
    unsigned char* ws = ws_opaque(p.ws);
    const u16* XB = (const u16*)(ws + OFF_XB); const u16* WINT = (const u16*)(ws + OFF_WINT); const u16* PT = (const u16*)(ws + OFF_PT);
    const u16* ACT = (const u16*)(ws + OFF_ACT); u16* MERGED = (u16*)(ws + OFF_MERGED);
    FULL_LANE_VARS
    const int xcd = blockIdx.x & 7, loc = blockIdx.x >> 3, nloc = gridDim.x >> 3;
    G8<4, 4> g;
    auto setup = [&](int l, int sg) {
        const int ct = l >> 3, tt = xcd * 8 + (l & 7), br = sg >> 1;
        if ((sg & 1) == 0) {
            auto rowWg = [=](int r) { return WINT + (size_t)(3584 + br * 1024 + ct * 128 + r) * 1024; };
            auto rowX = [=](int r) { return XB + (size_t)(tt * 256 + r) * 1024; };
            g8_setup<4, 4>(g, rowWg, rowX);
        } else {
            const int Kb = (br == 2) ? 512 : 256;
            const size_t poff = (br == 0) ? 0 : (br == 1) ? 262144 : (br == 2) ? 524288 : 1048576;
            const int aoff = (br == 0) ? 0 : (br == 1) ? 256 : (br == 2) ? 512 : 1024;
            auto rowP = [=](int r) { return PT + poff + (size_t)(ct * 128 + r) * Kb; };
            auto rowAct = [=](int r) { return ACT + (size_t)(tt * 256 + r) * LDACT + aoff; };
            g8_setup<4, 4>(g, rowP, rowAct);
        }
    };
    __syncthreads();
    if (loc < 64) { setup(loc, 0); g8_prefetch<4, 4>(g, 1024); }
    for (int l = loc; l < 8 * 8; l += nloc) {
        const int ct = l >> 3, tt = xcd * 8 + (l & 7);
        uint2 mpk[4][4];
#pragma unroll
        for (int i = 0; i < 4; ++i)
#pragma unroll
            for (int j = 0; j < 4; ++j) mpk[i][j] = make_uint2(0u, 0u);
#pragma unroll 1
        for (int br = 0; br < 4; ++br) {
            const int Kb = (br == 2) ? 512 : 256;
            uint2 gpk[4][4];
            {
                f32x4 accg[4][4]; zero_acc<4, 4>(accg);
                g8_run<4, 4>(g, accg, 1024);
                setup(l, 2 * br + 1); g8_prefetch<4, 4>(g, Kb);
#pragma unroll
                for (int i = 0; i < 4; ++i)
#pragma unroll
                    for (int j = 0; j < 4; ++j) {
                        f32x4 gg;
#pragma unroll
                        for (int r = 0; r < 4; ++r) gg[r] = sigmoidf_(accg[i][j][r]);
                        gpk[i][j] = pack4(gg);
                    }
            }
            f32x4 accy[4][4]; zero_acc<4, 4>(accy);
            g8_run<4, 4>(g, accy, Kb);
            if (br < 3) { setup(l, 2 * br + 2); g8_prefetch<4, 4>(g, 1024); }
            else if (l + nloc < 64) { setup(l + nloc, 0); g8_prefetch<4, 4>(g, 1024); }
#pragma unroll
            for (int i = 0; i < 4; ++i)
#pragma unroll
                for (int j = 0; j < 4; ++j) {
                    const uint2 gq = gpk[i][j]; const uint2 mm = mpk[i][j];
                    f32x4 v;
                    v[0] = bflo(mm.x) + bflo(gq.x) * accy[i][j][0]; v[1] = bfhi(mm.x) + bfhi(gq.x) * accy[i][j][1];
                    v[2] = bflo(mm.y) + bflo(gq.y) * accy[i][j][2]; v[3] = bfhi(mm.y) + bfhi(gq.y) * accy[i][j][3];
                    mpk[i][j] = pack4(v);
                }
        }
        g8_store_rows<4, 4>(mpk, [&](int mloc, int n, u32x4 v) {
            *(u32x4*)(MERGED + ((size_t)tt * 256 + n) * 1024 + ct * 128 + mloc) = v;
        });
    }
}

__device__ __forceinline__ u32x4 add_alpha_x(u32x4 v, u32x4 x) {
    u32x4 o;
    o.x = pack2(bflo(v.x) + ALPHA_F * bflo(x.x), bfhi(v.x) + ALPHA_F * bfhi(x.x)); o.y = pack2(bflo(v.y) + ALPHA_F * bflo(x.y), bfhi(v.y) + ALPHA_F * bfhi(x.y));
    o.z = pack2(bflo(v.z) + ALPHA_F * bflo(x.z), bfhi(v.z) + ALPHA_F * bfhi(x.z)); o.w = pack2(bflo(v.w) + ALPHA_F * bflo(x.w), bfhi(v.w) + ALPHA_F * bfhi(x.w));
    return o;
}
__device__ __forceinline__ void wout_phase(const Params& p, unsigned char* smem) {
    unsigned char* ws = ws_opaque(p.ws);
    const u16* XB = (const u16*)(ws + OFF_XB); const u16* WOUT = (const u16*)(ws + OFF_WOUT); const u16* MERGED = (const u16*)(ws + OFF_MERGED);
    u16* Z = (u16*)(ws + OFF_Z);
    FULL_LANE_VARS
    const int xcd = blockIdx.x & 7, loc = blockIdx.x >> 3, nloc = gridDim.x >> 3;
    G8<8, 4> g;
    auto setup = [&](int l) {
        const int ct = l >> 3, tt = xcd * 8 + (l & 7);
        auto rowW = [=](int r) { return WOUT + (size_t)(ct * 256 + r) * 1024; };
        auto rowM = [=](int r) { return MERGED + (size_t)(tt * 256 + r) * 1024; };
        g8_setup<8, 4>(g, rowW, rowM);
    };
    __syncthreads();
    if (loc < 32) { setup(loc); g8_prefetch<8, 4>(g, 1024); }
    for (int l = loc; l < 8 * 4; l += nloc) {
        const int ct = l >> 3, tt = xcd * 8 + (l & 7);
        f32x4 acc[8][4]; zero_acc<8, 4>(acc);
        g8_run<8, 4>(g, acc, 1024);
        if (l + nloc < 32) { setup(l + nloc); g8_prefetch<8, 4>(g, 1024); }
        uint2 pk[8][4];
#pragma unroll
        for (int i = 0; i < 8; ++i)
#pragma unroll
            for (int j = 0; j < 4; ++j) pk[i][j] = pack4(acc[i][j]);
        g8_store_rows<8, 4>(pk, [&](int mloc, int n, u32x4 v) {
            const size_t o = ((size_t)tt * 256 + n) * 1024 + ct * 256 + mloc;
            *(u32x4*)(Z + o) = add_alpha_x(v, *(const u32x4*)(XB + o));
        });
    }
}

__device__ __forceinline__ void ln_row16(float (&v)[16], const float* gam, const float* bet, int lane) {
    float s = 0.f;
#pragma unroll
    for (int i = 0; i < 16; ++i) s += v[i];
#pragma unroll
    for (int o = 32; o >= 1; o >>= 1) s += __shfl_xor(s, o);
    const float mu = s * (1.f / 1024.f);
    float q = 0.f;
#pragma unroll
    for (int i = 0; i < 16; ++i) { v[i] -= mu; q += v[i] * v[i]; }
#pragma unroll
    for (int o = 32; o >= 1; o >>= 1) q += __shfl_xor(q, o);
    const float rstd = rsqrtf(q * (1.f / 1024.f) + LN_EPS_F);
#pragma unroll
    for (int hh = 0; hh < 2; ++hh) {
        const int c = hh * 512 + lane * 8;
        const float4 g0 = *(const float4*)(gam + c), g1 = *(const float4*)(gam + c + 4), b0 = *(const float4*)(bet + c), b1 = *(const float4*)(bet + c + 4);
        v[8 * hh + 0] = v[8 * hh + 0] * rstd * g0.x + b0.x; v[8 * hh + 1] = v[8 * hh + 1] * rstd * g0.y + b0.y;
        v[8 * hh + 2] = v[8 * hh + 2] * rstd * g0.z + b0.z; v[8 * hh + 3] = v[8 * hh + 3] * rstd * g0.w + b0.w;
        v[8 * hh + 4] = v[8 * hh + 4] * rstd * g1.x + b1.x; v[8 * hh + 5] = v[8 * hh + 5] * rstd * g1.y + b1.y;
        v[8 * hh + 6] = v[8 * hh + 6] * rstd * g1.z + b1.z; v[8 * hh + 7] = v[8 * hh + 7] * rstd * g1.w + b1.w;
    }
}
__device__ __forceinline__ void unpack8(const uint4 w, float* v) {
    v[0] = bflo(w.x); v[1] = bfhi(w.x); v[2] = bflo(w.y); v[3] = bfhi(w.y); v[4] = bflo(w.z); v[5] = bfhi(w.z); v[6] = bflo(w.w); v[7] = bfhi(w.w);
}

__device__ __forceinline__ void router_phase(const Params& p, int layer, unsigned char* smem) {
    unsigned char* ws = ws_opaque(p.ws);
    float* L = (float*)(smem + 40960);
    const u16* Z = (const u16*)(ws + OFF_Z); u16* XB = (u16*)(ws + OFF_XB); const u16* RW = (const u16*)(ws + OFF_RW);
    unsigned* cnt = (unsigned*)(ws + OFF_CNT); unsigned* LIST = (unsigned*)(ws + OFF_LIST); float* GATEW = (float*)(ws + OFF_GATEW);
    const float* gam = p.in[20] + layer * 1024; const float* bet = p.in[21] + layer * 1024; const float* rbias = p.in[23] + layer * 64;
    for (int it = VBID; it < 512; it += VGRID) {
        const int t = tid_opaque(), lane = t & 63, wave = t >> 6, wm = wave >> 1, wn = wave & 1, fr = lane & 15, fg = lane >> 4;
#pragma unroll 2
        for (int i = 0; i < 8; ++i) {
            const size_t row = (size_t)it * 32 + wave * 8 + i;
            float v[16];
            unpack8(*(const uint4*)(Z + row * 1024 + lane * 8), v); unpack8(*(const uint4*)(Z + row * 1024 + 512 + lane * 8), v + 8);
            ln_row16(v, gam, bet, lane);
            *(uint4*)(XB + row * 1024 + lane * 8) = make_uint4(pack2(v[0], v[1]), pack2(v[2], v[3]), pack2(v[4], v[5]), pack2(v[6], v[7]));
            *(uint4*)(XB + row * 1024 + 512 + lane * 8) = make_uint4(pack2(v[8], v[9]), pack2(v[10], v[11]), pack2(v[12], v[13]), pack2(v[14], v[15]));
        }
        __threadfence_block();
        GSYNC();
        f32x4 acc[2][1]; zero_acc<2, 1>(acc);
        auto rowR = [=](int r) { return RW + (size_t)r * 1024; };
        auto rowX = [=](int r) { return (const u16*)XB + ((size_t)it * 32 + r) * 1024; };
        gemm_acc<2, 1>(acc, rowR, rowX, 1024, smem);
#pragma unroll
        for (int i = 0; i < 2; ++i)
#pragma unroll
            for (int r = 0; r < 4; ++r) L[(wn * 16 + fr) * 65 + wm * 32 + 16 * i + 4 * fg + r] = acc[i][0][r];
        GSYNC();
        {
            const int tokl = t >> 3, grp = t & 7;
            const float* Lr = L + tokl * 65 + grp * 8;
            float sc[8], bs[8];
#pragma unroll
            for (int k = 0; k < 8; ++k) { sc[k] = sigmoidf_(Lr[k]); bs[k] = sc[k] + rbias[grp * 8 + k]; }
            float m1 = -3e38f, m2 = -3e38f;
#pragma unroll
            for (int k = 0; k < 8; ++k) { const float v = bs[k]; if (v > m1) { m2 = m1; m1 = v; } else if (v > m2) m2 = v; }
            const float gsum = m1 + m2;
            float gs[8];
#pragma unroll
            for (int g2 = 0; g2 < 8; ++g2) gs[g2] = __shfl(gsum, (lane & ~7) | g2);
            unsigned gmask = 0u;
#pragma unroll
            for (int nsel = 0; nsel < 4; ++nsel) {
                float best = -3e38f; int bi = 0;
#pragma unroll
                for (int g2 = 0; g2 < 8; ++g2) if (!((gmask >> g2) & 1u) && gs[g2] > best) { best = gs[g2]; bi = g2; }
                gmask |= 1u << bi;
            }
            const bool gsel = (gmask >> grp) & 1u;
            unsigned chosen = 0u; int eidx[6]; float sraw[6]; float ssum = 0.f;
#pragma unroll
            for (int rnd = 0; rnd < 6; ++rnd) {
                float bv = -3e38f, bsr = 0.f; int be = 64;
#pragma unroll
                for (int k = 0; k < 8; ++k) if (gsel && !((chosen >> k) & 1u) && bs[k] > bv) { bv = bs[k]; bsr = sc[k]; be = grp * 8 + k; }
#pragma unroll
                for (int o = 1; o < 8; o <<= 1) {
                    const float ov = __shfl_xor(bv, o), osr = __shfl_xor(bsr, o); const int oe = __shfl_xor(be, o);
                    if (ov > bv || (ov == bv && oe < be)) { bv = ov; bsr = osr; be = oe; }
                }
                if ((be >> 3) == grp) chosen |= 1u << (be & 7);
                eidx[rnd] = be; sraw[rnd] = bsr; ssum += bsr;
            }
            const unsigned tok = (unsigned)(it * 32 + tokl);
            unsigned* lcnt = (unsigned*)(smem + 24576);
            if (t < 64) lcnt[t] = 0u;
            GSYNC();
            int mye = 0; float myg = 0.f; unsigned lpos = 0u;
#pragma unroll
            for (int rnd = 0; rnd < 6; ++rnd) if (grp == rnd) { mye = eidx[rnd]; myg = sraw[rnd] / ssum * 2.5f; }
            if (grp < 6) lpos = atomicAdd(&lcnt[mye], 1u);
            GSYNC();
            if (t < 64) { const unsigned c = lcnt[t]; lcnt[64 + t] = c ? atomicAdd(&cnt[t * 32], c) : 0u; }
            GSYNC();
            if (grp < 6) {
                LIST[(size_t)mye * 16384 + lcnt[64 + mye] + lpos] = tok * 8u + (unsigned)grp;
                GATEW[tok * 8u + grp] = myg;
            }
        }
        GSYNC();
    }
}

__device__ __forceinline__ void moe_prefix(const Params& p, int* pre) {
    __syncthreads();
    if (threadIdx.x == 0) {
        const unsigned* cnt = (const unsigned*)(ws_opaque(p.ws) + OFF_CNT);
        int a = 0;
        for (int e = 0; e < 64; ++e) { pre[e] = a; a += (int)((cnt[e * 32] + 255u) >> 8); }
        pre[64] = a; a += 64; pre[65] = a;
    }
    __syncthreads();
}

__device__ __forceinline__ void moe_up_phase(const Params& p, unsigned char* smem) {
    unsigned char* ws = ws_opaque(p.ws);
    int* pre = (int*)(g_smem + SMEM_PRE_OFF);
    const u16* XB = (const u16*)(ws + OFF_XB); const u16* WUP = (const u16*)(ws + OFF_WUP); u16* H = (u16*)(ws + OFF_H);
    const unsigned* cnt = (const unsigned*)(ws + OFF_CNT); const unsigned* LIST = (const unsigned*)(ws + OFF_LIST);
    FULL_LANE_VARS
    moe_prefix(p, pre);
    const int total = pre[65] * 2;
    G8<8, 4> g;
    auto setup = [&](int it) {
        const int bi = it >> 1, nt = it & 1;
        int e = 0; while (pre[e + 1] <= bi) ++e;
        const int rb = bi - pre[e]; const int ce = (e < 64) ? (int)cnt[e * 32] : T_TOK;
        auto rowW = [=](int r) { return WUP + ((size_t)e * 512 + nt * 256 + r) * 1024; };
        auto rowX = [=](int r) {
            const int idx = rb * 256 + r; unsigned tok = 0u;
            if (idx < ce) tok = (e < 64) ? (LIST[(size_t)e * 16384 + idx] >> 3) : (unsigned)idx;
            return XB + (size_t)tok * 1024;
        };
        g8_setup<8, 4>(g, rowW, rowX);
    };
    if ((int)blockIdx.x < total) { setup(blockIdx.x); g8_prefetch<8, 4>(g, 1024); }
    for (int it = blockIdx.x; it < total; it += gridDim.x) {
        const int bi = it >> 1, nt = it & 1;
        f32x4 acc[8][4]; zero_acc<8, 4>(acc);
        g8_run<8, 4>(g, acc, 1024);
        if (it + (int)gridDim.x < total) { setup(it + gridDim.x); g8_prefetch<8, 4>(g, 1024); }
        uint2 pk[4][4];
#pragma unroll
        for (int i = 0; i < 4; ++i)
#pragma unroll
            for (int j = 0; j < 4; ++j) {
                f32x4 v;
#pragma unroll
                for (int r = 0; r < 4; ++r) v[r] = siluf_(acc[2 * i][j][r]) * acc[2 * i + 1][j][r];
                pk[i][j] = pack4(v);
            }
        const size_t hrow0 = (size_t)bi * 256;
        g8_store_rows<4, 4>(pk, [&](int mloc, int n, u32x4 v) {
            *(u32x4*)(H + (hrow0 + n) * 256 + nt * 128 + mloc) = v;
        });
    }
}

__device__ __forceinline__ void moe_down_phase(const Params& p, unsigned char* smem) {
    unsigned char* ws = ws_opaque(p.ws);
    int* pre = (int*)(g_smem + SMEM_PRE_OFF);
    const u16* XB = (const u16*)(ws + OFF_XB); const u16* WD = (const u16*)(ws + OFF_WD); const u16* H = (const u16*)(ws + OFF_H);
    u16* Z = (u16*)(ws + OFF_Z); u16* YS = (u16*)(ws + OFF_YSLOT);
    const unsigned* cnt = (const unsigned*)(ws + OFF_CNT); const unsigned* LIST = (const unsigned*)(ws + OFF_LIST); const float* GATEW = (const float*)(ws + OFF_GATEW);
    FULL_LANE_VARS
    moe_prefix(p, pre);
    const int total = pre[65] * 4;
    G8<8, 4> g;
    auto setup = [&](int it) {
        const int bi = it >> 2, nt = it & 3;
        int e = 0; while (pre[e + 1] <= bi) ++e;
        auto rowW = [=](int r) { return WD + ((size_t)e * 1024 + nt * 256 + r) * 256; };
        auto rowH = [=](int r) { return H + ((size_t)bi * 256 + r) * 256; };
        g8_setup<8, 4>(g, rowW, rowH);
    };
    if ((int)blockIdx.x < total) { setup(blockIdx.x); g8_prefetch<8, 4>(g, 256); }
    for (int it = blockIdx.x; it < total; it += gridDim.x) {
        const int bi = it >> 2, nt = it & 3;
        int e = 0; while (pre[e + 1] <= bi) ++e;
        const int rb = bi - pre[e]; const int ce = (e < 64) ? (int)cnt[e * 32] : T_TOK;
        int2* rowinfo = (int2*)(g_smem + SMEM_ROWINFO_OFF) + (((it - (int)blockIdx.x) / (int)gridDim.x) & 1) * 256;
        if (t_ < 256) {
            const int idx = rb * 256 + t_; int dst = -1; float gw = 1.f;
            if (idx < ce) {
                if (e < 64) { const unsigned ent = LIST[(size_t)e * 16384 + idx]; dst = (int)((ent >> 3) * 6u + (ent & 7u)); gw = GATEW[ent]; }
                else dst = idx;
            }
            rowinfo[t_] = make_int2(dst, __float_as_int(gw));
        }
        f32x4 acc[8][4]; zero_acc<8, 4>(acc);
        PB(40); g8_run<8, 4>(g, acc, 256); PE(40);
        PB(42); if (it + (int)gridDim.x < total) { setup(it + gridDim.x); g8_prefetch<8, 4>(g, 256); } PE(42);
        PB(41);
        uint2 pk[8][4];
#pragma unroll
        for (int j = 0; j < 4; ++j) {
            const float gw = __int_as_float(rowinfo[wc * 64 + 16 * j + fr].y);
#pragma unroll
            for (int i = 0; i < 8; ++i) pk[i][j] = pack4(acc[i][j] * gw);
        }
        g8_store_rows<8, 4>(pk, [&](int mloc, int n, u32x4 v) {
            const int dst = rowinfo[n].x;
            if (dst >= 0) {
                const size_t o = (size_t)dst * 1024 + nt * 256 + mloc;
                if (e < 64) *(u32x4*)(YS + o) = v;
                else *(u32x4*)(Z + o) = add_alpha_x(v, *(const u32x4*)(XB + o));
            }
        });
        PE(41);
    }
}

__device__ __forceinline__ void combine_phase(const Params& p, int layer) {
    unsigned char* ws = ws_opaque(p.ws);
    const u16* Z = (const u16*)(ws + OFF_Z); const u16* YS = (const u16*)(ws + OFF_YSLOT); u16* XB = (u16*)(ws + OFF_XB);
    const float* gam = p.in[30] + layer * 1024; const float* bet = p.in[31] + layer * 1024;
    const int t = tid_opaque(), lane = t & 63, wave = t >> 6;
    for (int it = VBID; it < 512; it += VGRID) {
        for (int i = 0; i < 8; ++i) {
            const size_t row = (size_t)it * 32 + wave * 8 + i;
            float v[16];
            unpack8(*(const uint4*)(Z + row * 1024 + lane * 8), v); unpack8(*(const uint4*)(Z + row * 1024 + 512 + lane * 8), v + 8);
#pragma unroll
            for (int k = 0; k < 6; ++k) {
                float y[16];
                unpack8(*(const uint4*)(YS + (row * 6 + k) * 1024 + lane * 8), y); unpack8(*(const uint4*)(YS + (row * 6 + k) * 1024 + 512 + lane * 8), y + 8);
#pragma unroll
                for (int c = 0; c < 16; ++c) v[c] += y[c];
            }
            ln_row16(v, gam, bet, lane);
            *(uint4*)(XB + row * 1024 + lane * 8) = make_uint4(pack2(v[0], v[1]), pack2(v[2], v[3]), pack2(v[4], v[5]), pack2(v[6], v[7]));
            *(uint4*)(XB + row * 1024 + 512 + lane * 8) = make_uint4(pack2(v[8], v[9]), pack2(v[10], v[11]), pack2(v[12], v[13]), pack2(v[14], v[15]));
            if (layer == 1) {
                float* op = p.out + row * 1024;
                *(float4*)(op + lane * 8) = make_float4(v[0], v[1], v[2], v[3]); *(float4*)(op + lane * 8 + 4) = make_float4(v[4], v[5], v[6], v[7]);
                *(float4*)(op + 512 + lane * 8) = make_float4(v[8], v[9], v[10], v[11]); *(float4*)(op + 512 + lane * 8 + 4) = make_float4(v[12], v[13], v[14], v[15]);
            }
        }
    }
}

__device__ __forceinline__ void run_phase(const Params& p, int ph, int layer, unsigned char* smem) {
    switch (ph) {
        case 0: prep_phase(p, layer, layer == 0, smem); break;
        case 1: inproj_phase(p, layer, smem); break;
        case 2: p2a_phase(p, layer, smem); break;
        case 3: p2b_phase(p, layer, smem); break;
        case 4: merge_phase(p, smem); break;
        case 5: wout_phase(p, smem); break;
        case 6: router_phase(p, layer, smem); break;
        case 7: moe_up_phase(p, smem); break;
        case 8: moe_down_phase(p, smem); break;
        default: combine_phase(p, layer); if (layer == 0) prep_phase(p, 1, false, smem); break;
    }
}


#define XB_TMO      128
#define XB_XCNT(j)  (256  + 64 * (j))
#define XB_XSUB(j)  (1280 + 64 * (j))
#define XB_XGEN(j)  (2304 + 64 * (j))
#define XB_TOP      3328
#define XB_TOPGEN   3392
#define XCD_BAR_WORDS 3456
#define XB_SPIN_CAP (1u << 22)
__device__ __forceinline__ unsigned xb_ld(unsigned* p)              { return __hip_atomic_load(p, __ATOMIC_RELAXED, __HIP_MEMORY_SCOPE_AGENT); }
__device__ __forceinline__ unsigned xb_add(unsigned* p, unsigned v) { return __hip_atomic_fetch_add(p, v, __ATOMIC_RELAXED, __HIP_MEMORY_SCOPE_AGENT); }
__device__ __forceinline__ unsigned xb_xcc_id() { return (unsigned)__builtin_amdgcn_s_getreg((3 << 11) | 20) & 0xFu; }
#define XB_SPIN(cond, bar) do { unsigned _sp = 0; while (cond) { __builtin_amdgcn_s_sleep(1); \
    if ((++_sp & 255u) == 0u) { if (xb_ld(&(bar)[XB_TMO])) break; if (_sp > XB_SPIN_CAP) { atomicAdd(&(bar)[XB_TMO], 1u); break; } } } } while (0)
struct XcdBarrier { unsigned* bar; unsigned x; volatile LAS unsigned* st; };
__device__ __forceinline__ XcdBarrier xcd_barrier_post(unsigned* bar, volatile LAS unsigned* st) {
    XcdBarrier b; b.bar = bar; b.x = xb_xcc_id(); b.st = st;
    if (threadIdx.x == 0) (void)xb_add(&bar[XB_XCNT(b.x)], 1u);
    return b;
}
__device__ __forceinline__ void xcd_barrier_complete(unsigned* bar, unsigned x, unsigned& nloc, unsigned& nx) {
    const unsigned G = gridDim.x * gridDim.y * gridDim.z;
    unsigned sum, cnt, mine, sp = 0u;
    for (;;) {
        sum = 0u; cnt = 0u; mine = 0u;
#pragma unroll
        for (unsigned j = 0; j < 16; ++j) { const unsigned c = xb_ld(&bar[XB_XCNT(j)]); sum += c; cnt += (c > 0u) ? 1u : 0u; mine = (j == x) ? c : mine; }
        if (sum == G) break;
        __builtin_amdgcn_s_sleep(1);
        if ((++sp & 255u) == 0u) { if (xb_ld(&bar[XB_TMO])) break; if (sp > XB_SPIN_CAP) { atomicAdd(&bar[XB_TMO], 1u); break; } }
    }
    nloc = mine > 0u ? mine : 1u; nx = cnt > 0u ? cnt : 1u;
}
__device__ __forceinline__ void xcd_barrier_impl(const XcdBarrier& b) {
    asm volatile("s_waitcnt vmcnt(0)" ::: "memory");
    __syncthreads();
    if (threadIdx.x == 0) {
        unsigned* bar = b.bar;
        __builtin_amdgcn_s_waitcnt(0);
        unsigned nloc = b.st[0], nx = b.st[1];
        if (nloc == 0u) { xcd_barrier_complete(bar, b.x, nloc, nx); b.st[0] = nloc; b.st[1] = nx; }
        const unsigned old = xb_add(&bar[XB_XSUB(b.x)], 1u);
        const unsigned gen = old / nloc;
        if (old + 1u == (gen + 1u) * nloc) {
            __builtin_amdgcn_fence(__ATOMIC_RELEASE, "agent");
            asm volatile("s_waitcnt vmcnt(0)" ::: "memory");
            const unsigned og = xb_add(&bar[XB_TOP], 1u);
            const unsigned tg = og / nx;
            if (og + 1u == (tg + 1u) * nx) xb_add(&bar[XB_TOPGEN], 1u);
            else XB_SPIN(xb_ld(&bar[XB_TOPGEN]) == tg, bar);
            __builtin_amdgcn_fence(__ATOMIC_ACQUIRE, "agent");
            xb_add(&bar[XB_XGEN(b.x)], 1u);
            asm volatile("s_waitcnt vmcnt(0)" ::: "memory");
        } else {
            XB_SPIN(xb_ld(&bar[XB_XGEN(b.x)]) == gen, bar);
            __builtin_amdgcn_fence(__ATOMIC_ACQUIRE, "agent");
            asm volatile("s_waitcnt vmcnt(0)" ::: "memory");
        }
    }
    __syncthreads();
}

__device__ __forceinline__ void grid_barrier(const Params& p) {
    XcdBarrier b; b.bar = (unsigned*)(ws_opaque(p.ws) + OFF_BAR); b.x = xb_xcc_id(); b.st = (volatile LAS unsigned*)(g_smem + SMEM_BAR_OFF);
    xcd_barrier_impl(b);
}
__device__ __forceinline__ unsigned char* half_smem() { int t = threadIdx.x; asm volatile("" : "+v"(t)); return g_smem + (t >> 8) * SMEM_HALF; }
__device__ __forceinline__ void run_layer(const Params& p, const int layer) {
    PB(11); inproj_phase(p, layer, half_smem()); PE(11);      PB(30); grid_barrier(p); PE(30);
    PB(12); p2a_phase(p, layer, half_smem()); PE(12);         PB(30); grid_barrier(p); PE(30);
    PB(13); p2b_phase(p, layer, half_smem()); PE(13);         PB(30); grid_barrier(p); PE(30);
    PB(14); merge_phase(p, half_smem()); PE(14);              PB(30); grid_barrier(p); PE(30);
    PB(15); wout_phase(p, half_smem()); PE(15);               PB(30); grid_barrier(p); PE(30);
    PB(16); router_phase(p, layer, half_smem()); PE(16);      PB(30); grid_barrier(p); PE(30);
    PB(17); moe_up_phase(p, half_smem()); PE(17);             PB(30); grid_barrier(p); PE(30);
    PB(18); moe_down_phase(p, half_smem()); PE(18);           PB(30); grid_barrier(p); PE(30);
    PB(19); combine_phase(p, layer); PE(19);
    if (layer == 0) { PB(10); prep_phase(p, 1, false, half_smem()); PE(10); PB(30); grid_barrier(p); PE(30); }
}
__global__ void __launch_bounds__(NTHR, 2) k_mega(Params p) {
    volatile LAS unsigned* st = (volatile LAS unsigned*)(g_smem + SMEM_BAR_OFF);
    if (threadIdx.x == 0) { st[0] = 0u; st[1] = 0u; st[2] = 0u; st[3] = 0u; unsigned* gs = (unsigned*)(g_smem + SMEM_GS_OFF); gs[0] = 0u; gs[1] = 0u;
        volatile unsigned long long* q_ = (volatile unsigned long long*)(g_smem + SMEM_PROBE_OFF); q_[0] = 0ull; q_[1] = 0ull; }
    __syncthreads();
    (void)xcd_barrier_post((unsigned*)(p.ws + OFF_BAR), st);
    PB(10); prep_phase(p, 0, true, half_smem()); PE(10);
    PB(30); grid_barrier(p); PE(30);
    run_layer(p, 0);
    run_layer(p, 1);
    if (PROBE_ID >= 0 && blockIdx.x == 0 && threadIdx.x == 0) {
        const unsigned long long d_ = *(volatile unsigned long long*)(g_smem + SMEM_PROBE_OFF) * PROBE_AMP, t0_ = __builtin_amdgcn_s_memrealtime();
        while (__builtin_amdgcn_s_memrealtime() - t0_ < d_) __builtin_amdgcn_s_sleep(8);
    }
}

extern "C" void kernel_launch(void* const* d_in, const int* in_sizes, int n_in, void* d_out, int out_size, void* d_ws, size_t ws_size, hipStream_t stream) {
    if (ws_size < WS_TOTAL) { fprintf(stderr, "kernel_launch: workspace too small: %zu < %zu\n", ws_size, (size_t)WS_TOTAL); return; }
    Params p{};
    for (int i = 0; i < 32; ++i) p.in[i] = (const float*)d_in[i];
    p.out = (float*)d_out; p.ws = (unsigned char*)d_ws;
    (void)hipMemsetAsync((char*)d_ws + OFF_BAR, 0, 16384, stream);
    static int grid_blocks = 0;
    if (!grid_blocks) {
        int dev = 0, cus = 0, per_cu = 0;
        (void)hipGetDevice(&dev);
        (void)hipDeviceGetAttribute(&cus, hipDeviceAttributeMultiprocessorCount, dev);
        if (hipOccupancyMaxActiveBlocksPerMultiprocessor(&per_cu, (const void*)k_mega, NTHR, 0) != hipSuccess || per_cu < 1) { fprintf(stderr, "kernel_launch: occupancy query failed\n"); return; }
        grid_blocks = cus;
    }
    void* args[] = {&p};
    hipError_t e = hipLaunchCooperativeKernel((const void*)k_mega, dim3(grid_blocks), dim3(NTHR), args, 0, stream);
    if (e != hipSuccess) fprintf(stderr, "cooperative launch failed: %s (grid %d)\n", hipGetErrorString(e), grid_blocks);
}
```

```cpp
#include <hip/hip_runtime.h>
#include <stdint.h>
#include <stdio.h>


typedef unsigned short u16;
typedef short bf16x8 __attribute__((ext_vector_type(8)));
typedef short bf16x4 __attribute__((ext_vector_type(4)));
typedef float f32x4 __attribute__((ext_vector_type(4)));
typedef unsigned u32x4 __attribute__((ext_vector_type(4)));
typedef unsigned u32x2 __attribute__((ext_vector_type(2)));

#define NTHR 512
#define T_TOK 16384
#define SEQ 2048
#define DM 1024
#define ALPHA_F 1.41421356237f
#define LN_EPS_F 1e-5f
#define NEGBIG (-1e30f)
#define LDU 2560
#define LDACT 1280
#define SMEM_HALF 65536
#define SMEM_RING 147456
#define SMEM_BYTES 152832
#define SMEM_PRE_OFF 147456
#define SMEM_ROWINFO_OFF 148480
#define SMEM_GS_OFF 152592
#define SMEM_BAR_OFF 152608
#define SMEM_PROBE_OFF 152576

struct Params { const float* in[32]; float* out; unsigned char* ws; };

constexpr size_t al256(size_t x) { return (x + 255) & ~(size_t)255; }
constexpr size_t OFF_BAR   = 0;
constexpr size_t OFF_CNT   = 16384;
constexpr size_t OFF_BIAS1 = 32768;
constexpr size_t OFF_XB    = 65536;
constexpr size_t SZ_TD     = (size_t)T_TOK * 1024 * 2;
constexpr size_t OFF_Z     = OFF_XB + SZ_TD;
constexpr size_t OFF_A     = OFF_Z + SZ_TD;
constexpr size_t OFF_U     = OFF_A;
constexpr size_t SZ_U      = (size_t)T_TOK * LDU * 2;
constexpr size_t OFF_UT    = OFF_U + SZ_U;
constexpr size_t SZ_UT     = (size_t)8 * 1024 * 2048 * 2;
constexpr size_t SZ_A      = (size_t)T_TOK * 6 * 1024 * 2;
static_assert(SZ_A >= SZ_U + SZ_UT, "region A");
constexpr size_t OFF_YSLOT = OFF_A;
constexpr size_t OFF_B     = OFF_A + SZ_A;
constexpr size_t OFF_ACT   = OFF_B;
constexpr size_t SZ_ACT    = (size_t)T_TOK * LDACT * 2;
constexpr size_t OFF_MERGED= OFF_ACT + SZ_ACT;
constexpr size_t SZ_B      = SZ_ACT + SZ_TD;
constexpr size_t OFF_H     = OFF_B;
static_assert(SZ_B >= (size_t)(98304 + 64 * 255 + 16384 + 256) * 256 * 2, "region B");
constexpr size_t OFF_KC    = OFF_B + SZ_B;
constexpr size_t SZ_KC     = al256(((size_t)T_TOK * 64 + 1024) * 2);
constexpr size_t OFF_VC    = OFF_KC + SZ_KC;
constexpr size_t OFF_KCMP  = OFF_VC + SZ_KC;
constexpr size_t OFF_VCMPT = OFF_KCMP + 1024 * 64 * 2;
constexpr size_t OFF_KVT   = OFF_VCMPT + 8 * 64 * 128 * 2;
constexpr size_t OFF_LIST  = OFF_KVT + (size_t)512 * 8192 * 4;
constexpr size_t OFF_GATEW = OFF_LIST + (size_t)64 * 16384 * 4;
constexpr size_t OFF_WINT  = OFF_GATEW + (size_t)T_TOK * 8 * 4;
constexpr size_t OFF_PT    = OFF_WINT + (size_t)7680 * 1024 * 2;
constexpr size_t OFF_WOUT  = OFF_PT + (size_t)1280 * 1024 * 2;
constexpr size_t OFF_RW    = OFF_WOUT + (size_t)1024 * 1024 * 2;
constexpr size_t OFF_WUP   = OFF_RW + (size_t)64 * 1024 * 2;
constexpr size_t OFF_WD    = OFF_WUP + (size_t)65 * 512 * 1024 * 2;
constexpr size_t OFF_W1T   = OFF_WD + (size_t)65 * 1024 * 256 * 2;
constexpr size_t OFF_W2T   = OFF_W1T + (size_t)2 * 256 * 2048 * 2;
constexpr size_t WS_TOTAL  = OFF_W2T + (size_t)2 * 64 * 256 * 2;

#define MFMA16(a, b, c) __builtin_amdgcn_mfma_f32_16x16x32_bf16((a), (b), (c), 0, 0, 0)

__device__ __forceinline__ u16 f2bf(float f) { uint32_t u = __float_as_uint(f); u += 0x7fffu + ((u >> 16) & 1u); return (u16)(u >> 16); }
__device__ __forceinline__ float bf2f(u16 h) { return __uint_as_float(((uint32_t)h) << 16); }
typedef __bf16 bf16x2_t __attribute__((ext_vector_type(2)));
typedef float f32x2_t __attribute__((ext_vector_type(2)));
__device__ __forceinline__ uint32_t pack2(float a, float b) { const f32x2_t v = {a, b}; return __builtin_bit_cast(uint32_t, __builtin_convertvector(v, bf16x2_t)); }
__device__ __forceinline__ uint2 pack4(f32x4 v) { return make_uint2(pack2(v[0], v[1]), pack2(v[2], v[3])); }
__device__ __forceinline__ float sigmoidf_(float x) { return __builtin_amdgcn_rcpf(1.f + __builtin_amdgcn_exp2f(-1.44269504089f * x)); }
__device__ __forceinline__ float siluf_(float x) { return x * __builtin_amdgcn_rcpf(1.f + __builtin_amdgcn_exp2f(-1.44269504089f * x)); }
__device__ __forceinline__ float bflo(uint32_t w) { return __uint_as_float(w << 16); }
__device__ __forceinline__ float bfhi(uint32_t w) { return __uint_as_float(w & 0xffff0000u); }

#define LAS __attribute__((address_space(3)))
__shared__ __attribute__((aligned(16))) unsigned char g_smem[SMEM_BYTES];
#define VBID  ((int)(blockIdx.x * 2 + __builtin_amdgcn_readfirstlane((int)(threadIdx.x >> 8))))
#define VGRID ((int)(gridDim.x * 2))
__device__ __forceinline__ void gsync() {
    unsigned* ctr = (unsigned*)(g_smem + SMEM_GS_OFF) + (threadIdx.x >> 8);
    asm volatile("s_waitcnt lgkmcnt(0)" ::: "memory");
    unsigned old = 0u;
    if ((threadIdx.x & 63) == 0) old = __hip_atomic_fetch_add(ctr, 1u, __ATOMIC_RELAXED, __HIP_MEMORY_SCOPE_WORKGROUP);
    old = (unsigned)__builtin_amdgcn_readfirstlane((int)old);
    const unsigned want = ((old >> 2) + 1u) << 2;
    while (__hip_atomic_load(ctr, __ATOMIC_RELAXED, __HIP_MEMORY_SCOPE_WORKGROUP) < want) __builtin_amdgcn_s_sleep(0);
    asm volatile("" ::: "memory");
}
#define GSYNC() gsync()

#ifndef PROBE_ID
#define PROBE_ID -1
#endif
#define PROBE_AMP 8
#ifndef PROBE_BLK
#define PROBE_BLK 0
#endif
#define PB(id) do { if ((id) == PROBE_ID && blockIdx.x == PROBE_BLK && threadIdx.x == 0) { *(volatile unsigned long long*)(g_smem + SMEM_PROBE_OFF + 8) = __builtin_amdgcn_s_memrealtime(); } } while (0)
#define PE(id) do { if ((id) == PROBE_ID && blockIdx.x == PROBE_BLK && threadIdx.x == 0) { volatile unsigned long long* q_ = (volatile unsigned long long*)(g_smem + SMEM_PROBE_OFF); q_[0] += __builtin_amdgcn_s_memrealtime() - q_[1]; } } while (0)

__device__ __forceinline__ int tid_opaque() { int t = threadIdx.x & 255; asm volatile("" : "+v"(t)); return t; }
__device__ __forceinline__ unsigned char* ws_opaque(unsigned char* w) {
    unsigned lo = (unsigned)(uintptr_t)w, hi = (unsigned)((uintptr_t)w >> 32);
    asm volatile("" : "+v"(lo), "+v"(hi));
    lo = __builtin_amdgcn_readfirstlane(lo); hi = __builtin_amdgcn_readfirstlane(hi);
    return (unsigned char*)(((uintptr_t)hi << 32) | (uintptr_t)lo);
}

template <int WM, int WN> __device__ __forceinline__ void zero_acc(f32x4 (&acc)[WM][WN]) {
#pragma unroll
    for (int i = 0; i < WM; ++i)
#pragma unroll
        for (int j = 0; j < WN; ++j) acc[i][j] = (f32x4){0.f, 0.f, 0.f, 0.f};
}

template <int WM, int WN, class FA, class FB>
__device__ __forceinline__ void gemm_acc(f32x4 (&acc)[WM][WN], FA rowA, FB rowB, int K, unsigned char* sbase) {
    constexpr int A_BYTES = 32 * WM * 128, B_BYTES = 32 * WN * 128, BUF = A_BYTES + B_BYTES;
    const int tid = tid_opaque(), lane = tid & 63, wave = tid >> 6;
    const int wm = wave >> 1, wn = wave & 1;
    const int fr = lane & 15, fg = lane >> 4;
    const int lrow = lane >> 3, lch = (lane & 7) ^ lrow;
    const u16* pa[WM]; const u16* pb[WN];
#pragma unroll
    for (int i = 0; i < WM; ++i) pa[i] = rowA((wave + 4 * i) * 8 + lrow) + lch * 8;
#pragma unroll
    for (int j = 0; j < WN; ++j) pb[j] = rowB((wave + 4 * j) * 8 + lrow) + lch * 8;
    unsigned char* const ldst = sbase + wave * 1024 + lane * 16;
    GSYNC();
#pragma unroll
    for (int i = 0; i < WM; ++i) __builtin_amdgcn_global_load_lds((const unsigned*)(pa[i]), (unsigned*)(ldst + i * 4096), 16, 0, 0);
#pragma unroll
    for (int j = 0; j < WN; ++j) __builtin_amdgcn_global_load_lds((const unsigned*)(pb[j]), (unsigned*)(ldst + A_BYTES + j * 4096), 16, 0, 0);
    const int nk = K >> 6;
    for (int kt = 0; kt < nk; ++kt) {
        asm volatile("s_waitcnt vmcnt(0)" ::: "memory");
        GSYNC();
        if (kt + 1 < nk) {
            unsigned char* const d = ldst + ((kt + 1) & 1) * BUF;
            const int ko = (kt + 1) * 64;
#pragma unroll
            for (int i = 0; i < WM; ++i) __builtin_amdgcn_global_load_lds((const unsigned*)(pa[i] + ko), (unsigned*)(d + i * 4096), 16, 0, 0);
#pragma unroll
            for (int j = 0; j < WN; ++j) __builtin_amdgcn_global_load_lds((const unsigned*)(pb[j] + ko), (unsigned*)(d + A_BYTES + j * 4096), 16, 0, 0);
        }
        const unsigned char* a0 = sbase + (kt & 1) * BUF + (wm * 16 * WM + fr) * 128;
        const unsigned char* b0 = sbase + (kt & 1) * BUF + A_BYTES + (wn * 16 * WN + fr) * 128;
#pragma unroll
        for (int ks = 0; ks < 2; ++ks) {
            const int co = ((4 * ks + fg) ^ (fr & 7)) << 4;
            bf16x8 a[WM], b[WN];
#pragma unroll
            for (int i = 0; i < WM; ++i) a[i] = *(const bf16x8*)(a0 + i * 2048 + co);
#pragma unroll
            for (int j = 0; j < WN; ++j) b[j] = *(const bf16x8*)(b0 + j * 2048 + co);
#pragma unroll
            for (int i = 0; i < WM; ++i)
#pragma unroll
                for (int j = 0; j < WN; ++j) acc[i][j] = MFMA16(a[i], b[j], acc[i][j]);
        }
    }
}

template <int TM, int TN> struct G8 {
    static constexpr int A_BYTES = 32 * TM * 64, B_BYTES = 64 * TN * 64, SLOT = A_BYTES + B_BYTES, PA = TM / 4, PB = TN / 2, NP = PA + PB;
    static_assert(4 * SLOT <= 131072, "ring");
    const u16* pp[NP];
};
template <int TM, int TN, class FA, class FB>
__device__ __forceinline__ void g8_setup(G8<TM, TN>& g, FA rowA, FB rowB) {
    int tid = threadIdx.x; asm volatile("" : "+v"(tid));
    const int lane = tid & 63, wave = tid >> 6;
    const int srow = lane >> 2, sch = (lane & 3) ^ ((0 - (lane >> 4)) & 3);
#pragma unroll
    for (int i = 0; i < G8<TM, TN>::PA; ++i) g.pp[i] = rowA(16 * (wave + 8 * i) + srow) + sch * 8;
#pragma unroll
    for (int j = 0; j < G8<TM, TN>::PB; ++j) g.pp[G8<TM, TN>::PA + j] = rowB(16 * (wave + 8 * j) + srow) + sch * 8;
}
#define G8_ISSUE(g, sl) do { unsigned char* const d_ = ldst + ((sl) & 3) * GT::SLOT; const int ko_ = (sl) * 32; \
        _Pragma("unroll") for (int q = 0; q < GT::NP; ++q) \
            __builtin_amdgcn_global_load_lds((const unsigned*)((g).pp[q] + ko_), (unsigned*)(d_ + (q < GT::PA ? q * 8192 : GT::A_BYTES + (q - GT::PA) * 8192)), 16, 0, 0); } while (0)
template <int TM, int TN>
__device__ __forceinline__ void g8_prefetch(const G8<TM, TN>& g, int K) {
    typedef G8<TM, TN> GT;
    int tid = threadIdx.x; asm volatile("" : "+v"(tid));
    unsigned char* const ldst = g_smem + (tid >> 6) * 1024 + (tid & 63) * 16;
    G8_ISSUE(g, 0);
    if (K > 32) G8_ISSUE(g, 1);
}
template <int TM, int TN>
__device__ __forceinline__ void g8_run(const G8<TM, TN>& g, f32x4 (&acc)[TM][TN], int K) {
    typedef G8<TM, TN> GT;
    int tid = threadIdx.x; asm volatile("" : "+v"(tid));
    const int lane = tid & 63, wave = tid >> 6, wr = wave >> 2, wc = wave & 3;
    const int fr = lane & 15, fg = lane >> 4;
    unsigned char* const ldst = g_smem + wave * 1024 + lane * 16;
    const int swz = (fg ^ ((0 - (fr >> 2)) & 3)) << 4;
    const int aoff = (wr * 16 * TM + fr) * 64 + swz, boff = GT::A_BYTES + (wc * 16 * TN + fr) * 64 + swz;
    const int ns = K >> 5;
    const int wr_u = __builtin_amdgcn_readfirstlane(wr);
    asm volatile("s_waitcnt vmcnt(0)" ::: "memory");
    __builtin_amdgcn_s_barrier();
    __builtin_amdgcn_sched_barrier(0);
    if (ns > 2) G8_ISSUE(g, 2);
    __builtin_amdgcn_sched_barrier(0);
    if (wr_u == 1) __builtin_amdgcn_s_barrier();
    __builtin_amdgcn_sched_barrier(0);
    for (int s = 0; s < ns; ++s) {
        const unsigned char* sl = g_smem + (s & 3) * GT::SLOT;
        bf16x8 a[TM], b[TN];
#pragma unroll
        for (int j = 0; j < TN; ++j) b[j] = *(const bf16x8*)(sl + boff + j * 1024);
#pragma unroll
        for (int i = 0; i < TM; ++i) a[i] = *(const bf16x8*)(sl + aoff + i * 1024);
        if (s + 3 < ns) { G8_ISSUE(g, s + 3); asm volatile("s_waitcnt vmcnt(%0)" :: "i"(2 * GT::NP) : "memory"); }
        else if (s + 2 < ns) asm volatile("s_waitcnt vmcnt(%0)" :: "i"(GT::NP) : "memory");
        else asm volatile("s_waitcnt vmcnt(0)" ::: "memory");
        asm volatile("s_waitcnt lgkmcnt(0)" ::: "memory");
        __builtin_amdgcn_sched_barrier(0);
        __builtin_amdgcn_s_barrier();
        __builtin_amdgcn_sched_barrier(0);
        __builtin_amdgcn_s_setprio(1);
#pragma unroll
        for (int i = 0; i < TM; ++i)
#pragma unroll
            for (int j = 0; j < TN; ++j) acc[i][j] = MFMA16(a[i], b[j], acc[i][j]);
        __builtin_amdgcn_s_setprio(0);
        __builtin_amdgcn_sched_barrier(0);
        __builtin_amdgcn_s_barrier();
        __builtin_amdgcn_sched_barrier(0);
    }
    if (wr_u == 0) __builtin_amdgcn_s_barrier();
    __builtin_amdgcn_sched_barrier(0);
}
template <int TM, int TN> struct G8W {
    static constexpr int A_BYTES = 32 * TM * 128, B_BYTES = 64 * TN * 128, SLOT = A_BYTES + B_BYTES, PA = TM / 2, PB = TN, NP = PA + PB;
    static_assert(3 * SLOT <= SMEM_RING, "ring");
    const u16* pp[NP];
};
template <int TM, int TN, class FA, class FB>
__device__ __forceinline__ void g8w_setup(G8W<TM, TN>& g, FA rowA, FB rowB) {
    int tid = threadIdx.x; asm volatile("" : "+v"(tid));
    const int lane = tid & 63, wave = tid >> 6;
    const int srow = lane >> 3, sch = (lane & 7) ^ srow;
#pragma unroll
    for (int i = 0; i < G8W<TM, TN>::PA; ++i) g.pp[i] = rowA(8 * (wave + 8 * i) + srow) + sch * 8;
#pragma unroll
    for (int j = 0; j < G8W<TM, TN>::PB; ++j) g.pp[G8W<TM, TN>::PA + j] = rowB(8 * (wave + 8 * j) + srow) + sch * 8;
}
#define G8W_ISSUE(g, sl, slot) do { unsigned char* const d_ = ldst + (slot) * GT::SLOT; const int ko_ = (sl) * 64; \
        _Pragma("unroll") for (int q = 0; q < GT::NP; ++q) \
            __builtin_amdgcn_global_load_lds((const unsigned*)((g).pp[q] + ko_), (unsigned*)(d_ + (q < GT::PA ? q * 8192 : GT::A_BYTES + (q - GT::PA) * 8192)), 16, 0, 0); } while (0)
template <int TM, int TN>
__device__ __forceinline__ void g8w_prefetch(const G8W<TM, TN>& g, int K) {
    typedef G8W<TM, TN> GT;
    int tid = threadIdx.x; asm volatile("" : "+v"(tid));
    unsigned char* const ldst = g_smem + (tid >> 6) * 1024 + (tid & 63) * 16;
    G8W_ISSUE(g, 0, 0);
    if (K > 64) G8W_ISSUE(g, 1, 1);
}
template <int TM, int TN>
__device__ __forceinline__ void g8w_run(const G8W<TM, TN>& g, f32x4 (&acc)[TM][TN], int K) {
    typedef G8W<TM, TN> GT;
    int tid = threadIdx.x; asm volatile("" : "+v"(tid));
    const int lane = tid & 63, wave = tid >> 6, wr = wave >> 2, wc = wave & 3;
    const int fr = lane & 15, fg = lane >> 4;
    unsigned char* const ldst = g_smem + wave * 1024 + lane * 16;
    const int co0 = ((fg) ^ (fr & 7)) << 4, co1 = ((4 + fg) ^ (fr & 7)) << 4;
    const int aoff = (wr * 16 * TM + fr) * 128, boff = GT::A_BYTES + (wc * 16 * TN + fr) * 128;
    const int ns = K >> 6;
    const int wr_u = __builtin_amdgcn_readfirstlane(wr);
    asm volatile("s_waitcnt vmcnt(0)" ::: "memory");
    __builtin_amdgcn_s_barrier();
    __builtin_amdgcn_sched_barrier(0);
    if (wr_u == 1) __builtin_amdgcn_s_barrier();
    __builtin_amdgcn_sched_barrier(0);
    int slot = 0;
    for (int s = 0; s < ns; ++s) {
        const unsigned char* sl = g_smem + slot * GT::SLOT;
        bf16x8 a[TM][2], b[TN][2];
#pragma unroll
        for (int j = 0; j < TN; ++j) { b[j][0] = *(const bf16x8*)(sl + boff + j * 2048 + co0); b[j][1] = *(const bf16x8*)(sl + boff + j * 2048 + co1); }
#pragma unroll
        for (int i = 0; i < TM; ++i) { a[i][0] = *(const bf16x8*)(sl + aoff + i * 2048 + co0); a[i][1] = *(const bf16x8*)(sl + aoff + i * 2048 + co1); }
        const int slot2 = (slot == 0) ? 2 : slot - 1;
        if (s + 2 < ns) { G8W_ISSUE(g, s + 2, slot2); asm volatile("s_waitcnt vmcnt(%0)" :: "i"(GT::NP) : "memory"); }
        else asm volatile("s_waitcnt vmcnt(0)" ::: "memory");
        asm volatile("s_waitcnt lgkmcnt(0)" ::: "memory");
        __builtin_amdgcn_sched_barrier(0);
        __builtin_amdgcn_s_barrier();
        __builtin_amdgcn_sched_barrier(0);
        __builtin_amdgcn_s_setprio(1);
#pragma unroll
        for (int ks = 0; ks < 2; ++ks)
#pragma unroll
            for (int i = 0; i < TM; ++i)
#pragma unroll
                for (int j = 0; j < TN; ++j) acc[i][j] = MFMA16(a[i][ks], b[j][ks], acc[i][j]);
        __builtin_amdgcn_s_setprio(0);
        __builtin_amdgcn_sched_barrier(0);
        __builtin_amdgcn_s_barrier();
        __builtin_amdgcn_sched_barrier(0);
        slot = (slot == 2) ? 0 : slot + 1;
    }
    if (wr_u == 0) __builtin_amdgcn_s_barrier();
    __builtin_amdgcn_sched_barrier(0);
}
template <int TM, int TN, class F>
__device__ __forceinline__ void g8_store_rows(const uint2 (&pk)[TM][TN], F sink, int stg_off = 65536) {
    constexpr int RB = 32 * TM;
    constexpr int C16 = 2 * TM;
    static_assert(64 * TN * RB <= 65536, "staging");
    int tid = threadIdx.x; asm volatile("" : "+v"(tid));
    const int lane = tid & 63, wave = tid >> 6, wr = wave >> 2, wc = wave & 3, fr = lane & 15, fg = lane >> 4;
    unsigned char* const stg = g_smem + stg_off;
#pragma unroll
    for (int h = 0; h < 2; ++h) {
        if (h == 1) { asm volatile("s_waitcnt lgkmcnt(0)" ::: "memory"); __builtin_amdgcn_s_barrier(); }
        __builtin_amdgcn_sched_barrier(0);
        if (wr == h) {
#pragma unroll
            for (int i = 0; i < TM; ++i)
#pragma unroll
                for (int j = 0; j < TN; ++j) {
                    const int n = wc * 16 * TN + 16 * j + fr, c = 4 * i + fg;
                    *(uint2*)(stg + n * RB + ((c ^ ((n & 7) << 1)) << 3)) = pk[i][j];
                }
        }
        asm volatile("s_waitcnt lgkmcnt(0)" ::: "memory");
        __builtin_amdgcn_s_barrier();
        __builtin_amdgcn_sched_barrier(0);
#pragma unroll
        for (int it = 0; it < (64 * TN * C16) / 512; ++it) {
            const int idx = it * 512 + tid, n = idx / C16, k = idx % C16;
            const u32x4 v = *(const u32x4*)(stg + n * RB + ((k ^ (n & 7)) << 4));
            sink(h * 16 * TM + 8 * k, n, v);
        }
    }
}
#define FULL_LANE_VARS int t_ = threadIdx.x; asm volatile("" : "+v"(t_)); const int lane = t_ & 63, wave = t_ >> 6, wr = wave >> 2, wc = wave & 3, fr = lane & 15, fg = lane >> 4; (void)wr; (void)wc; (void)fr; (void)fg; (void)lane;

__device__ __forceinline__ void stage_rows64(u16* s, const u16* g, int ld) {
    const int t = tid_opaque(), r = t >> 2, c = (t & 3) * 16;
    const uint4* p = (const uint4*)(g + (size_t)r * ld + c);
    const uint4 v0 = p[0], v1 = p[1];
    *(uint4*)&s[r * 72 + c] = v0; *(uint4*)&s[r * 72 + c + 8] = v1;
}
__device__ __forceinline__ void qk64(const u16* sK, const bf16x8 (&qf)[2], f32x4 (&s)[4], int lane) {
    const int r = lane & 15, g = lane >> 4;
#pragma unroll
    for (int mt = 0; mt < 4; ++mt) {
        s[mt] = (f32x4){0.f, 0.f, 0.f, 0.f};
#pragma unroll
        for (int ks = 0; ks < 2; ++ks) {
            const bf16x8 a = *(const bf16x8*)&sK[(16 * mt + r) * 72 + 32 * ks + 8 * g];
            s[mt] = MFMA16(a, qf[ks], s[mt]);
        }
    }
}
template <int DT>
__device__ __forceinline__ void pv64(const u16* sVt, int vstride, const bf16x8 (&pb)[2], f32x4 (&o)[DT], int lane) {
    const int r = lane & 15, g = lane >> 4;
#pragma unroll
    for (int dt = 0; dt < DT; ++dt)
#pragma unroll
        for (int s2 = 0; s2 < 2; ++s2) {
            const u16* p = &sVt[(16 * dt + r) * vstride + 32 * s2 + 4 * g];
            const u32x2 lo = *(const u32x2*)p, hi = *(const u32x2*)(p + 16);
            const u32x4 av = {lo.x, lo.y, hi.x, hi.y};
            o[dt] = MFMA16(__builtin_bit_cast(bf16x8, av), pb[s2], o[dt]);
        }
}
__device__ __forceinline__ void pack_p(const float (&x)[16], bf16x8 (&pb)[2]) {
#pragma unroll
    for (int s2 = 0; s2 < 2; ++s2) {
        const u32x4 tv = {pack2(x[8 * s2 + 0], x[8 * s2 + 1]), pack2(x[8 * s2 + 2], x[8 * s2 + 3]),
                          pack2(x[8 * s2 + 4], x[8 * s2 + 5]), pack2(x[8 * s2 + 6], x[8 * s2 + 7])};
        pb[s2] = __builtin_bit_cast(bf16x8, tv);
    }
}
template <int DT, class F>
__device__ __forceinline__ void flash_step(const u16* sK, const u16* sVt, int vstride, const bf16x8 (&qf)[2],
                                           f32x4 (&o)[DT], float& m, float& l, bool lane_active, F logit, int lane) {
    if (__ballot(lane_active) == 0ull) return;
    f32x4 s[4]; qk64(sK, qf, s, lane);
    const int g = lane >> 4;
    float x[16]; float mx = NEGBIG;
#pragma unroll
    for (int mt = 0; mt < 4; ++mt)
#pragma unroll
        for (int rr = 0; rr < 4; ++rr) {
            bool valid; float v = logit(16 * mt + 4 * g + rr, s[mt][rr], valid);
            v = (valid && lane_active) ? v : NEGBIG; x[mt * 4 + rr] = v; mx = fmaxf(mx, v);
        }
    mx = fmaxf(mx, __shfl_xor(mx, 16)); mx = fmaxf(mx, __shfl_xor(mx, 32));
    const float mn = fmaxf(m, mx), alpha = __builtin_amdgcn_exp2f((m - mn) * 1.44269504089f);
    float ps = 0.f;
#pragma unroll
    for (int i = 0; i < 16; ++i) { const float pv = (x[i] > -1e29f) ? __builtin_amdgcn_exp2f((x[i] - mn) * 1.44269504089f) : 0.f; x[i] = pv; ps += pv; }
    l = l * alpha + ps; m = mn;
#pragma unroll
    for (int dt = 0; dt < DT; ++dt) o[dt] *= alpha;
    bf16x8 pb[2]; pack_p(x, pb);
    pv64<DT>(sVt, vstride, pb, o, lane);
}

struct PrepDesc { const float* src; u16* dst; int ld_src, k0, c0, nvalid, ld_dst, drow_base, grp_stride; };
__device__ __forceinline__ void win_seg(int drow, int& src, int& nvalid) {
    nvalid = 64;
    if (drow < 896) src = drow;
    else if (drow < 1152) src = 1024 + (drow - 896);
    else if (drow < 1408) src = 1280 + (drow - 1152);
    else if (drow < 1920) src = 2048 + (drow - 1408);
    else if (drow < 2176) src = 2560 + (drow - 1920);
    else if (drow < 2240) src = 2816;
    else if (drow < 2304) src = 2880;
    else if (drow < 2368) src = 2944;
    else if (drow < 2432) src = 3072;
    else if (drow < 2496) { src = 3200; nvalid = 12; }
    else if (drow < 2560) { src = 0; nvalid = 0; }
    else if (drow < 2688) src = 896 + (drow - 2560);
    else if (drow < 2944) src = 1280 + (drow - 2688);
    else if (drow < 3456) src = 1536 + (drow - 2944);
    else if (drow < 3520) src = 3008;
    else if (drow < 3584) src = 3136;
    else src = 3212 + (drow - 3584);
}
#define PREP_NTILES (1920 + 320 + 256 + 8320 + 4160 + 256 + 8)
__device__ __forceinline__ void prep_get(const Params& p, unsigned char* ws, int layer, int idx, PrepDesc& d) {
    d.nvalid = 64; d.grp_stride = 16;
    if (idx < 1920) {
        const int dg = idx >> 4, kt = idx & 15; int src, nv; win_seg(dg * 64, src, nv);
        d.src = p.in[1] + (size_t)layer * 1024 * 7308; d.ld_src = 7308; d.k0 = kt * 64; d.c0 = src; d.nvalid = nv;
        d.dst = (u16*)(ws + OFF_WINT); d.ld_dst = 1024; d.drow_base = dg * 64; return;
    }
    idx -= 1920;
    if (idx < 320) {
        int K, local; size_t off;
        if (idx < 64) { d.src = p.in[15] + (size_t)layer * 256 * 1024; K = 256; local = idx; off = 0; }
        else if (idx < 128) { d.src = p.in[16] + (size_t)layer * 256 * 1024; K = 256; local = idx - 64; off = 262144; }
        else if (idx < 256) { d.src = p.in[17] + (size_t)layer * 512 * 1024; K = 512; local = idx - 128; off = 524288; }
        else { d.src = p.in[18] + (size_t)layer * 256 * 1024; K = 256; local = idx - 256; off = 1048576; }
        const int nk = K >> 6, ct = local / nk, kt = local % nk;
        d.ld_src = 1024; d.k0 = kt * 64; d.c0 = ct * 64; d.dst = (u16*)(ws + OFF_PT) + off; d.ld_dst = K; d.drow_base = ct * 64; return;
    }
    idx -= 320;
    if (idx < 256) {
        const int ct = idx >> 4, kt = idx & 15;
        d.src = p.in[19] + (size_t)layer * 1024 * 1024; d.ld_src = 1024; d.k0 = kt * 64; d.c0 = ct * 64; d.dst = (u16*)(ws + OFF_WOUT); d.ld_dst = 1024; d.drow_base = ct * 64; return;
    }
    idx -= 256;
    if (idx < 8320) {
        const int e = idx >> 7, rem = idx & 127, isUp = rem >> 6, r2 = rem & 63, ct = r2 >> 4, kt = r2 & 15;
        d.src = (e < 64) ? p.in[24 + isUp] + ((size_t)layer * 64 + e) * 1024 * 256 : p.in[27 + isUp] + (size_t)layer * 1024 * 256;
        d.ld_src = 256; d.k0 = kt * 64; d.c0 = ct * 64; d.dst = (u16*)(ws + OFF_WUP) + (size_t)e * 512 * 1024; d.ld_dst = 1024; d.drow_base = 32 * (ct * 4) + 16 * isUp; d.grp_stride = 32; return;
    }
    idx -= 8320;
    if (idx < 4160) {
        const int e = idx >> 6, r2 = idx & 63, ct = r2 >> 2, kt = r2 & 3;
        d.src = (e < 64) ? p.in[26] + ((size_t)layer * 64 + e) * 256 * 1024 : p.in[29] + (size_t)layer * 256 * 1024;
        d.ld_src = 1024; d.k0 = kt * 64; d.c0 = ct * 64; d.dst = (u16*)(ws + OFF_WD) + (size_t)e * 1024 * 256; d.ld_dst = 256; d.drow_base = ct * 64; return;
    }
    idx -= 4160;
    if (idx < 256) {
        const int which = idx >> 7, r2 = idx & 127, ct = r2 >> 5, kt = r2 & 31;
        d.src = p.in[which ? 13 : 10] + (size_t)layer * 2048 * 256; d.ld_src = 256; d.k0 = kt * 64; d.c0 = ct * 64;
        d.dst = (u16*)(ws + OFF_W1T) + (size_t)which * 256 * 2048; d.ld_dst = 2048; d.drow_base = ct * 64; return;
    }
    idx -= 256;
    {
        const int which = idx >> 2, kt = idx & 3;
        d.src = p.in[which ? 14 : 11] + (size_t)layer * 256 * 64; d.ld_src = 64; d.k0 = kt * 64; d.c0 = 0;
        d.dst = (u16*)(ws + OFF_W2T) + (size_t)which * 64 * 256; d.ld_dst = 256; d.drow_base = 0;
    }
}
__device__ __forceinline__ void cvt16(const float* src, u16* dst) {
    const float4 a = ((const float4*)src)[0], b = ((const float4*)src)[1], c = ((const float4*)src)[2], d = ((const float4*)src)[3];
    *(uint4*)dst = make_uint4(pack2(a.x, a.y), pack2(a.z, a.w), pack2(b.x, b.y), pack2(b.z, b.w));
    *(uint4*)(dst + 8) = make_uint4(pack2(c.x, c.y), pack2(c.z, c.w), pack2(d.x, d.y), pack2(d.z, d.w));
}
__device__ __forceinline__ void prep_phase(const Params& p, int layer, bool with_x, unsigned char* smem) {
    float* tile = (float*)smem;
    unsigned char* ws = ws_opaque(p.ws);
    const int t = tid_opaque();
    for (int it = VBID; it < PREP_NTILES; it += 2 * VGRID) {
        const int it1 = it + VGRID; const bool has1 = it1 < PREP_NTILES;
        PrepDesc d0, d1; prep_get(p, ws, layer, it, d0); prep_get(p, ws, layer, has1 ? it1 : it, d1);
        const int rr = t >> 4, cc = (t & 15) * 4;
        float4 v0[4], v1[4];
#pragma unroll
        for (int ii = 0; ii < 4; ++ii) {
            const int row = rr + 16 * ii;
            v0[ii] = make_float4(0.f, 0.f, 0.f, 0.f); v1[ii] = v0[ii];
            if (cc < d0.nvalid) v0[ii] = *(const float4*)(d0.src + (size_t)(d0.k0 + row) * d0.ld_src + d0.c0 + cc);
            if (has1 && cc < d1.nvalid) v1[ii] = *(const float4*)(d1.src + (size_t)(d1.k0 + row) * d1.ld_src + d1.c0 + cc);
        }
#pragma unroll
        for (int ii = 0; ii < 4; ++ii) {
            const int row = rr + 16 * ii;
            float* tp = tile + row * 65 + cc; tp[0] = v0[ii].x; tp[1] = v0[ii].y; tp[2] = v0[ii].z; tp[3] = v0[ii].w;
            float* tq = tile + 64 * 65 + row * 65 + cc; tq[0] = v1[ii].x; tq[1] = v1[ii].y; tq[2] = v1[ii].z; tq[3] = v1[ii].w;
        }
        GSYNC();
        {
            const int j = t >> 2, kk = (t & 3) * 16;
#pragma unroll
            for (int h = 0; h < 2; ++h) {
                if (h == 1 && !has1) break;
                const float* tb = tile + h * 64 * 65;
                const int ld_dst = h ? d1.ld_dst : d0.ld_dst, drow_base = h ? d1.drow_base : d0.drow_base, gst = h ? d1.grp_stride : d0.grp_stride, k0 = h ? d1.k0 : d0.k0;
                u16* dst = h ? d1.dst : d0.dst;
                uint32_t w[8];
#pragma unroll
                for (int i = 0; i < 8; ++i) w[i] = pack2(tb[(kk + 2 * i) * 65 + j], tb[(kk + 2 * i + 1) * 65 + j]);
                u16* dp = dst + (size_t)(drow_base + (j >> 4) * gst + (j & 15)) * ld_dst + k0 + kk;
                *(uint4*)dp = make_uint4(w[0], w[1], w[2], w[3]); *(uint4*)(dp + 8) = make_uint4(w[4], w[5], w[6], w[7]);
            }
        }
        GSYNC();
    }
    const int nH = 16, nI = 32, nJ = 1, nX = with_x ? 4096 : 0;
    for (int it = VBID; it < nH + nI + nJ + nX; it += VGRID) {
        int idx = it;
        if (idx < nH) {
            cvt16(p.in[22] + (size_t)layer * 65536 + (size_t)idx * 4096 + t * 16, (u16*)(ws + OFF_RW) + (size_t)idx * 4096 + t * 16);
            continue;
        }
        idx -= nH;
        if (idx < nI) {
            const int which = idx >> 4, part = idx & 15;
            const float* pe = p.in[which ? 12 : 9] + (size_t)layer * 2048 + part * 128;
            const float* w1 = p.in[which ? 13 : 10] + (size_t)layer * 2048 * 256 + (size_t)part * 128 * 256;
            float s0 = 0.f, s1 = 0.f, s2 = 0.f, s3 = 0.f;
#pragma unroll 4
            for (int i = 0; i < 128; i += 4) {
                s0 += pe[i] * w1[(size_t)i * 256 + t]; s1 += pe[i + 1] * w1[(size_t)(i + 1) * 256 + t];
                s2 += pe[i + 2] * w1[(size_t)(i + 2) * 256 + t]; s3 += pe[i + 3] * w1[(size_t)(i + 3) * 256 + t];
            }
            ((float*)(ws + OFF_BIAS1))[(which * 16 + part) * 256 + t] = (s0 + s1) + (s2 + s3);
            continue;
        }
        idx -= nI;
        if (idx < nJ) {
            for (int i = t; i < 2048; i += 256) ((unsigned*)(ws + OFF_CNT))[i] = 0u;
            u16* kcp = (u16*)(ws + OFF_KC) + (size_t)T_TOK * 64; u16* vcp = (u16*)(ws + OFF_VC) + (size_t)T_TOK * 64;
            for (int i = t; i < 1024; i += 256) { kcp[i] = 0; vcp[i] = 0; }
            continue;
        }
        idx -= nJ;
        cvt16(p.in[0] + (size_t)idx * 4096 + t * 16, (u16*)(ws + OFF_XB) + (size_t)idx * 4096 + t * 16);
    }
}

__device__ __forceinline__ void inproj_phase(const Params& p, int layer, unsigned char* smem) {
    unsigned char* ws = ws_opaque(p.ws);
    const u16* XB = (const u16*)(ws + OFF_XB); const u16* WINT = (const u16*)(ws + OFF_WINT);
    u16* U = (u16*)(ws + OFF_U); u16* UT = (u16*)(ws + OFF_UT); u16* KC = (u16*)(ws + OFF_KC); u16* VC = (u16*)(ws + OFF_VC);
    FULL_LANE_VARS
    const int xcd = blockIdx.x & 7, loc = blockIdx.x >> 3, nloc = gridDim.x >> 3;
    G8<8, 4> g;
    auto setup = [&](int l) {
        const int ft = l >> 3, tt = xcd * 8 + (l & 7);
        auto rowX = [=](int r) { return XB + (size_t)(tt * 256 + r) * 1024; };
        auto rowW = [=](int r) { return WINT + (size_t)(ft * 256 + r) * 1024; };
        if (ft < 10) g8_setup<8, 4>(g, rowW, rowX); else g8_setup<8, 4>(g, rowX, rowW);
    };
    __syncthreads();
    if (loc < 112) { setup(loc); g8_prefetch<8, 4>(g, 1024); }
    for (int l = loc; l < 8 * 14; l += nloc) {
        const int ft = l >> 3, tt = xcd * 8 + (l & 7);
        f32x4 acc[8][4]; zero_acc<8, 4>(acc);
        PB(43); g8_run<8, 4>(g, acc, 1024); PE(43);
        if (l + nloc < 112) { setup(l + nloc); g8_prefetch<8, 4>(g, 1024); }
        PB(44);
        uint2 pk[8][4];
        if (ft < 10) {
#pragma unroll
            for (int i = 0; i < 8; ++i)
#pragma unroll
                for (int j = 0; j < 4; ++j) pk[i][j] = pack4(acc[i][j]);
            g8_store_rows<8, 4>(pk, [&](int mloc, int n, u32x4 v) {
                const int m = ft * 256 + mloc; const size_t tok = (size_t)tt * 256 + n;
                if (m >= 2176 && m < 2304) { const int f = m - 2176; if (f < 64) *(u32x4*)(KC + tok * 64 + f) = v; else *(u32x4*)(VC + tok * 64 + (f - 64)) = v; }
                else *(u32x4*)(U + tok * LDU + m) = v;
            });
        } else {
            const int trow0 = __builtin_amdgcn_readfirstlane(ft * 256 + wc * 64 - 2560);
            const bool scaled = (trow0 >= 128) && (trow0 < 384);
            const float l2g = __log2f(1.f - __builtin_amdgcn_exp2f(-5.f - (float)((trow0 - 128) >> 6)));
            int tl_ = threadIdx.x; asm volatile("" : "+v"(tl_));
            const int sq0 = ((tl_ >> 8) * 128 + 4 * ((tl_ & 63) >> 4)) & 127;
#pragma unroll
            for (int i = 0; i < 8; ++i) {
                float sc[4];
#pragma unroll
                for (int r = 0; r < 4; ++r) {
                    const int sq = (sq0 + 16 * i + r) & 127;
                    sc[r] = scaled ? 0.125f * __builtin_amdgcn_exp2f((float)(127 - sq) * l2g) : 1.f;
                }
#pragma unroll
                for (int j = 0; j < 4; ++j) {
                    f32x4 v = acc[i][j];
                    v[0] *= sc[0]; v[1] *= sc[1]; v[2] *= sc[2]; v[3] *= sc[3];
                    pk[i][j] = pack4(v);
                }
            }
            g8_store_rows<8, 4>(pk, [&](int mloc, int n, u32x4 v) {
                const int m = tt * 256 + mloc, trow = ft * 256 + n - 2560, b = m >> 11, sq = m & 2047;
                *(u32x4*)(UT + ((size_t)(b * 1024 + trow)) * 2048 + sq) = v;
            });
        }
        PE(44);
    }
}

__device__ __forceinline__ void compress_item(const Params& p, int item, unsigned char* smem) {
    unsigned char* ws = ws_opaque(p.ws);
    u16* sH = (u16*)(smem + 40960);
    const int which = item >> 5, r0 = (item & 31) * 32;
    const u16* src = (const u16*)(ws + (which ? OFF_VC : OFF_KC));
    const u16* W1 = (const u16*)(ws + OFF_W1T) + (size_t)which * 256 * 2048;
    const u16* W2 = (const u16*)(ws + OFF_W2T) + (size_t)which * 64 * 256;
    const int t = tid_opaque();
    const int lane = t & 63, wave = t >> 6, wm = wave >> 1, wn = wave & 1, fr = lane & 15, fg = lane >> 4;
    float* bias = (float*)(smem + 40960 + 32 * 264 * 2);
    {
        const float* bp = (const float*)(ws + OFF_BIAS1) + which * 16 * 256 + t;
        float bs = 0.f;
#pragma unroll
        for (int k = 0; k < 16; ++k) bs += bp[k * 256];
        bias[t] = bs;
    }
    for (int half = 0; half < 2; ++half) {
        f32x4 acc[4][1]; zero_acc<4, 1>(acc);
        auto rowW = [=](int r) { return W1 + (size_t)(half * 128 + r) * 2048; };
        auto rowA = [=](int r) { return src + (size_t)(r0 + r) * 1024; };
        gemm_acc<4, 1>(acc, rowW, rowA, 2048, smem);
#pragma unroll
        for (int i = 0; i < 4; ++i) {
            const int m = half * 128 + wm * 64 + 16 * i + 4 * fg, n = wn * 16 + fr;
            f32x4 v = acc[i][0];
#pragma unroll
            for (int r = 0; r < 4; ++r) { const float xx = v[r] + bias[m + r]; v[r] = 0.5f * xx * (1.f + erff(xx * 0.70710678118f)); }
            *(uint2*)&sH[n * 264 + m] = pack4(v);
        }
    }
    GSYNC();
    if (which == 0) {
        f32x4 acc2[2];
        acc2[0] = (f32x4){0.f, 0.f, 0.f, 0.f}; acc2[1] = acc2[0];
#pragma unroll
        for (int ks = 0; ks < 8; ++ks) {
            const bf16x8 a = *(const bf16x8*)(W2 + (size_t)(16 * wave + fr) * 256 + 32 * ks + 8 * fg);
#pragma unroll
            for (int nt = 0; nt < 2; ++nt) { const bf16x8 b = *(const bf16x8*)&sH[(16 * nt + fr) * 264 + 32 * ks + 8 * fg]; acc2[nt] = MFMA16(a, b, acc2[nt]); }
        }
        u16* KCMP = (u16*)(ws + OFF_KCMP);
#pragma unroll
        for (int nt = 0; nt < 2; ++nt) *(uint2*)(KCMP + (size_t)(r0 + 16 * nt + fr) * 64 + 16 * wave + 4 * fg) = pack4(acc2[nt]);
    } else {
        f32x4 acc2[2];
        acc2[0] = (f32x4){0.f, 0.f, 0.f, 0.f}; acc2[1] = acc2[0];
        const int mt = wave >> 1, nb = (wave & 1) * 2;
#pragma unroll
        for (int ks = 0; ks < 8; ++ks) {
            const bf16x8 a = *(const bf16x8*)&sH[(16 * mt + fr) * 264 + 32 * ks + 8 * fg];
#pragma unroll
            for (int nt = 0; nt < 2; ++nt) { const bf16x8 b = *(const bf16x8*)(W2 + (size_t)(16 * (nb + nt) + fr) * 256 + 32 * ks + 8 * fg); acc2[nt] = MFMA16(a, b, acc2[nt]); }
        }
        u16* VCMPT = (u16*)(ws + OFF_VCMPT);
        const int rg = r0 + 16 * mt + 4 * fg, bb = rg >> 7, ii = rg & 127;
#pragma unroll
        for (int nt = 0; nt < 2; ++nt) *(uint2*)(VCMPT + (size_t)(bb * 64 + 16 * (nb + nt) + fr) * 128 + ii) = pack4(acc2[nt]);
    }
    GSYNC();
}

__device__ __forceinline__ void retkv_item(const Params& p, int item) {
    unsigned char* ws = ws_opaque(p.ws);
    const int bh = item >> 4, mc = item & 15, b = bh >> 2, h = bh & 3;
    const u16* Vt = (const u16*)(ws + OFF_UT) + ((size_t)(b * 1024 + 384 + h * 128)) * 2048 + mc * 128;
    const u16* Kt = (const u16*)(ws + OFF_UT) + ((size_t)(b * 1024 + 128 + h * 64)) * 2048 + mc * 128;
    const int t = tid_opaque();
    const int lane = t & 63, wave = t >> 6, fr = lane & 15, fg = lane >> 4;
    f32x4 acc[2][4]; zero_acc<2, 4>(acc);
#pragma unroll
    for (int ks = 0; ks < 4; ++ks) {
        bf16x8 a[2], bb[4];
#pragma unroll
        for (int mt = 0; mt < 2; ++mt) a[mt] = *(const bf16x8*)(Vt + (size_t)(32 * wave + 16 * mt + fr) * 2048 + 32 * ks + 8 * fg);
#pragma unroll
        for (int nt = 0; nt < 4; ++nt) bb[nt] = *(const bf16x8*)(Kt + (size_t)(16 * nt + fr) * 2048 + 32 * ks + 8 * fg);
#pragma unroll
        for (int mt = 0; mt < 2; ++mt)
#pragma unroll
            for (int nt = 0; nt < 4; ++nt) acc[mt][nt] = MFMA16(a[mt], bb[nt], acc[mt][nt]);
    }
    float* KVT = (float*)(ws + OFF_KVT) + (size_t)item * 8192;
#pragma unroll
    for (int mt = 0; mt < 2; ++mt)
#pragma unroll
        for (int nt = 0; nt < 4; ++nt)
#pragma unroll
            for (int r = 0; r < 4; ++r) KVT[(32 * wave + 16 * mt + 4 * fg + r) * 64 + 16 * nt + fr] = acc[mt][nt][r];
}

__device__ __forceinline__ void swa_item(const Params& p, int layer, int item, unsigned char* smem) {
    unsigned char* ws = ws_opaque(p.ws);
    u16* sK = (u16*)smem; u16* sVt = sK + 64 * 72;
    const u16* U = (const u16*)(ws + OFF_U); const u16* UT = (const u16*)(ws + OFF_UT); u16* ACT = (u16*)(ws + OFF_ACT);
    const int b = item >> 7, h = (item >> 5) & 3, qb = item & 31, kvh = h >> 1;
    const int t = tid_opaque();
    const int lane = t & 63, wave = t >> 6, q = lane & 15, g = lane >> 4;
    const int tq = qb * 64 + wave * 16 + q; const size_t tglob = (size_t)b * 2048 + tq;
    bf16x8 qf[2];
#pragma unroll
    for (int ks = 0; ks < 2; ++ks) qf[ks] = *(const bf16x8*)(U + tglob * LDU + 512 + h * 64 + 32 * ks + 8 * g);
    const float slope = exp2f(-(float)(h + 1)); const float sink = p.in[6][layer * 4 + h];
    f32x4 o[4];
#pragma unroll
    for (int dt = 0; dt < 4; ++dt) o[dt] = (f32x4){0.f, 0.f, 0.f, 0.f};
    float m = NEGBIG, l = 0.f;
    const int kt0 = qb >= 2 ? qb - 2 : 0;
    for (int kt = kt0; kt <= qb; ++kt) {
        GSYNC();
        stage_rows64(sK, U + ((size_t)b * 2048 + kt * 64) * LDU + 768 + kvh * 64, LDU);
        stage_rows64(sVt, UT + ((size_t)(b * 1024 + kvh * 64)) * 2048 + kt * 64, 2048);
        GSYNC();
        flash_step<4>(sK, sVt, 72, qf, o, m, l, true,
                      [&](int key, float s, bool& valid) { const int d = tq - (kt * 64 + key); valid = (d >= 0) && (d < 128); return s * 0.125f - slope * (float)d; }, lane);
    }
    float lt = l + __shfl_xor(l, 16); lt += __shfl_xor(lt, 32);
    const float m2 = fmaxf(m, sink), sc = __expf(m - m2), den = lt * sc + __expf(sink - m2), inv = sc / fmaxf(den, 1e-30f);
#pragma unroll
    for (int dt = 0; dt < 4; ++dt) *(uint2*)(ACT + tglob * LDACT + 256 + h * 64 + 16 * dt + 4 * g) = pack4(o[dt] * inv);
    GSYNC();
}

__device__ __forceinline__ void conv_item(const Params& p, int layer, int item, unsigned char* smem) {
    unsigned char* ws = ws_opaque(p.ws);
    u16* sh = (u16*)smem; float* sy = (float*)(smem + 62 * 256 * 2);
    const u16* U = (const u16*)(ws + OFF_U); u16* ACT = (u16*)(ws + OFF_ACT);
    const int b = item >> 6, s0 = (item & 63) * 32, t = tid_opaque();
    {
        const int rl = t >> 5, c8 = (t & 31) * 8;
#pragma unroll 1
        for (int pb = 0; pb < 8; pb += 4) {
            u32x4 av[4], gv[4];
#pragma unroll
            for (int ps = 0; ps < 4; ++ps) {
                const int r = (pb + ps) * 8 + rl, sp = s0 - 30 + r;
                av[ps] = (u32x4){0u, 0u, 0u, 0u}; gv[ps] = av[ps];
                if (r < 62 && sp >= 0) { const u16* row = U + ((size_t)b * 2048 + sp) * LDU; av[ps] = *(const u32x4*)(row + c8); gv[ps] = *(const u32x4*)(row + 256 + c8); }
            }
#pragma unroll
            for (int ps = 0; ps < 4; ++ps) {
                const int r = (pb + ps) * 8 + rl;
                if (r < 62) {
                    u32x4 hv;
                    hv.x = pack2(bflo(av[ps].x) * sigmoidf_(bflo(gv[ps].x)), bfhi(av[ps].x) * sigmoidf_(bfhi(gv[ps].x)));
                    hv.y = pack2(bflo(av[ps].y) * sigmoidf_(bflo(gv[ps].y)), bfhi(av[ps].y) * sigmoidf_(bfhi(gv[ps].y)));
                    hv.z = pack2(bflo(av[ps].z) * sigmoidf_(bflo(gv[ps].z)), bfhi(av[ps].z) * sigmoidf_(bfhi(gv[ps].z)));
                    hv.w = pack2(bflo(av[ps].w) * sigmoidf_(bflo(gv[ps].w)), bfhi(av[ps].w) * sigmoidf_(bfhi(gv[ps].w)));
                    *(u32x4*)&sh[r * 256 + c8] = hv;
                }
            }
        }
    }
    GSYNC();
    float w[31];
#pragma unroll
    for (int k = 0; k < 31; ++k) w[k] = p.in[2][(size_t)layer * 31 * 256 + k * 256 + t];
    const float db = p.in[3][layer * 256 + t];
#pragma unroll 1
    for (int tt = 0; tt < 32; ++tt) {
        float a = db;
#pragma unroll
        for (int k = 0; k < 31; ++k) a += bf2f(sh[(tt + k) * 256 + t]) * w[k];
        sy[tt * 256 + t] = a;
    }
    GSYNC();
    const int lane = t & 63, wave = t >> 6, c = lane * 4;
    const float4 gg = *(const float4*)(p.in[4] + layer * 256 + c), bb = *(const float4*)(p.in[5] + layer * 256 + c);
#pragma unroll
    for (int i = 0; i < 8; ++i) {
        const int tt = wave * 8 + i;
        const float4 v = *(const float4*)&sy[tt * 256 + c];
        float s = v.x + v.y + v.z + v.w;
#pragma unroll
        for (int o = 32; o >= 1; o >>= 1) s += __shfl_xor(s, o);
        const float mu = s * (1.f / 256.f);
        const float dx = v.x - mu, dy = v.y - mu, dz = v.z - mu, dw = v.w - mu;
        float q = dx * dx + dy * dy + dz * dz + dw * dw;
#pragma unroll
        for (int o = 32; o >= 1; o >>= 1) q += __shfl_xor(q, o);
        const float rstd = rsqrtf(q * (1.f / 256.f) + LN_EPS_F);
        f32x4 ov; ov[0] = siluf_(dx * rstd * gg.x + bb.x); ov[1] = siluf_(dy * rstd * gg.y + bb.y); ov[2] = siluf_(dz * rstd * gg.z + bb.z); ov[3] = siluf_(dw * rstd * gg.w + bb.w);
        *(uint2*)(ACT + ((size_t)b * 2048 + s0 + tt) * LDACT + c) = pack4(ov);
    }
    GSYNC();
}

#define FOR_ITEMS(j, base, n) for (int j = (int)((VBID + VGRID - ((base) % VGRID)) % VGRID); j < (n); j += VGRID)
__device__ __forceinline__ int p2a_first(int v, int base) {
    if (v < 64) return (v >= base) ? v : (1 << 30);
    int i = v;
    if (i < base) i += ((base - i + 447) / 448) * 448;
    return i;
}
#define FOR_ITEMS_P2A(j, base, n) for (int i_ = p2a_first(VBID, (base)), j = i_ - (base); j < (n); i_ = (VBID < 64 ? (1 << 30) : i_ + 448), j = i_ - (base))
__device__ __forceinline__ void p2a_phase(const Params& p, int layer, unsigned char* smem) {
    FOR_ITEMS(j, 0, 64) compress_item(p, j, smem);
    FOR_ITEMS_P2A(j, 0, 512) retkv_item(p, j);
    FOR_ITEMS_P2A(j, 512, 1024) swa_item(p, layer, j, smem);
    FOR_ITEMS_P2A(j, 1536, 512) conv_item(p, layer, j, smem);
}

__device__ __forceinline__ void retout_item(const Params& p, int layer, int item, unsigned char* smem) {
    unsigned char* ws = ws_opaque(p.ws);
    u16* sS = (u16*)smem; u16* sK = sS + 128 * 72; u16* sVt = sK + 64 * 72;
    const u16* U = (const u16*)(ws + OFF_U); const u16* UT = (const u16*)(ws + OFF_UT); u16* ACT = (u16*)(ws + OFF_ACT);
    const int bh = item & 31, n = 15 - (item >> 5), b = bh >> 2, h = bh & 3, t = tid_opaque();
    const float l2g = log2f(1.f - exp2f(-5.f - (float)h));
    {
        float as[32];
#pragma unroll
        for (int i = 0; i < 32; ++i) as[i] = 0.f;
#pragma unroll 4
        for (int mm = 0; mm < n; ++mm) {
            const float wgt = exp2f(128.f * (float)(n - 1 - mm) * l2g);
            const float4* src = (const float4*)((const float*)(ws + OFF_KVT) + (size_t)(bh * 16 + mm) * 8192 + t * 32);
#pragma unroll
            for (int i = 0; i < 8; ++i) { const float4 v = src[i]; as[4 * i] += wgt * v.x; as[4 * i + 1] += wgt * v.y; as[4 * i + 2] += wgt * v.z; as[4 * i + 3] += wgt * v.w; }
        }
        u16* dp = &sS[(t >> 1) * 72 + (t & 1) * 32];
#pragma unroll
        for (int i = 0; i < 4; ++i) *(uint4*)(dp + 8 * i) = make_uint4(pack2(as[8 * i], as[8 * i + 1]), pack2(as[8 * i + 2], as[8 * i + 3]), pack2(as[8 * i + 4], as[8 * i + 5]), pack2(as[8 * i + 6], as[8 * i + 7]));
    }
    GSYNC();
    const int lane = t & 63, wave = t >> 6, q = lane & 15, g = lane >> 4;
    bf16x8 qf[2][2]; f32x4 o[2][8];
#pragma unroll
    for (int qt = 0; qt < 2; ++qt) {
        const size_t tglob = (size_t)b * 2048 + n * 128 + 32 * wave + 16 * qt + q;
#pragma unroll
        for (int ks = 0; ks < 2; ++ks) qf[qt][ks] = *(const bf16x8*)(U + tglob * LDU + 896 + h * 64 + 32 * ks + 8 * g);
#pragma unroll
        for (int dt = 0; dt < 8; ++dt) {
            o[qt][dt] = (f32x4){0.f, 0.f, 0.f, 0.f};
#pragma unroll
            for (int ks = 0; ks < 2; ++ks) { const bf16x8 a = *(const bf16x8*)&sS[(16 * dt + q) * 72 + 32 * ks + 8 * g]; o[qt][dt] = MFMA16(a, qf[qt][ks], o[qt][dt]); }
        }
        const float xi = exp2f((float)(32 * wave + 16 * qt + q + 1) * l2g);
#pragma unroll
        for (int dt = 0; dt < 8; ++dt) o[qt][dt] *= xi;
    }
    for (int kt = 0; kt < 2; ++kt) {
        GSYNC();
        stage_rows64(sK, U + ((size_t)b * 2048 + n * 128 + kt * 64) * LDU + 1152 + h * 64, LDU);
        stage_rows64(sVt, UT + ((size_t)(b * 1024 + 384 + h * 128)) * 2048 + n * 128 + kt * 64, 2048);
        stage_rows64(sVt + 64 * 72, UT + ((size_t)(b * 1024 + 384 + h * 128 + 64)) * 2048 + n * 128 + kt * 64, 2048);
        GSYNC();
#pragma unroll
        for (int qt = 0; qt < 2; ++qt) {
            if (kt * 64 > 32 * wave + 16 * qt + 15) continue;
            const int tql = 32 * wave + 16 * qt + q;
            f32x4 s[4]; qk64(sK, qf[qt], s, lane);
            float x[16];
#pragma unroll
            for (int mt = 0; mt < 4; ++mt)
#pragma unroll
                for (int rr = 0; rr < 4; ++rr) { const int d = tql - (kt * 64 + 16 * mt + 4 * g + rr); x[mt * 4 + rr] = (d >= 0) ? s[mt][rr] * 0.125f * __builtin_amdgcn_exp2f((float)d * l2g) : 0.f; }
            bf16x8 pb[2]; pack_p(x, pb);
            pv64<8>(sVt, 72, pb, o[qt], lane);
        }
    }
#pragma unroll
    for (int qt = 0; qt < 2; ++qt) {
        const size_t tglob = (size_t)b * 2048 + n * 128 + 32 * wave + 16 * qt + q;
        float s = 0.f;
#pragma unroll
        for (int dt = 0; dt < 8; ++dt) s += o[qt][dt][0] + o[qt][dt][1] + o[qt][dt][2] + o[qt][dt][3];
        s += __shfl_xor(s, 16); s += __shfl_xor(s, 32);
        const float mu = s * (1.f / 128.f);
        float v = 0.f;
#pragma unroll
        for (int dt = 0; dt < 8; ++dt)
#pragma unroll
            for (int r = 0; r < 4; ++r) { const float d = o[qt][dt][r] - mu; v += d * d; }
        v += __shfl_xor(v, 16); v += __shfl_xor(v, 32);
        const float rstd = rsqrtf(v * (1.f / 128.f) + LN_EPS_F);
#pragma unroll
        for (int dt = 0; dt < 8; ++dt) {
            const int c = h * 128 + 16 * dt + 4 * g;
            const float4 gn = *(const float4*)(p.in[7] + layer * 512 + c), gb = *(const float4*)(p.in[8] + layer * 512 + c);
            const uint2 gv = *(const uint2*)(U + tglob * LDU + 1408 + c);
            f32x4 ov;
            ov[0] = ((o[qt][dt][0] - mu) * rstd * gn.x + gb.x) * siluf_(bflo(gv.x));
            ov[1] = ((o[qt][dt][1] - mu) * rstd * gn.y + gb.y) * siluf_(bfhi(gv.x));
            ov[2] = ((o[qt][dt][2] - mu) * rstd * gn.z + gb.z) * siluf_(bflo(gv.y));
            ov[3] = ((o[qt][dt][3] - mu) * rstd * gn.w + gb.w) * siluf_(bfhi(gv.y));
            *(uint2*)(ACT + tglob * LDACT + 512 + c) = pack4(ov);
        }
    }
    GSYNC();
}

__device__ __forceinline__ void nsa_item(const Params& p, int item, unsigned char* smem) {
    unsigned char* ws = ws_opaque(p.ws);
    u16* sKc = (u16*)smem;
    u16* sVc = sKc + 128 * 72;
    float* impL = (float*)(smem + 36864);
    unsigned* qmask = (unsigned*)(smem + 36864 + 8192);
    unsigned* wgor = qmask + 16;
    const u16* U = (const u16*)(ws + OFF_U); const u16* UT = (const u16*)(ws + OFF_UT); u16* ACT = (u16*)(ws + OFF_ACT);
    const int b = item & 7, tq16 = (item < 512) ? 127 - (item >> 3) : ((item - 512) >> 3);
    const int t = tid_opaque();
    const int lane = t & 63, h = t >> 6, q = lane & 15, g = lane >> 4;
    const int tq = tq16 * 16 + q, cur = tq16 >> 2; const size_t tglob = (size_t)b * 2048 + tq;
    GSYNC();
    {
        const u16* kc = (const u16*)(ws + OFF_KCMP) + (size_t)b * 128 * 64;
        stage_rows64(sKc, kc, 64); stage_rows64(sKc + 64 * 72, kc + 64 * 64, 64);
        const u16* vc = (const u16*)(ws + OFF_VCMPT) + (size_t)b * 64 * 128;
        const int r = t >> 2, c = (t & 3) * 32;
        const uint4* src = (const uint4*)(vc + (size_t)r * 128 + c);
#pragma unroll
        for (int i = 0; i < 4; ++i) *(uint4*)&sVc[r * 136 + c + 8 * i] = src[i];
        if (t == 0) *wgor = 0u;
    }
    GSYNC();
    const float slope = exp2f(-(float)(h + 5));
    bf16x8 qh[2];
    {
        const u16* qrow = U + tglob * LDU + 1920 + h * 64 + 8 * g;
        qh[0] = *(const bf16x8*)(qrow); qh[1] = *(const bf16x8*)(qrow + 32);
    }
    {
        f32x4 s0[4], s1[4]; qk64(sKc, qh, s0, lane); qk64(sKc + 64 * 72, qh, s1, lane);
        float x[32]; float mx = NEGBIG;
#pragma unroll
        for (int mt = 0; mt < 4; ++mt)
#pragma unroll
            for (int rr = 0; rr < 4; ++rr) {
                const int c0 = 16 * mt + 4 * g + rr, c1 = 64 + c0;
                const int d0 = tq - (16 * c0 + 31), d1 = tq - (16 * c1 + 31);
                const float v0 = d0 >= 0 ? s0[mt][rr] * 0.125f - slope * (float)d0 : NEGBIG;
                const float v1 = d1 >= 0 ? s1[mt][rr] * 0.125f - slope * (float)d1 : NEGBIG;
                x[mt * 4 + rr] = v0; x[16 + mt * 4 + rr] = v1; mx = fmaxf(mx, fmaxf(v0, v1));
            }
        mx = fmaxf(mx, __shfl_xor(mx, 16)); mx = fmaxf(mx, __shfl_xor(mx, 32));
        float ps = 0.f;
#pragma unroll
        for (int i = 0; i < 32; ++i) { const float pv = (x[i] > -1e29f) ? __builtin_amdgcn_exp2f((x[i] - mx) * 1.44269504089f) : 0.f; x[i] = pv; ps += pv; }
        ps += __shfl_xor(ps, 16); ps += __shfl_xor(ps, 32);
        const float inv = 1.f / fmaxf(ps, 1e-30f);
        float* myimp = impL + (h * 16 + q) * 32;
#pragma unroll
        for (int tm = 0; tm < 8; ++tm) myimp[4 * tm + g] = (x[tm * 4] + x[tm * 4 + 1] + x[tm * 4 + 2] + x[tm * 4 + 3]) * inv;
        GSYNC();
#pragma unroll
        for (int tm = 0; tm < 8; ++tm) { const int j1 = 4 * tm + g + 1; if (j1 < 32) myimp[j1] += x[tm * 4 + 3] * inv; }
        GSYNC();
    }
    if (h == 0 && g == 0) {
        float* v0 = impL + q * 32;
        for (int j = 0; j < 32; ++j) {
            float v = v0[j] + v0[512 + j] + v0[1024 + j] + v0[1536 + j];
            if (j == 0 || j == cur || j == cur - 1) v = 1e4f; else if (j > cur) v = -1.f;
            v0[j] = v;
        }
        unsigned mask = 0u;
        for (int nsel = 0; nsel < 8; ++nsel) {
            float best = -3e38f; int bj = 0;
            for (int j = 0; j < 32; ++j) { const float v = v0[j]; if (!((mask >> j) & 1u) && v > best) { best = v; bj = j; } }
            mask |= 1u << bj;
        }
        qmask[q] = mask;
        atomicOr(wgor, mask);
    }
    GSYNC();
    const unsigned mymask = qmask[q];
    const unsigned allmask = *wgor;
    const u16* grow = U + tglob * LDU + 2432;
    const float g0 = sigmoidf_(bf2f(grow[h])), g1 = sigmoidf_(bf2f(grow[4 + h])), g2 = sigmoidf_(bf2f(grow[8 + h]));
    f32x4 otot[4];
    {
        f32x4 o[4];
#pragma unroll
        for (int dt = 0; dt < 4; ++dt) o[dt] = (f32x4){0.f, 0.f, 0.f, 0.f};
        float m = NEGBIG, l = 0.f;
#pragma unroll
        for (int tile = 0; tile < 2; ++tile)
            flash_step<4>(sKc + tile * 64 * 72, sVc + tile * 64, 136, qh, o, m, l, true,
                          [&](int key, float sv, bool& valid) { const int d = tq - (16 * (tile * 64 + key) + 31); valid = d >= 0; return sv * 0.125f - slope * (float)d; }, lane);
        float lt = l + __shfl_xor(l, 16); lt += __shfl_xor(lt, 32);
        const float sc = g0 / fmaxf(lt, 1e-30f);
#pragma unroll
        for (int dt = 0; dt < 4; ++dt) otot[dt] = o[dt] * sc;
    }
    GSYNC();
    const int sr = t >> 2, scol = (t & 3) * 16;
#pragma unroll
    for (int br = 0; br < 2; ++br) {
        const int kcol = br ? 2368 : 2304, vrow = br ? 960 : 896;
        const int kt0 = cur >= 8 ? cur - 8 : 0;
        unsigned tiles = br ? ((0xffffffffu >> (31 - cur)) & ~((1u << kt0) - 1u)) : (allmask & (0xffffffffu >> (31 - cur)));
        f32x4 o[4];
#pragma unroll
        for (int dt = 0; dt < 4; ++dt) o[dt] = (f32x4){0.f, 0.f, 0.f, 0.f};
        float m = NEGBIG, l = 0.f;
        u32x4 rk0, rk1, rv0, rv1;
        int j = -1, bufi = 0;
        if (tiles) {
            j = __builtin_ctz(tiles); tiles &= tiles - 1u;
            const u16* kp = U + ((size_t)b * 2048 + j * 64 + sr) * LDU + kcol + scol; const u16* vp = UT + ((size_t)(b * 1024 + vrow + sr)) * 2048 + j * 64 + scol;
            rk0 = *(const u32x4*)kp; rk1 = *(const u32x4*)(kp + 8); rv0 = *(const u32x4*)vp; rv1 = *(const u32x4*)(vp + 8);
        }
        while (j >= 0) {
            u16* bK = sKc + bufi * (2 * 64 * 72); u16* bV = bK + 64 * 72;
            *(u32x4*)&bK[sr * 72 + scol] = rk0; *(u32x4*)&bK[sr * 72 + scol + 8] = rk1;
            *(u32x4*)&bV[sr * 72 + scol] = rv0; *(u32x4*)&bV[sr * 72 + scol + 8] = rv1;
            GSYNC();
            int jn = -1;
            if (tiles) {
                jn = __builtin_ctz(tiles); tiles &= tiles - 1u;
                const u16* kp = U + ((size_t)b * 2048 + jn * 64 + sr) * LDU + kcol + scol; const u16* vp = UT + ((size_t)(b * 1024 + vrow + sr)) * 2048 + jn * 64 + scol;
                rk0 = *(const u32x4*)kp; rk1 = *(const u32x4*)(kp + 8); rv0 = *(const u32x4*)vp; rv1 = *(const u32x4*)(vp + 8);
            }
            if (br == 0)
                flash_step<4>(bK, bV, 72, qh, o, m, l, ((mymask >> j) & 1u) != 0u,
                              [&](int key, float sv, bool& valid) { const int d = tq - (j * 64 + key); valid = d >= 0; return sv * 0.125f - slope * (float)d; }, lane);
            else
                flash_step<4>(bK, bV, 72, qh, o, m, l, true,
                              [&](int key, float sv, bool& valid) { const int d = tq - (j * 64 + key); valid = (d >= 0) && (d < 512); return sv * 0.125f - slope * (float)d; }, lane);
            j = jn; bufi ^= 1;
        }
        float lt = l + __shfl_xor(l, 16); lt += __shfl_xor(lt, 32);
        const float sc = (br ? g2 : g1) / fmaxf(lt, 1e-30f);
#pragma unroll
        for (int dt = 0; dt < 4; ++dt) otot[dt] += o[dt] * sc;
        GSYNC();
    }
#pragma unroll
    for (int dt = 0; dt < 4; ++dt) *(uint2*)(ACT + tglob * LDACT + 1024 + h * 64 + 16 * dt + 4 * g) = pack4(otot[dt]);
}

__device__ __forceinline__ void p2b_phase(const Params& p, int layer, unsigned char* smem) {
    PB(50); FOR_ITEMS(j, 0, 1024) nsa_item(p, j, smem); PE(50);
    PB(51); FOR_ITEMS(j, 1024, 512) retout_item(p, layer, j, smem); PE(51);
}

__device__ __forceinline__ void merge_phase(const Params& p, unsigned char* smem) {
    unsigned char* ws = ws_opaque(p.ws);
    const u16* XB = (const u16*)(ws + OFF_XB); const u16* WINT = (const u16*)(ws + OFF_WINT); const u16* PT = (const u16*)(ws + OFF_PT);
    const u16* ACT = (const u16*)(ws + OFF_ACT); u16* MERGED = (u16*)(ws + OFF_MERGED);
    FULL_LANE_VARS
    const int xcd = blockIdx.x & 7, loc = blockIdx.x >> 3, nloc = gridDim.x >> 3;
    G8W<4, 4> g;
    auto setup = [&](int l, int sg) {
        const int ct = l >> 3, tt = xcd * 8 + (l & 7), br = sg >> 1;
        if ((sg & 1) == 0) {
            auto rowWg = [=](int r) { return WINT + (size_t)(3584 + br * 1024 + ct * 128 + r) * 1024; };
            auto rowX = [=](int r) { return XB + (size_t)(tt * 256 + r) * 1024; };
            g8w_setup<4, 4>(g, rowWg, rowX);
        } else {
            const int Kb = (br == 2) ? 512 : 256;
            const size_t poff = (br == 0) ? 0 : (br == 1) ? 262144 : (br == 2) ? 524288 : 1048576;
            const int aoff = (br == 0) ? 0 : (br == 1) ? 256 : (br == 2) ? 512 : 1024;
            auto rowP = [=](int r) { return PT + poff + (size_t)(ct * 128 + r) * Kb; };
            auto rowAct = [=](int r) { return ACT + (size_t)(tt * 256 + r) * LDACT + aoff; };
            g8w_setup<4, 4>(g, rowP, rowAct);
        }
    };
    __syncthreads();
    if (loc < 64) { setup(loc, 0); g8w_prefetch<4, 4>(g, 1024); }
    for (int l = loc; l < 8 * 8; l += nloc) {
        const int ct = l >> 3, tt = xcd * 8 + (l & 7);
        uint2 mpk[4][4];
#pragma unroll
        for (int i = 0; i < 4; ++i)
#pragma unroll
            for (int j = 0; j < 4; ++j) mpk[i][j] = make_uint2(0u, 0u);
#pragma unroll 1
        for (int br = 0; br < 4; ++br) {
            const int Kb = (br == 2) ? 512 : 256;
            uint2 gpk[4][4];
            {
                f32x4 accg[4][4]; zero_acc<4, 4>(accg);
                g8w_run<4, 4>(g, accg, 1024);
                setup(l, 2 * br + 1); g8w_prefetch<4, 4>(g, Kb);
#pragma unroll
                for (int i = 0; i < 4; ++i)
#pragma unroll
                    for (int j = 0; j < 4; ++j) {
                        f32x4 gg;
#pragma unroll
                        for (int r = 0; r < 4; ++r) gg[r] = sigmoidf_(accg[i][j][r]);
                        gpk[i][j] = pack4(gg);
                    }
            }
            f32x4 accy[4][4]; zero_acc<4, 4>(accy);
            g8w_run<4, 4>(g, accy, Kb);
            if (br < 3) { setup(l, 2 * br + 2); g8w_prefetch<4, 4>(g, 1024); }
            else if (l + nloc < 64) { setup(l + nloc, 0); g8w_prefetch<4, 4>(g, 1024); }
#pragma unroll
            for (int i = 0; i < 4; ++i)
#pragma unroll
                for (int j = 0; j < 4; ++j) {
                    const uint2 gq = gpk[i][j]; const uint2 mm = mpk[i][j];
                    f32x4 v;
                    v[0] = bflo(mm.x) + bflo(gq.x) * accy[i][j][0]; v[1] = bfhi(mm.x) + bfhi(gq.x) * accy[i][j][1];
                    v[2] = bflo(mm.y) + bflo(gq.y) * accy[i][j][2]; v[3] = bfhi(mm.y) + bfhi(gq.y) * accy[i][j][3];
                    mpk[i][j] = pack4(v);
                }
        }
        g8_store_rows<4, 4>(mpk, [&](int mloc, int n, u32x4 v) {
            *(u32x4*)(MERGED + ((size_t)tt * 256 + n) * 1024 + ct * 128 + mloc) = v;
        }, 98304);
    }
}

__device__ __forceinline__ u32x4 add_alpha_x(u32x4 v, u32x4 x) {
    u32x4 o;
    o.x = pack2(bflo(v.x) + ALPHA_F * bflo(x.x), bfhi(v.x) + ALPHA_F * bfhi(x.x)); o.y = pack2(bflo(v.y) + ALPHA_F * bflo(x.y), bfhi(v.y) + ALPHA_F * bfhi(x.y));
    o.z = pack2(bflo(v.z) + ALPHA_F * bflo(x.z), bfhi(v.z) + ALPHA_F * bfhi(x.z)); o.w = pack2(bflo(v.w) + ALPHA_F * bflo(x.w), bfhi(v.w) + ALPHA_F * bfhi(x.w));
    return o;
}
__device__ __forceinline__ void wout_phase(const Params& p, unsigned char* smem) {
    unsigned char* ws = ws_opaque(p.ws);
    const u16* XB = (const u16*)(ws + OFF_XB); const u16* WOUT = (const u16*)(ws + OFF_WOUT); const u16* MERGED = (const u16*)(ws + OFF_MERGED);
    u16* Z = (u16*)(ws + OFF_Z);
    FULL_LANE_VARS
    const int xcd = blockIdx.x & 7, loc = blockIdx.x >> 3, nloc = gridDim.x >> 3;
    G8<8, 4> g;
    auto setup = [&](int l) {
        const int ct = l >> 3, tt = xcd * 8 + (l & 7);
        auto rowW = [=](int r) { return WOUT + (size_t)(ct * 256 + r) * 1024; };
        auto rowM = [=](int r) { return MERGED + (size_t)(tt * 256 + r) * 1024; };
        g8_setup<8, 4>(g, rowW, rowM);
    };
    __syncthreads();
    if (loc < 32) { setup(loc); g8_prefetch<8, 4>(g, 1024); }
    for (int l = loc; l < 8 * 4; l += nloc) {
        const int ct = l >> 3, tt = xcd * 8 + (l & 7);
        f32x4 acc[8][4]; zero_acc<8, 4>(acc);
        g8_run<8, 4>(g, acc, 1024);
        if (l + nloc < 32) { setup(l + nloc); g8_prefetch<8, 4>(g, 1024); }
        uint2 pk[8][4];
#pragma unroll
        for (int i = 0; i < 8; ++i)
#pragma unroll
            for (int j = 0; j < 4; ++j) pk[i][j] = pack4(acc[i][j]);
        g8_store_rows<8, 4>(pk, [&](int mloc, int n, u32x4 v) {
            const size_t o = ((size_t)tt * 256 + n) * 1024 + ct * 256 + mloc;
            *(u32x4*)(Z + o) = add_alpha_x(v, *(const u32x4*)(XB + o));
        });
    }
}

__device__ __forceinline__ void ln_row16(float (&v)[16], const float* gam, const float* bet, int lane) {
    float s = 0.f;
#pragma unroll
    for (int i = 0; i < 16; ++i) s += v[i];
#pragma unroll
    for (int o = 32; o >= 1; o >>= 1) s += __shfl_xor(s, o);
    const float mu = s * (1.f / 1024.f);
    float q = 0.f;
#pragma unroll
    for (int i = 0; i < 16; ++i) { v[i] -= mu; q += v[i] * v[i]; }
#pragma unroll
    for (int o = 32; o >= 1; o >>= 1) q += __shfl_xor(q, o);
    const float rstd = rsqrtf(q * (1.f / 1024.f) + LN_EPS_F);
#pragma unroll
    for (int hh = 0; hh < 2; ++hh) {
        const int c = hh * 512 + lane * 8;
        const float4 g0 = *(const float4*)(gam + c), g1 = *(const float4*)(gam + c + 4), b0 = *(const float4*)(bet + c), b1 = *(const float4*)(bet + c + 4);
        v[8 * hh + 0] = v[8 * hh + 0] * rstd * g0.x + b0.x; v[8 * hh + 1] = v[8 * hh + 1] * rstd * g0.y + b0.y;
        v[8 * hh + 2] = v[8 * hh + 2] * rstd * g0.z + b0.z; v[8 * hh + 3] = v[8 * hh + 3] * rstd * g0.w + b0.w;
        v[8 * hh + 4] = v[8 * hh + 4] * rstd * g1.x + b1.x; v[8 * hh + 5] = v[8 * hh + 5] * rstd * g1.y + b1.y;
        v[8 * hh + 6] = v[8 * hh + 6] * rstd * g1.z + b1.z; v[8 * hh + 7] = v[8 * hh + 7] * rstd * g1.w + b1.w;
    }
}
__device__ __forceinline__ void unpack8(const uint4 w, float* v) {
    v[0] = bflo(w.x); v[1] = bfhi(w.x); v[2] = bflo(w.y); v[3] = bfhi(w.y); v[4] = bflo(w.z); v[5] = bfhi(w.z); v[6] = bflo(w.w); v[7] = bfhi(w.w);
}

__device__ __forceinline__ void router_phase(const Params& p, int layer, unsigned char* smem) {
    unsigned char* ws = ws_opaque(p.ws);
    float* L = (float*)(smem + 40960);
    const u16* Z = (const u16*)(ws + OFF_Z); u16* XB = (u16*)(ws + OFF_XB); const u16* RW = (const u16*)(ws + OFF_RW);
    unsigned* cnt = (unsigned*)(ws + OFF_CNT); unsigned* LIST = (unsigned*)(ws + OFF_LIST); float* GATEW = (float*)(ws + OFF_GATEW);
    const float* gam = p.in[20] + layer * 1024; const float* bet = p.in[21] + layer * 1024; const float* rbias = p.in[23] + layer * 64;
    for (int it = VBID; it < 512; it += VGRID) {
        const int t = tid_opaque(), lane = t & 63, wave = t >> 6, wm = wave >> 1, wn = wave & 1, fr = lane & 15, fg = lane >> 4;
#pragma unroll 2
        for (int i = 0; i < 8; ++i) {
            const size_t row = (size_t)it * 32 + wave * 8 + i;
            float v[16];
            unpack8(*(const uint4*)(Z + row * 1024 + lane * 8), v); unpack8(*(const uint4*)(Z + row * 1024 + 512 + lane * 8), v + 8);
            ln_row16(v, gam, bet, lane);
            *(uint4*)(XB + row * 1024 + lane * 8) = make_uint4(pack2(v[0], v[1]), pack2(v[2], v[3]), pack2(v[4], v[5]), pack2(v[6], v[7]));
            *(uint4*)(XB + row * 1024 + 512 + lane * 8) = make_uint4(pack2(v[8], v[9]), pack2(v[10], v[11]), pack2(v[12], v[13]), pack2(v[14], v[15]));
        }
        __threadfence_block();
        GSYNC();
        f32x4 acc[2][1]; zero_acc<2, 1>(acc);
        auto rowR = [=](int r) { return RW + (size_t)r * 1024; };
        auto rowX = [=](int r) { return (const u16*)XB + ((size_t)it * 32 + r) * 1024; };
        gemm_acc<2, 1>(acc, rowR, rowX, 1024, smem);
#pragma unroll
        for (int i = 0; i < 2; ++i)
#pragma unroll
            for (int r = 0; r < 4; ++r) L[(wn * 16 + fr) * 65 + wm * 32 + 16 * i + 4 * fg + r] = acc[i][0][r];
        GSYNC();
        {
            const int tokl = t >> 3, grp = t & 7;
            const float* Lr = L + tokl * 65 + grp * 8;
            float sc[8], bs[8];
#pragma unroll
            for (int k = 0; k < 8; ++k) { sc[k] = sigmoidf_(Lr[k]); bs[k] = sc[k] + rbias[grp * 8 + k]; }
            float m1 = -3e38f, m2 = -3e38f;
#pragma unroll
            for (int k = 0; k < 8; ++k) { const float v = bs[k]; if (v > m1) { m2 = m1; m1 = v; } else if (v > m2) m2 = v; }
            const float gsum = m1 + m2;
            float gs[8];
#pragma unroll
            for (int g2 = 0; g2 < 8; ++g2) gs[g2] = __shfl(gsum, (lane & ~7) | g2);
            unsigned gmask = 0u;
#pragma unroll
            for (int nsel = 0; nsel < 4; ++nsel) {
                float best = -3e38f; int bi = 0;
#pragma unroll
                for (int g2 = 0; g2 < 8; ++g2) if (!((gmask >> g2) & 1u) && gs[g2] > best) { best = gs[g2]; bi = g2; }
                gmask |= 1u << bi;
            }
            const bool gsel = (gmask >> grp) & 1u;
            unsigned chosen = 0u; int eidx[6]; float sraw[6]; float ssum = 0.f;
#pragma unroll
            for (int rnd = 0; rnd < 6; ++rnd) {
                float bv = -3e38f, bsr = 0.f; int be = 64;
#pragma unroll
                for (int k = 0; k < 8; ++k) if (gsel && !((chosen >> k) & 1u) && bs[k] > bv) { bv = bs[k]; bsr = sc[k]; be = grp * 8 + k; }
#pragma unroll
                for (int o = 1; o < 8; o <<= 1) {
                    const float ov = __shfl_xor(bv, o), osr = __shfl_xor(bsr, o); const int oe = __shfl_xor(be, o);
                    if (ov > bv || (ov == bv && oe < be)) { bv = ov; bsr = osr; be = oe; }
                }
                if ((be >> 3) == grp) chosen |= 1u << (be & 7);
                eidx[rnd] = be; sraw[rnd] = bsr; ssum += bsr;
            }
            const unsigned tok = (unsigned)(it * 32 + tokl);
            unsigned* lcnt = (unsigned*)(smem + 24576);
            if (t < 64) lcnt[t] = 0u;
            GSYNC();
            int mye = 0; float myg = 0.f; unsigned lpos = 0u;
#pragma unroll
            for (int rnd = 0; rnd < 6; ++rnd) if (grp == rnd) { mye = eidx[rnd]; myg = sraw[rnd] / ssum * 2.5f; }
            if (grp < 6) lpos = atomicAdd(&lcnt[mye], 1u);
            GSYNC();
            if (t < 64) { const unsigned c = lcnt[t]; lcnt[64 + t] = c ? atomicAdd(&cnt[t * 32], c) : 0u; }
            GSYNC();
            if (grp < 6) {
                LIST[(size_t)mye * 16384 + lcnt[64 + mye] + lpos] = tok * 8u + (unsigned)grp;
                GATEW[tok * 8u + grp] = myg;
            }
        }
        GSYNC();
    }
}

__device__ __forceinline__ void moe_prefix(const Params& p, int* pre) {
    __syncthreads();
    if (threadIdx.x == 0) {
        const unsigned* cnt = (const unsigned*)(ws_opaque(p.ws) + OFF_CNT);
        int a = 0;
        for (int e = 0; e < 64; ++e) { pre[e] = a; a += (int)((cnt[e * 32] + 255u) >> 8); }
        pre[64] = a; a += 64; pre[65] = a;
    }
    __syncthreads();
}

__device__ __forceinline__ void moe_up_phase(const Params& p, unsigned char* smem) {
    unsigned char* ws = ws_opaque(p.ws);
    int* pre = (int*)(g_smem + SMEM_PRE_OFF);
    const u16* XB = (const u16*)(ws + OFF_XB); const u16* WUP = (const u16*)(ws + OFF_WUP); u16* H = (u16*)(ws + OFF_H);
    const unsigned* cnt = (const unsigned*)(ws + OFF_CNT); const unsigned* LIST = (const unsigned*)(ws + OFF_LIST);
    FULL_LANE_VARS
    moe_prefix(p, pre);
    const int total = pre[65] * 2;
    G8<8, 4> g;
    auto setup = [&](int it) {
        const int bi = it >> 1, nt = it & 1;
        int e = 0; while (pre[e + 1] <= bi) ++e;
        const int rb = bi - pre[e]; const int ce = (e < 64) ? (int)cnt[e * 32] : T_TOK;
        auto rowW = [=](int r) { return WUP + ((size_t)e * 512 + nt * 256 + r) * 1024; };
        auto rowX = [=](int r) {
            const int idx = rb * 256 + r; unsigned tok = 0u;
            if (idx < ce) tok = (e < 64) ? (LIST[(size_t)e * 16384 + idx] >> 3) : (unsigned)idx;
            return XB + (size_t)tok * 1024;
        };
        g8_setup<8, 4>(g, rowW, rowX);
    };
    if ((int)blockIdx.x < total) { setup(blockIdx.x); g8_prefetch<8, 4>(g, 1024); }
    for (int it = blockIdx.x; it < total; it += gridDim.x) {
        const int bi = it >> 1, nt = it & 1;
        f32x4 acc[8][4]; zero_acc<8, 4>(acc);
        g8_run<8, 4>(g, acc, 1024);
        if (it + (int)gridDim.x < total) { setup(it + gridDim.x); g8_prefetch<8, 4>(g, 1024); }
        uint2 pk[4][4];
#pragma unroll
        for (int i = 0; i < 4; ++i)
#pragma unroll
            for (int j = 0; j < 4; ++j) {
                f32x4 v;
#pragma unroll
                for (int r = 0; r < 4; ++r) v[r] = siluf_(acc[2 * i][j][r]) * acc[2 * i + 1][j][r];
                pk[i][j] = pack4(v);
            }
        const size_t hrow0 = (size_t)bi * 256;
        g8_store_rows<4, 4>(pk, [&](int mloc, int n, u32x4 v) {
            *(u32x4*)(H + (hrow0 + n) * 256 + nt * 128 + mloc) = v;
        });
    }
}

__device__ __forceinline__ void moe_down_phase(const Params& p, unsigned char* smem) {
    unsigned char* ws = ws_opaque(p.ws);
    int* pre = (int*)(g_smem + SMEM_PRE_OFF);
    const u16* XB = (const u16*)(ws + OFF_XB); const u16* WD = (const u16*)(ws + OFF_WD); const u16* H = (const u16*)(ws + OFF_H);
    u16* Z = (u16*)(ws + OFF_Z); u16* YS = (u16*)(ws + OFF_YSLOT);
    const unsigned* cnt = (const unsigned*)(ws + OFF_CNT); const unsigned* LIST = (const unsigned*)(ws + OFF_LIST); const float* GATEW = (const float*)(ws + OFF_GATEW);
    FULL_LANE_VARS
    moe_prefix(p, pre);
    const int total = pre[65] * 4;
    G8<8, 4> g;
    auto setup = [&](int it) {
        const int bi = it >> 2, nt = it & 3;
        int e = 0; while (pre[e + 1] <= bi) ++e;
        auto rowW = [=](int r) { return WD + ((size_t)e * 1024 + nt * 256 + r) * 256; };
        auto rowH = [=](int r) { return H + ((size_t)bi * 256 + r) * 256; };
        g8_setup<8, 4>(g, rowW, rowH);
    };
    if ((int)blockIdx.x < total) { setup(blockIdx.x); g8_prefetch<8, 4>(g, 256); }
    for (int it = blockIdx.x; it < total; it += gridDim.x) {
        const int bi = it >> 2, nt = it & 3;
        int e = 0; while (pre[e + 1] <= bi) ++e;
        const int rb = bi - pre[e]; const int ce = (e < 64) ? (int)cnt[e * 32] : T_TOK;
        int2* rowinfo = (int2*)(g_smem + SMEM_ROWINFO_OFF) + (((it - (int)blockIdx.x) / (int)gridDim.x) & 1) * 256;
        if (t_ < 256) {
            const int idx = rb * 256 + t_; int dst = -1; float gw = 1.f;
            if (idx < ce) {
                if (e < 64) { const unsigned ent = LIST[(size_t)e * 16384 + idx]; dst = (int)((ent >> 3) * 6u + (ent & 7u)); gw = GATEW[ent]; }
                else dst = idx;
            }
            rowinfo[t_] = make_int2(dst, __float_as_int(gw));
        }
        f32x4 acc[8][4]; zero_acc<8, 4>(acc);
        PB(40); g8_run<8, 4>(g, acc, 256); PE(40);
        PB(42); if (it + (int)gridDim.x < total) { setup(it + gridDim.x); g8_prefetch<8, 4>(g, 256); } PE(42);
        PB(41);
        uint2 pk[8][4];
#pragma unroll
        for (int j = 0; j < 4; ++j) {
            const float gw = __int_as_float(rowinfo[wc * 64 + 16 * j + fr].y);
#pragma unroll
            for (int i = 0; i < 8; ++i) pk[i][j] = pack4(acc[i][j] * gw);
        }
        g8_store_rows<8, 4>(pk, [&](int mloc, int n, u32x4 v) {
            const int dst = rowinfo[n].x;
            if (dst >= 0) {
                const size_t o = (size_t)dst * 1024 + nt * 256 + mloc;
                if (e < 64) *(u32x4*)(YS + o) = v;
                else *(u32x4*)(Z + o) = add_alpha_x(v, *(const u32x4*)(XB + o));
            }
        });
        PE(41);
    }
}

__device__ __forceinline__ void combine_phase(const Params& p, int layer) {
    unsigned char* ws = ws_opaque(p.ws);
    const u16* Z = (const u16*)(ws + OFF_Z); const u16* YS = (const u16*)(ws + OFF_YSLOT); u16* XB = (u16*)(ws + OFF_XB);
    const float* gam = p.in[30] + layer * 1024; const float* bet = p.in[31] + layer * 1024;
    const int t = tid_opaque(), lane = t & 63, wave = t >> 6;
    for (int it = VBID; it < 512; it += VGRID) {
        for (int i = 0; i < 8; ++i) {
            const size_t row = (size_t)it * 32 + wave * 8 + i;
            float v[16];
            unpack8(*(const uint4*)(Z + row * 1024 + lane * 8), v); unpack8(*(const uint4*)(Z + row * 1024 + 512 + lane * 8), v + 8);
#pragma unroll
            for (int k = 0; k < 6; ++k) {
                float y[16];
                unpack8(*(const uint4*)(YS + (row * 6 + k) * 1024 + lane * 8), y); unpack8(*(const uint4*)(YS + (row * 6 + k) * 1024 + 512 + lane * 8), y + 8);
#pragma unroll
                for (int c = 0; c < 16; ++c) v[c] += y[c];
            }
            ln_row16(v, gam, bet, lane);
            *(uint4*)(XB + row * 1024 + lane * 8) = make_uint4(pack2(v[0], v[1]), pack2(v[2], v[3]), pack2(v[4], v[5]), pack2(v[6], v[7]));
            *(uint4*)(XB + row * 1024 + 512 + lane * 8) = make_uint4(pack2(v[8], v[9]), pack2(v[10], v[11]), pack2(v[12], v[13]), pack2(v[14], v[15]));
            if (layer == 1) {
                float* op = p.out + row * 1024;
                *(float4*)(op + lane * 8) = make_float4(v[0], v[1], v[2], v[3]); *(float4*)(op + lane * 8 + 4) = make_float4(v[4], v[5], v[6], v[7]);
                *(float4*)(op + 512 + lane * 8) = make_float4(v[8], v[9], v[10], v[11]); *(float4*)(op + 512 + lane * 8 + 4) = make_float4(v[12], v[13], v[14], v[15]);
            }
        }
    }
}

__device__ __forceinline__ void run_phase(const Params& p, int ph, int layer, unsigned char* smem) {
    switch (ph) {
        case 0: prep_phase(p, layer, layer == 0, smem); break;
        case 1: inproj_phase(p, layer, smem); break;
        case 2: p2a_phase(p, layer, smem); break;
        case 3: p2b_phase(p, layer, smem); break;
        case 4: merge_phase(p, smem); break;
        case 5: wout_phase(p, smem); break;
        case 6: router_phase(p, layer, smem); break;
        case 7: moe_up_phase(p, smem); break;
        case 8: moe_down_phase(p, smem); break;
        default: combine_phase(p, layer); if (layer == 0) prep_phase(p, 1, false, smem); break;
    }
}


#define XB_TMO      128
#define XB_XCNT(j)  (256  + 64 * (j))
#define XB_XSUB(j)  (1280 + 64 * (j))
#define XB_XGEN(j)  (2304 + 64 * (j))
#define XB_TOP      3328
#define XB_TOPGEN   3392
#define XCD_BAR_WORDS 3456
#define XB_SPIN_CAP (1u << 22)
__device__ __forceinline__ unsigned xb_ld(unsigned* p)              { return __hip_atomic_load(p, __ATOMIC_RELAXED, __HIP_MEMORY_SCOPE_AGENT); }
__device__ __forceinline__ unsigned xb_add(unsigned* p, unsigned v) { return __hip_atomic_fetch_add(p, v, __ATOMIC_RELAXED, __HIP_MEMORY_SCOPE_AGENT); }
__device__ __forceinline__ unsigned xb_xcc_id() { return (unsigned)__builtin_amdgcn_s_getreg((3 << 11) | 20) & 0xFu; }
#define XB_SPIN(cond, bar) do { unsigned _sp = 0; while (cond) { __builtin_amdgcn_s_sleep(1); \
    if ((++_sp & 255u) == 0u) { if (xb_ld(&(bar)[XB_TMO])) break; if (_sp > XB_SPIN_CAP) { atomicAdd(&(bar)[XB_TMO], 1u); break; } } } } while (0)
struct XcdBarrier { unsigned* bar; unsigned x; volatile LAS unsigned* st; };
__device__ __forceinline__ XcdBarrier xcd_barrier_post(unsigned* bar, volatile LAS unsigned* st) {
    XcdBarrier b; b.bar = bar; b.x = xb_xcc_id(); b.st = st;
    if (threadIdx.x == 0) (void)xb_add(&bar[XB_XCNT(b.x)], 1u);
    return b;
}
__device__ __forceinline__ void xcd_barrier_complete(unsigned* bar, unsigned x, unsigned& nloc, unsigned& nx) {
    const unsigned G = gridDim.x * gridDim.y * gridDim.z;
    unsigned sum, cnt, mine, sp = 0u;
    for (;;) {
        sum = 0u; cnt = 0u; mine = 0u;
#pragma unroll
        for (unsigned j = 0; j < 16; ++j) { const unsigned c = xb_ld(&bar[XB_XCNT(j)]); sum += c; cnt += (c > 0u) ? 1u : 0u; mine = (j == x) ? c : mine; }
        if (sum == G) break;
        __builtin_amdgcn_s_sleep(1);
        if ((++sp & 255u) == 0u) { if (xb_ld(&bar[XB_TMO])) break; if (sp > XB_SPIN_CAP) { atomicAdd(&bar[XB_TMO], 1u); break; } }
    }
    nloc = mine > 0u ? mine : 1u; nx = cnt > 0u ? cnt : 1u;
}
__device__ __forceinline__ void xcd_barrier_impl(const XcdBarrier& b) {
    asm volatile("s_waitcnt vmcnt(0)" ::: "memory");
    __syncthreads();
    if (threadIdx.x == 0) {
        unsigned* bar = b.bar;
        __builtin_amdgcn_s_waitcnt(0);
        unsigned nloc = b.st[0], nx = b.st[1];
        if (nloc == 0u) { xcd_barrier_complete(bar, b.x, nloc, nx); b.st[0] = nloc; b.st[1] = nx; }
        const unsigned old = xb_add(&bar[XB_XSUB(b.x)], 1u);
        const unsigned gen = old / nloc;
        if (old + 1u == (gen + 1u) * nloc) {
            __builtin_amdgcn_fence(__ATOMIC_RELEASE, "agent");
            asm volatile("s_waitcnt vmcnt(0)" ::: "memory");
            const unsigned og = xb_add(&bar[XB_TOP], 1u);
            const unsigned tg = og / nx;
            if (og + 1u == (tg + 1u) * nx) xb_add(&bar[XB_TOPGEN], 1u);
            else XB_SPIN(xb_ld(&bar[XB_TOPGEN]) == tg, bar);
            __builtin_amdgcn_fence(__ATOMIC_ACQUIRE, "agent");
            xb_add(&bar[XB_XGEN(b.x)], 1u);
            asm volatile("s_waitcnt vmcnt(0)" ::: "memory");
        } else {
            XB_SPIN(xb_ld(&bar[XB_XGEN(b.x)]) == gen, bar);
            __builtin_amdgcn_fence(__ATOMIC_ACQUIRE, "agent");
            asm volatile("s_waitcnt vmcnt(0)" ::: "memory");
        }
    }
    __syncthreads();
}

__device__ __forceinline__ void grid_barrier(const Params& p) {
    XcdBarrier b; b.bar = (unsigned*)(ws_opaque(p.ws) + OFF_BAR); b.x = xb_xcc_id(); b.st = (volatile LAS unsigned*)(g_smem + SMEM_BAR_OFF);
    xcd_barrier_impl(b);
}
__device__ __forceinline__ unsigned char* half_smem() { int t = threadIdx.x; asm volatile("" : "+v"(t)); return g_smem + (t >> 8) * SMEM_HALF; }
__device__ __forceinline__ void run_layer(const Params& p, const int layer) {
    PB(11); inproj_phase(p, layer, half_smem()); PE(11);      PB(31); grid_barrier(p); PE(31);
    PB(12); p2a_phase(p, layer, half_smem()); PE(12);         PB(32); grid_barrier(p); PE(32);
    PB(13); p2b_phase(p, layer, half_smem()); PE(13);         PB(33); grid_barrier(p); PE(33);
    PB(14); merge_phase(p, half_smem()); PE(14);              PB(34); grid_barrier(p); PE(34);
    PB(15); wout_phase(p, half_smem()); PE(15);               PB(35); grid_barrier(p); PE(35);
    PB(16); router_phase(p, layer, half_smem()); PE(16);      PB(36); grid_barrier(p); PE(36);
    PB(17); moe_up_phase(p, half_smem()); PE(17);             PB(37); grid_barrier(p); PE(37);
    PB(18); moe_down_phase(p, half_smem()); PE(18);           PB(38); grid_barrier(p); PE(38);
    PB(19); combine_phase(p, layer); PE(19);
    if (layer == 0) { PB(10); prep_phase(p, 1, false, half_smem()); PE(10); PB(39); grid_barrier(p); PE(39); }
}
__global__ void __launch_bounds__(NTHR, 2) k_mega(Params p) {
    volatile LAS unsigned* st = (volatile LAS unsigned*)(g_smem + SMEM_BAR_OFF);
    if (threadIdx.x == 0) { st[0] = 0u; st[1] = 0u; st[2] = 0u; st[3] = 0u; unsigned* gs = (unsigned*)(g_smem + SMEM_GS_OFF); gs[0] = 0u; gs[1] = 0u;
        volatile unsigned long long* q_ = (volatile unsigned long long*)(g_smem + SMEM_PROBE_OFF); q_[0] = 0ull; q_[1] = 0ull; }
    __syncthreads();
    (void)xcd_barrier_post((unsigned*)(p.ws + OFF_BAR), st);
    PB(10); prep_phase(p, 0, true, half_smem()); PE(10);
    PB(39); grid_barrier(p); PE(39);
    run_layer(p, 0);
    run_layer(p, 1);
    if (PROBE_ID >= 0 && blockIdx.x == PROBE_BLK && threadIdx.x == 0) {
        const unsigned long long d_ = *(volatile unsigned long long*)(g_smem + SMEM_PROBE_OFF) * PROBE_AMP, t0_ = __builtin_amdgcn_s_memrealtime();
        while (__builtin_amdgcn_s_memrealtime() - t0_ < d_) __builtin_amdgcn_s_sleep(8);
    }
}

extern "C" void kernel_launch(void* const* d_in, const int* in_sizes, int n_in, void* d_out, int out_size, void* d_ws, size_t ws_size, hipStream_t stream) {
    if (ws_size < WS_TOTAL) { fprintf(stderr, "kernel_launch: workspace too small: %zu < %zu\n", ws_size, (size_t)WS_TOTAL); return; }
    Params p{};
    for (int i = 0; i < 32; ++i) p.in[i] = (const float*)d_in[i];
    p.out = (float*)d_out; p.ws = (unsigned char*)d_ws;
    (void)hipMemsetAsync((char*)d_ws + OFF_BAR, 0, 16384, stream);
    static int grid_blocks = 0;
    if (!grid_blocks) {
        int dev = 0, cus = 0, per_cu = 0;
        (void)hipGetDevice(&dev);
        (void)hipDeviceGetAttribute(&cus, hipDeviceAttributeMultiprocessorCount, dev);
        if (hipOccupancyMaxActiveBlocksPerMultiprocessor(&per_cu, (const void*)k_mega, NTHR, 0) != hipSuccess || per_cu < 1) { fprintf(stderr, "kernel_launch: occupancy query failed\n"); return; }
        grid_blocks = cus;
    }
    void* args[] = {&p};
    hipError_t e = hipLaunchCooperativeKernel((const void*)k_mega, dim3(grid_blocks), dim3(NTHR), args, 0, stream);
    if (e != hipSuccess) fprintf(stderr, "cooperative launch failed: %s (grid %d)\n", hipGetErrorString(e), grid_blocks);
}
```
